# Optimizing an MI355X kernel written in HIP

```python
import jax, jax.numpy as jnp
from jax import lax
import numpy as np

D_MODEL = 1024
BATCH = 32
SEQ = 256
DEPTH = 4
DEC_BATCH = 8
DEC_SEQ = 4096
PAST_LEN = 512

GRID_W = 64
N_MLA_LAYERS = (DEPTH + 1) // 2
N_POOL_LAYERS = DEPTH // 2
N_MOD = 9
FFN_HIDDEN = 2816
EPS = 1e-6
MLA_HEADS = D_MODEL // 128
Q_LORA = D_MODEL // 4
KV_LORA = D_MODEL // 8
QK_NOPE = 64
QK_ROPE = 32
V_HEAD = 64
QK_HEAD = QK_NOPE + QK_ROPE
ROPE_BASE = 10000.0
ATTN_BLOCK = 128
MLA_WIDTH = MLA_HEADS * V_HEAD
GMLP_GROUPS = 4
GMLP_CHUNK = 128
GMLP_WIDTH = D_MODEL // 2
GMLP_GROUP_CH = GMLP_WIDTH // GMLP_GROUPS
MIX_WIDTH = MLA_WIDTH + GMLP_WIDTH
OFF_KV = Q_LORA
OFF_KR = Q_LORA + KV_LORA
OFF_G = Q_LORA + KV_LORA + QK_ROPE
IN_DIM = OFF_G + 2 * GMLP_WIDTH
POOL_WINDOWS = (2, 4, 8, 16)
POOL_GROUP_CH = D_MODEL // len(POOL_WINDOWS)

kernel_name = 'hybrid_mla_gmlp_pool_diffusion_step'


def rms_norm(x, g):
    x32 = x.astype(jnp.float32)
    y = x32 * lax.rsqrt(jnp.mean(x32 * x32, axis=-1, keepdims=True) + EPS)
    return (y * g.astype(jnp.float32)).astype(x.dtype)


def modulate(x, g, m, k):
    return rms_norm(x, g) * (1 + m[:, 3 * k + 1, None, :]) + m[:, 3 * k, None, :]


def swiglu(h, w1, w3, w2):
    return (jax.nn.silu(h @ w1) * (h @ w3)) @ w2


def axial_rope_tables(rows):
    row = jnp.repeat(jnp.arange(rows), GRID_W).astype(jnp.float32)
    col = jnp.tile(jnp.arange(GRID_W), rows).astype(jnp.float32)
    per_axis = QK_ROPE // 2
    inv = ROPE_BASE ** (-jnp.arange(0, per_axis, 2, dtype=jnp.float32) / per_axis)
    ang = jnp.concatenate([row[:, None] * inv, col[:, None] * inv], axis=-1)
    return jnp.cos(ang), jnp.sin(ang)


def apply_rope(x, cos, sin):
    half = QK_ROPE // 4
    xr = x.astype(jnp.float32).reshape(x.shape[:-1] + (2, 2, half))
    x1, x2 = xr[..., 0, :], xr[..., 1, :]
    c = cos.reshape(cos.shape[0], 2, half)[None, :, None]
    s = sin.reshape(sin.shape[0], 2, half)[None, :, None]
    out = jnp.stack([x1 * c - x2 * s, x1 * s + x2 * c], axis=-2)
    return out.reshape(x.shape).astype(x.dtype)


def block_attention(q, k, v):
    B, Lq, H, Dh = q.shape
    nblk = Lq // ATTN_BLOCK
    qb = q.reshape(B, nblk, ATTN_BLOCK, H, Dh).transpose(1, 0, 2, 3, 4)
    scale = Dh ** -0.5

    def one(qblk):
        s = jnp.einsum('bqhd,bkhd->bhqk', qblk, k, preferred_element_type=jnp.float32) * scale
        p = jax.nn.softmax(s, axis=-1).astype(v.dtype)
        return jnp.einsum('bhqk,bkhd->bqhd', p, v)

    o = lax.map(one, qb)
    return o.transpose(1, 0, 2, 3, 4).reshape(B, Lq, H, v.shape[-1])


def mla_kv(kv_lat, k_rope, w_kvb, k_norm):
    B, L, _ = kv_lat.shape
    kv = (kv_lat @ w_kvb).reshape(B, L, MLA_HEADS, QK_NOPE + V_HEAD)
    k_nope, v = kv[..., :QK_NOPE], kv[..., QK_NOPE:]
    k = jnp.concatenate([k_nope, jnp.broadcast_to(k_rope[:, :, None, :], (B, L, MLA_HEADS, QK_ROPE))], axis=-1)
    return rms_norm(k, k_norm), v


def chunk_gmlp(g, v_norm, ws, bs):
    u, v = g[..., :GMLP_WIDTH], g[..., GMLP_WIDTH:]
    v = rms_norm(v, v_norm)
    B, L, _ = v.shape
    vr = v.reshape(B, L // GMLP_CHUNK, GMLP_CHUNK, GMLP_GROUPS, GMLP_GROUP_CH)
    mixed = jnp.einsum('gpq,bnqgc->bnpgc', ws, vr) + bs.T[:, :, None]
    return u * mixed.reshape(B, L, GMLP_WIDTH)


def multiscale_pool(h, pool_w, pool_scale):
    B, L, D = h.shape
    h32 = h.astype(jnp.float32)
    cs = jnp.concatenate([jnp.zeros((B, 1, D), jnp.float32), jnp.cumsum(h32, axis=1)], axis=1)
    t = jnp.arange(L)
    outs = []
    for gi, w in enumerate(POOL_WINDOWS):
        sl = slice(gi * POOL_GROUP_CH, (gi + 1) * POOL_GROUP_CH)
        lo = jnp.clip(t - w // 2, 0, L)
        hi = jnp.clip(t + w - w // 2, 0, L)
        csg = cs[:, :, sl]
        mean = (csg[:, hi] - csg[:, lo]) / (hi - lo).astype(jnp.float32)[None, :, None]
        outs.append((mean - h32[:, :, sl]).astype(h.dtype) @ pool_w[gi])
    return jnp.concatenate(outs, axis=-1) * pool_scale


def trunk(x, cvec, rope, cache_ckv, cache_krope, w_mod, b_mod, norm_g, ffn_w1, ffn_w3, ffn_w2,
          w_in, q_a_norm, kv_a_norm, w_qb, w_kvb, q_norm, k_norm, gmlp_v_norm, gmlp_ws, gmlp_b,
          w_out, pool_w, pool_scale):
    B, L, _ = x.shape
    ckv_out, krope_out = [], []
    for i in range(DEPTH):
        m = (jax.nn.silu(cvec) @ w_mod[i] + b_mod[i]).reshape(cvec.shape[0], N_MOD, D_MODEL)
        h = modulate(x, norm_g[i, 0], m, 0)
        x = x + 0.5 * m[:, 2, None, :] * swiglu(h, ffn_w1[i, 0], ffn_w3[i, 0], ffn_w2[i, 0])
        h = modulate(x, norm_g[i, 1], m, 1)
        if i % 2 == 0:
            j = i // 2
            proj = h @ w_in[j]
            q_lat = rms_norm(proj[..., :OFF_KV], q_a_norm[j])
            kv_lat = rms_norm(proj[..., OFF_KV:OFF_KR], kv_a_norm[j])
            k_rope = proj[..., OFF_KR:OFF_G]
            gm = jax.nn.gelu(proj[..., OFF_G:])
            q = rms_norm((q_lat @ w_qb[j]).reshape(B, L, MLA_HEADS, QK_HEAD), q_norm[j])
            k, v = mla_kv(kv_lat, k_rope, w_kvb[j], k_norm[j])
            if cache_ckv is None:
                attn = block_attention(q, k, v)
                ckv_out.append(kv_lat)
                krope_out.append(k_rope)
            else:
                cos, sin = rope
                q = jnp.concatenate([q[..., :QK_NOPE], apply_rope(q[..., QK_NOPE:], cos, sin)], axis=-1)
                k = jnp.concatenate([k[..., :QK_NOPE], apply_rope(k[..., QK_NOPE:], cos, sin)], axis=-1)
                kc, vc = mla_kv(cache_ckv[:, j], cache_krope[:, j], w_kvb[j], k_norm[j])
                attn = block_attention(q, jnp.concatenate([k, kc], axis=1), jnp.concatenate([v, vc], axis=1))
            gout = chunk_gmlp(gm, gmlp_v_norm[j], gmlp_ws[j], gmlp_b[j])
            mix = jnp.concatenate([attn.reshape(B, L, MLA_WIDTH), gout], axis=-1) @ w_out[j]
        else:
            j = i // 2
            mix = multiscale_pool(h, pool_w[j], pool_scale[j])
        x = x + m[:, 5, None, :] * mix
        h = modulate(x, norm_g[i, 2], m, 2)
        x = x + 0.5 * m[:, 8, None, :] * swiglu(h, ffn_w1[i, 1], ffn_w3[i, 1], ffn_w2[i, 1])
    return x, ckv_out, krope_out


def setup_inputs(seed: int = 0) -> dict:
    key = jax.random.key(seed)
    ks = jax.random.split(key, 32)
    nrm = lambda k, shape, s: jax.random.normal(k, shape, jnp.float32) * s
    gain = lambda k, shape: 1.0 + 0.02 * jax.random.normal(k, shape, jnp.float32)
    return {
        'x_prompt': nrm(ks[0], (BATCH, SEQ, D_MODEL), 1.0),
        'x_sample': nrm(ks[1], (DEC_BATCH, DEC_SEQ, D_MODEL), 1.0),
        'cache_ckv': nrm(ks[2], (DEC_BATCH, N_MLA_LAYERS, PAST_LEN, KV_LORA), 1.0),
        'cache_krope': nrm(ks[3], (DEC_BATCH, N_MLA_LAYERS, PAST_LEN, QK_ROPE), 1.0),
        'c': nrm(ks[4], (DEC_BATCH, D_MODEL), 1.0),
        'c_ctx': nrm(ks[5], (D_MODEL,), 1.0),
        'w_mod': nrm(ks[6], (DEPTH, D_MODEL, N_MOD * D_MODEL), 0.5 * D_MODEL ** -0.5),
        'b_mod': nrm(ks[7], (DEPTH, N_MOD * D_MODEL), 0.02),
        'norm_g': gain(ks[8], (DEPTH, 3, D_MODEL)),
        'ffn_w1': nrm(ks[9], (DEPTH, 2, D_MODEL, FFN_HIDDEN), D_MODEL ** -0.5),
        'ffn_w3': nrm(ks[10], (DEPTH, 2, D_MODEL, FFN_HIDDEN), D_MODEL ** -0.5),
        'ffn_w2': nrm(ks[11], (DEPTH, 2, FFN_HIDDEN, D_MODEL), FFN_HIDDEN ** -0.5),
        'w_in': nrm(ks[12], (N_MLA_LAYERS, D_MODEL, IN_DIM), D_MODEL ** -0.5),
        'q_a_norm': gain(ks[13], (N_MLA_LAYERS, Q_LORA)),
        'kv_a_norm': gain(ks[14], (N_MLA_LAYERS, KV_LORA)),
        'w_qb': nrm(ks[15], (N_MLA_LAYERS, Q_LORA, MLA_HEADS * QK_HEAD), Q_LORA ** -0.5),
        'w_kvb': nrm(ks[16], (N_MLA_LAYERS, KV_LORA, MLA_HEADS * (QK_NOPE + V_HEAD)), KV_LORA ** -0.5),
        'q_norm': gain(ks[17], (N_MLA_LAYERS, QK_HEAD)),
        'k_norm': gain(ks[18], (N_MLA_LAYERS, QK_HEAD)),
        'gmlp_v_norm': gain(ks[19], (N_MLA_LAYERS, GMLP_WIDTH)),
        'gmlp_ws': nrm(ks[20], (N_MLA_LAYERS, GMLP_GROUPS, GMLP_CHUNK, GMLP_CHUNK), GMLP_CHUNK ** -0.5),
        'gmlp_b': nrm(ks[21], (N_MLA_LAYERS, GMLP_GROUPS, GMLP_CHUNK), 0.02),
        'w_out': nrm(ks[22], (N_MLA_LAYERS, MIX_WIDTH, D_MODEL), MIX_WIDTH ** -0.5),
        'pool_w': nrm(ks[23], (N_POOL_LAYERS, len(POOL_WINDOWS), POOL_GROUP_CH, POOL_GROUP_CH), POOL_GROUP_CH ** -0.5),
        'pool_scale': gain(ks[24], (N_POOL_LAYERS, D_MODEL)),
    }


def reference(x_prompt, x_sample, cache_ckv, cache_krope, c, c_ctx, w_mod, b_mod, norm_g,
              ffn_w1, ffn_w3, ffn_w2, w_in, q_a_norm, kv_a_norm, w_qb, w_kvb, q_norm, k_norm,
              gmlp_v_norm, gmlp_ws, gmlp_b, w_out, pool_w, pool_scale):
    weights = (w_mod, b_mod, norm_g, ffn_w1, ffn_w3, ffn_w2, w_in, q_a_norm, kv_a_norm, w_qb,
               w_kvb, q_norm, k_norm, gmlp_v_norm, gmlp_ws, gmlp_b, w_out, pool_w, pool_scale)
    y_prompt, ckv_list, krope_list = trunk(x_prompt, c_ctx[None, :], None, None, None, *weights)
    new_ckv = jnp.stack(ckv_list, axis=1)
    new_krope = jnp.stack(krope_list, axis=1)
    ROWS = x_sample.shape[1] // GRID_W
    rope = axial_rope_tables(ROWS)
    y_sample, _, _ = trunk(x_sample, c, rope, cache_ckv, cache_krope, *weights)
    return (y_prompt, y_sample, new_ckv, new_krope)
```

```cpp
#include <hip/hip_runtime.h>
#include <hip/hip_cooperative_groups.h>
#include <cstdio>
#include <cstdint>
namespace cg = cooperative_groups;
#ifndef EN_NORM
#define EN_NORM 1
#endif
#ifndef EN_G1
#define EN_G1 1
#endif
#ifndef EN_GRES
#define EN_GRES 1
#endif
#ifndef EN_GRAW
#define EN_GRAW 1
#endif
#ifndef EN_POST1
#define EN_POST1 1
#endif
#ifndef EN_POST2
#define EN_POST2 1
#endif
#ifndef EN_ATT
#define EN_ATT 1
#endif
#ifndef EN_POOL
#define EN_POOL 1
#endif
#ifndef EN_PRO
#define EN_PRO 1
#endif
#ifndef DUPMASK
#define DUPMASK 0
#endif

#define LAS __attribute__((address_space(3)))
typedef unsigned short bf16_t;
typedef short bf16x8 __attribute__((ext_vector_type(8)));
typedef short s16x4 __attribute__((ext_vector_type(4)));
typedef float f32x4 __attribute__((ext_vector_type(4)));
typedef float f32x16 __attribute__((ext_vector_type(16)));
typedef unsigned u32x4 __attribute__((ext_vector_type(4)));
typedef unsigned u32x2 __attribute__((ext_vector_type(2)));

constexpr int DM = 1024, FF = 2816, MTOK = 40960, MEXT = 45056, NCTX = 8192, LLAT = 4096, PAST = 512, KVB = 4608;
constexpr int NMOD = 9216;
constexpr int QLD = 2048;
constexpr float EPS = 1e-6f;
constexpr size_t SZ_W13 = (size_t)8 * 5632 * 1024 * 2, SZ_W2 = (size_t)8 * 1024 * 2816 * 2, SZ_WIN = (size_t)2 * 1536 * 1024 * 2,
                 SZ_WQKV = (size_t)2 * 1792 * 384 * 2, SZ_WOUT = (size_t)2 * 1024 * 1024 * 2, SZ_POOLT = (size_t)2 * 1024 * 256 * 2,
                 SZ_WS = (size_t)2 * 4 * 128 * 128 * 2, SZ_MOD = (size_t)4 * 9 * NMOD * 4, SZ_ROPE = (size_t)2 * 4096 * 16 * 4,
                 SZ_H = (size_t)MTOK * 1024 * 2;
constexpr size_t OFF_W13 = 0, OFF_W2 = OFF_W13 + SZ_W13, OFF_WIN = OFF_W2 + SZ_W2, OFF_WQKV = OFF_WIN + SZ_WIN, OFF_WOUT = OFF_WQKV + SZ_WQKV,
                 OFF_POOLT = OFF_WOUT + SZ_WOUT, OFF_WS = OFF_POOLT + SZ_POOLT, OFF_MOD = OFF_WS + SZ_WS, OFF_ROPE = OFF_MOD + SZ_MOD,
                 OFF_H = OFF_ROPE + SZ_ROPE, OFF_R = OFF_H + SZ_H;
constexpr size_t R_QKVLAT = 0, R_KROPE = (size_t)MEXT * 384 * 2, R_PROJ = 41943040, R_GM = R_PROJ + (size_t)MTOK * 512 * 4,
                 R_QKVRAW = R_PROJ, SZ_R = SZ_H + (size_t)MTOK * 2816 * 2;
static_assert(R_KROPE + (size_t)MTOK * 32 * 4 <= R_PROJ, "ws map");
static_assert(R_QKVRAW + (size_t)MEXT * QLD * 2 <= SZ_R, "ws map");
constexpr size_t OFF_CTL = OFF_R + SZ_R, SZ_CTL = 16384;
constexpr size_t OFF_RSS = OFF_CTL + SZ_CTL, SZ_RSS = (size_t)12 * MTOK * 4;
constexpr size_t OFF_B13 = OFF_RSS + SZ_RSS, SZ_B13 = (size_t)8 * 9 * 5632 * 4;
constexpr size_t OFF_BIN = OFF_B13 + SZ_B13, SZ_BIN = (size_t)2 * 9 * 1536 * 4;
constexpr size_t R_U = SZ_H;
static_assert(R_U + (size_t)MTOK * 2816 * 2 <= SZ_R, "ws map");
constexpr size_t WS_NEED = OFF_BIN + SZ_BIN;

__device__ __forceinline__ unsigned cvt_pk_bf16(float lo, float hi) { unsigned r; asm volatile("v_cvt_pk_bf16_f32 %0, %1, %2" : "=v"(r) : "v"(lo), "v"(hi)); return r; }
__device__ __forceinline__ float bf2f(unsigned short b) { return __uint_as_float(((unsigned)b) << 16); }
__device__ __forceinline__ float bflo(unsigned w) { return __uint_as_float(w << 16); }
__device__ __forceinline__ float bfhi(unsigned w) { return __uint_as_float(w & 0xffff0000u); }
__device__ __forceinline__ float wave_sum(float v) {
#pragma unroll
    for (int o = 1; o < 64; o <<= 1) v += __shfl_xor(v, o);
    return v;
}
__device__ __forceinline__ float fast_sigmoid(float x) { return __builtin_amdgcn_rcpf(1.0f + __builtin_amdgcn_exp2f(-1.4426950408889634f * x)); }
__device__ __forceinline__ float silu_f(float x) { return x * fast_sigmoid(x); }
__device__ __forceinline__ float gelu_tanh_f(float x) { const float y = 0.7978845608028654f * (x + 0.044715f * x * x * x); return x * fast_sigmoid(2.0f * y); }
__device__ __forceinline__ int cv_of_row(int r) { return r < NCTX ? 0 : 1 + ((r - NCTX) >> 12); }

#ifndef PROBE_KREP
#define PROBE_KREP 1
#endif
namespace pg8 {
constexpr int BM = 256, BK = 64, HALF = 128, HTB = HALF * BK * 2, STAGE_BYTES = 8 * HTB, NXCD = 8, WGM = 8;
__host__ __device__ __forceinline__ int lds_byte(int r, int c) { const int st = (r >> 4) * 2 + (c >> 5), rr = r & 15, cc = c & 31, ob = rr * 64 + cc * 2; return st * 1024 + (ob ^ (((ob >> 9) & 1) << 5)); }
__host__ __device__ __forceinline__ void stage_rc(int b, int& R, int& C) { const int st = b / 1024, sb = b % 1024, swz = sb ^ (((sb >> 9) & 1) << 5); R = (st >> 1) * 16 + swz / 64; C = (st & 1) * 32 + (swz % 64) / 2; }
__host__ __device__ __forceinline__ int perm32(int rho) { const int n = rho >> 4, i = rho & 15; return 8 * (i >> 2) + 4 * n + (i & 3); }

struct Unit { int pm, pn, half; };
struct Gemm { const bf16_t* A; const bf16_t* Bt; int M, N, K, lda, ldb, apn, ksp, pad_; };

struct StaticOrder {
    int nM, nN, nwg, G, c, ht;
    __device__ void init(int M, int N, int G_, int c_, int ht_ = 0) { nM = M / BM; nN = N / BM; nwg = nM * nN; G = G_; c = c_; ht = ht_; }
    __device__ bool next(int i, Unit& u) const {
        long L = (long)i * G + c; u.half = -1;
        if (ht) { const int nfull = nwg / G, rem = nwg - nfull * G;
            if (rem > 0 && 2 * rem <= G && i >= nfull) { if (i > nfull || (c >> 1) >= rem) return false; L = (long)nfull * G + (c >> 1); u.half = c & 1; } }
        if (L >= nwg) return false;
        int wgid = (int)L; { const int q = nwg / NXCD, r = nwg % NXCD, xcd = wgid % NXCD, off = wgid / NXCD; wgid = (xcd < r ? xcd * (q + 1) : r * (q + 1) + (xcd - r) * q) + off; }
        const int nig = WGM * nN, gid = wgid / nig, fm = gid * WGM, gsz = (nM - fm) < WGM ? (nM - fm) : WGM;
        u.pm = fm + ((wgid % nig) % gsz); u.pn = (wgid % nig) / gsz; return true;
    }
};

struct EpiSwiglu {
    static constexpr bool PERM = true; static constexpr int KREP = PROBE_KREP;
    bf16_t* U; const float* rss; const float* bias;
    static constexpr bool PREF = true;
    __device__ __forceinline__ bool pref_on() const { return true; }
    __device__ __forceinline__ const float* pref_ptr(const Unit& u, int tid) const { const int cv = u.pm < 32 ? 0 : 1 + ((u.pm - 32) >> 4);
        return tid < 256 ? rss + u.pm * BM + tid : bias + (size_t)cv * 5632 + u.pn * BM + (tid - 256); }
    __device__ __forceinline__ void run(f32x4 (&acc)[2][2][4][2], const Unit& u, int wr, int wc, int fr, int fq, const LAS float* sc) const {
        const int row0 = u.pm * BM + wr * 64 + fr, col0 = u.pn * HALF + wc * 32 + 8 * fq;
        const LAS float* bp = sc + 256 + wc * 32 + 8 * fq;
        const f32x4 ba0 = *(const LAS f32x4*)(bp), ba1 = *(const LAS f32x4*)(bp + 4), bb0 = *(const LAS f32x4*)(bp + HALF), bb1 = *(const LAS f32x4*)(bp + HALF + 4);
#pragma unroll
        for (int ai = 0; ai < 2; ++ai)
#pragma unroll
            for (int m = 0; m < 4; ++m) {
                const int row = row0 + ai * HALF + m * 16;
                bf16_t* rowp = U + (size_t)row * FF + col0;
                const float rstd = (1.0f / (float)KREP) / sqrtf(sc[ai * HALF + wr * 64 + m * 16 + fr] * (1.0f / 1024.0f) + EPS);
                const f32x4 a0 = acc[ai][0][m][0] * rstd + ba0, a1 = acc[ai][0][m][1] * rstd + ba1, b0 = acc[ai][1][m][0] * rstd + bb0, b1 = acc[ai][1][m][1] * rstd + bb1;
                f32x4 v0, v1;
#pragma unroll
                for (int e = 0; e < 4; ++e) { v0[e] = silu_f(a0[e]) * b0[e]; v1[e] = silu_f(a1[e]) * b1[e]; }
                u32x4 w; w.x = cvt_pk_bf16(v0[0], v0[1]); w.y = cvt_pk_bf16(v0[2], v0[3]); w.z = cvt_pk_bf16(v1[0], v1[1]); w.w = cvt_pk_bf16(v1[2], v1[3]);
                *(u32x4*)rowp = w;
            }
    }
};
struct EpiResid {
    static constexpr bool PERM = true; static constexpr int KREP = 1;
    float* X; const float* gate; const float* scale;
    bf16_t* An; const float* gn; const float* scn; float* rssn;
    float coef; int pad_;
    static constexpr bool PREF = false;
    __device__ __forceinline__ bool pref_on() const { return false; }
    __device__ __forceinline__ const float* pref_ptr(const Unit&, int) const { return nullptr; }
    __device__ __forceinline__ void run(f32x4 (&acc)[2][2][4][2], const Unit& u, int wr, int wc, int fr, int fq, const LAS float*) const {
        const int row0 = u.pm * BM + wr * 64 + fr; int col0 = u.pn * BM + wc * 32 + 8 * fq;
        const int cv = u.pm < 32 ? 0 : 1 + ((u.pm - 32) >> 4);
        const bool nx = An != nullptr;
        const int hb = u.half > 0 ? HALF : 0, nbj = u.half < 0 ? 2 : 1;
        col0 += hb;
        f32x4 gv[2][2], gm[2][2];
#pragma unroll
        for (int bj = 0; bj < 2; ++bj)
#pragma unroll
            for (int n = 0; n < 2; ++n) { const int c = col0 + (bj < nbj ? bj : 0) * HALF + 4 * n; f32x4 g = *(const f32x4*)(gate + (size_t)cv * NMOD + c) * coef;
                if (scale) g = g * *(const f32x4*)(scale + c); gv[bj][n] = g;
                gm[bj][n] = nx ? *(const f32x4*)(gn + c) * (*(const f32x4*)(scn + (size_t)cv * NMOD + c) + 1.0f) : (f32x4){0.f, 0.f, 0.f, 0.f}; }
#pragma unroll
        for (int ai = 0; ai < 2; ++ai)
#pragma unroll
            for (int m = 0; m < 4; ++m) { const int row = row0 + ai * HALF + m * 16; float* rowp = X + (size_t)row * DM + col0;
                float ss = 0.f;
#pragma unroll
                for (int bj = 0; bj < 2; ++bj) if (bj < nbj) { f32x4* p = (f32x4*)(rowp + bj * HALF);
                    const f32x4 x0 = __builtin_nontemporal_load(p) + acc[ai][bj][m][0] * gv[bj][0], x1 = __builtin_nontemporal_load(p + 1) + acc[ai][bj][m][1] * gv[bj][1];
                    __builtin_nontemporal_store(x0, p); __builtin_nontemporal_store(x1, p + 1);
                    if (nx) { ss += ((x0[0] * x0[0] + x0[1] * x0[1]) + (x0[2] * x0[2] + x0[3] * x0[3])) + ((x1[0] * x1[0] + x1[1] * x1[1]) + (x1[2] * x1[2] + x1[3] * x1[3]));
                        const f32x4 a0 = x0 * gm[bj][0], a1 = x1 * gm[bj][1]; u32x4 w; w.x = cvt_pk_bf16(a0[0], a0[1]); w.y = cvt_pk_bf16(a0[2], a0[3]); w.z = cvt_pk_bf16(a1[0], a1[1]); w.w = cvt_pk_bf16(a1[2], a1[3]);
                        *(u32x4*)(An + (size_t)row * DM + col0 + bj * HALF) = w; } }
                if (nx) { ss += __shfl_xor(ss, 16); ss += __shfl_xor(ss, 32);
                    if (fq == 0) (void)__hip_atomic_fetch_add(rssn + row, ss, __ATOMIC_RELAXED, __HIP_MEMORY_SCOPE_AGENT); } }
    }
};
struct EpiRaw {
    static constexpr bool PERM = true; static constexpr int KREP = 1;
    float* R; bf16_t* G; const float* rss; const float* bias; int ldr, nraw, ldg, act;
    static constexpr bool PREF = true;
    __device__ __forceinline__ bool pref_on() const { return rss != nullptr; }
    __device__ __forceinline__ const float* pref_ptr(const Unit& u, int tid) const { const int cv = u.pm < 32 ? 0 : 1 + ((u.pm - 32) >> 4);
        return tid < 256 ? rss + u.pm * BM + tid : bias + (size_t)cv * 1536 + u.pn * BM + (tid - 256); }
    __device__ __forceinline__ void run(f32x4 (&acc)[2][2][4][2], const Unit& u, int wr, int wc, int fr, int fq, const LAS float* sc) const {
        const int row0 = u.pm * BM + wr * 64 + fr, cw = wc * 32 + 8 * fq;
        if (rss) {
            f32x4 bv[2][2];
#pragma unroll
            for (int bj = 0; bj < 2; ++bj)
#pragma unroll
                for (int n = 0; n < 2; ++n) bv[bj][n] = *(const LAS f32x4*)(sc + 256 + cw + bj * HALF + 4 * n);
#pragma unroll
            for (int ai = 0; ai < 2; ++ai)
#pragma unroll
                for (int m = 0; m < 4; ++m) { const float rstd = 1.0f / sqrtf(sc[ai * HALF + wr * 64 + m * 16 + fr] * (1.0f / 1024.0f) + EPS);
#pragma unroll
                    for (int bj = 0; bj < 2; ++bj)
#pragma unroll
                        for (int n = 0; n < 2; ++n) acc[ai][bj][m][n] = acc[ai][bj][m][n] * rstd + bv[bj][n]; }
        }
        if (u.pn < nraw) {
#pragma unroll
            for (int ai = 0; ai < 2; ++ai)
#pragma unroll
                for (int m = 0; m < 4; ++m) { float* rowp = R + (size_t)(row0 + ai * HALF + m * 16) * ldr + u.pn * BM + cw;
#pragma unroll
                    for (int bj = 0; bj < 2; ++bj) { *(f32x4*)(rowp + bj * HALF) = acc[ai][bj][m][0]; *(f32x4*)(rowp + bj * HALF + 4) = acc[ai][bj][m][1]; } }
        } else {
#pragma unroll
            for (int ai = 0; ai < 2; ++ai)
#pragma unroll
                for (int m = 0; m < 4; ++m) { bf16_t* rowp = G + (size_t)(row0 + ai * HALF + m * 16) * ldg + (u.pn - nraw) * BM + cw;
#pragma unroll
                    for (int bj = 0; bj < 2; ++bj) { f32x4 v0 = acc[ai][bj][m][0], v1 = acc[ai][bj][m][1];
                        if (act) {
#pragma unroll
                            for (int e = 0; e < 4; ++e) { v0[e] = gelu_tanh_f(v0[e]); v1[e] = gelu_tanh_f(v1[e]); } }
                        u32x4 w; w.x = cvt_pk_bf16(v0[0], v0[1]); w.y = cvt_pk_bf16(v0[2], v0[3]); w.z = cvt_pk_bf16(v1[0], v1[1]); w.w = cvt_pk_bf16(v1[2], v1[3]);
                        *(u32x4*)(rowp + bj * HALF) = w; } }
        }
    }
};

template <class Epi, bool HT = false>
__device__ __forceinline__ void gemm_phase(LAS unsigned char* lds, const Gemm g, const StaticOrder S, const Epi E) {
    int tid = threadIdx.x; asm volatile("" : "+v"(tid));
    const int wid = __builtin_amdgcn_readfirstlane(tid >> 6), lane = tid & 63, wr = wid >> 2, wc = wid & 3, fr = lane & 15, fq = lane >> 4;
    const int nt = g.K / BK;
#define PG8_NT(u) (g.ksp ? ((u).pn < g.ksp ? 4 : 2) : nt)
#define PG8_KO(u) ((size_t)(g.ksp ? ((u).pn < g.ksp ? 0 : 512) : 0))
    unsigned voffA[2], voffB[2];
#pragma unroll
    for (int i = 0; i < 2; ++i) { int R, C; stage_rc(tid * 16 + i * 8192, R, C); const int Rb = Epi::PERM ? ((R & ~31) + perm32(R & 31)) : R;
        voffA[i] = (unsigned)(R * g.lda + C) * 2u; voffB[i] = (unsigned)(Rb * g.ldb + C) * 2u; }
    const size_t kstep = (size_t)(BK * 2);
    const size_t hstepA = (size_t)HALF * g.lda * 2, hstepB = (size_t)HALF * g.ldb * 2;
    const size_t tstepA = 2 * hstepA, tstepB = 2 * hstepB;
    const unsigned ldsw = (unsigned)wid * 1024u;
    const int aoff = lds_byte(wr * 64 + fr, fq * 8), boff = lds_byte(wc * 32 + fr, fq * 8);
#define PG8_SA(b, h) (((b) * 2 + (h)) * HTB)
#define PG8_SB(b, h) ((4 + (b) * 2 + (h)) * HTB)
#define PG8_STAGE(bufoff, gbase, voff) do { _Pragma("unroll") for (int _i = 0; _i < 2; ++_i) \
        __builtin_amdgcn_global_load_lds((const unsigned*)((const char*)(gbase) + (voff)[_i]), (LAS unsigned*)(lds + (bufoff) + ldsw + _i * 8192), 16, 0, 0); } while (0)
#define PG8_LDA(dst, b, h) do { _Pragma("unroll") for (int m = 0; m < 4; ++m) _Pragma("unroll") for (int k = 0; k < 2; ++k) dst[m][k] = *(const LAS bf16x8*)(lds + PG8_SA(b, h) + aoff + m * 2048 + k * 1024); } while (0)
#define PG8_LDB(dst, b, h) do { _Pragma("unroll") for (int n = 0; n < 2; ++n) _Pragma("unroll") for (int k = 0; k < 2; ++k) dst[n][k] = *(const LAS bf16x8*)(lds + PG8_SB(b, h) + boff + n * 2048 + k * 1024); } while (0)
#define PG8_MMA(ai, bj, At, Bt) do { __builtin_amdgcn_s_setprio(1); _Pragma("unroll") for (int m = 0; m < 4; ++m) _Pragma("unroll") for (int n = 0; n < 2; ++n) _Pragma("unroll") for (int k = 0; k < 2; ++k) \
        acc[ai][bj][m][n] = __builtin_amdgcn_mfma_f32_16x16x32_bf16(Bt[n][k], At[m][k], acc[ai][bj][m][n], 0, 0, 0); __builtin_amdgcn_s_setprio(0); } while (0)
#define PG8_WAIT_V(n) asm volatile("s_waitcnt vmcnt(" #n ")" ::: "memory")
#define PG8_WAIT_L(n) asm volatile("s_waitcnt lgkmcnt(" #n ")" ::: "memory")
#define PG8_BAR __builtin_amdgcn_s_barrier()
#define PG8_SCHED __builtin_amdgcn_sched_barrier(0)
    Unit cur, nxt; int ui = 0;
    if (!S.next(0, cur)) return;
    constexpr int EPI_LDS = 131328;
#define PG8_PREF(u) do { if (Epi::PREF && E.pref_on()) __builtin_amdgcn_global_load_lds((const unsigned*)E.pref_ptr(u, tid), (LAS unsigned*)(lds + EPI_LDS + (ui & 1) * 2048 + wid * 256), 4, 0, 0); } while (0)
    PG8_PREF(cur);
    f32x4 acc[2][2][4][2];
#pragma unroll
    for (int a = 0; a < 2; ++a)
#pragma unroll
        for (int b = 0; b < 2; ++b)
#pragma unroll
            for (int m = 0; m < 4; ++m)
#pragma unroll
                for (int n = 0; n < 2; ++n) acc[a][b][m][n] = (f32x4){0.f, 0.f, 0.f, 0.f};
    bf16x8 At[4][2], B0[2][2], B1[2][2];
    const char* cA = (const char*)g.A + (size_t)cur.pm * tstepA + (size_t)cur.pn * g.apn + PG8_KO(cur); const char* cB = (const char*)g.Bt + (size_t)cur.pn * tstepB + ((HT && cur.half > 0) ? hstepB : 0) + PG8_KO(cur);
    int ntc = PG8_NT(cur);
    size_t hBc = (HT && cur.half >= 0) ? 0 : hstepB;
    PG8_STAGE(PG8_SB(0, 0), cB, voffB); PG8_STAGE(PG8_SB(0, 1), cB + hBc, voffB); PG8_STAGE(PG8_SA(0, 0), cA, voffA); PG8_STAGE(PG8_SA(0, 1), cA + hstepA, voffA);
    if (wr == 1) PG8_BAR;
    PG8_WAIT_V(2); PG8_BAR;
    PG8_STAGE(PG8_SB(1, 0), cB + kstep, voffB); PG8_STAGE(PG8_SA(1, 0), cA + kstep, voffA); PG8_STAGE(PG8_SB(1, 1), cB + hBc + kstep, voffB);
    PG8_WAIT_V(6); PG8_BAR;
#define PG8_KBODY(B1ON) \
        for (int t = 0, tk = 0; t < ntc * Epi::KREP; t += 2) { \
            const bool last = (t == ntc * Epi::KREP - 2); \
            const int tk2 = (tk + 2 >= ntc) ? tk + 2 - ntc : tk + 2; \
            const char* a1 = cA + (size_t)(tk + 1) * kstep; \
            const char* a2 = last ? nA : cA + (size_t)tk2 * kstep; const char* b2 = last ? nB : cB + (size_t)tk2 * kstep; const size_t hb2 = last ? nhB : hBc; tk = tk2; \
            const char* a3 = a2 + kstep; const char* b3 = b2 + kstep; \
            PG8_LDB(B0, 0, 0); if (B1ON) PG8_LDB(B1, 0, 1); PG8_SCHED; PG8_LDA(At, 0, 0); PG8_STAGE(PG8_SA(1, 1), a1 + hstepA, voffA); \
            PG8_WAIT_V(8); PG8_WAIT_L(0); PG8_BAR; PG8_MMA(0, 0, At, B0); if (B1ON) PG8_MMA(0, 1, At, B1); PG8_BAR; PG8_SCHED; \
            PG8_LDA(At, 0, 1); PG8_STAGE(PG8_SB(0, 0), b2, voffB); PG8_STAGE(PG8_SB(0, 1), b2 + hb2, voffB); PG8_STAGE(PG8_SA(0, 0), a2, voffA); \
            PG8_WAIT_V(8); PG8_WAIT_L(0); PG8_BAR; PG8_MMA(1, 0, At, B0); if (B1ON) PG8_MMA(1, 1, At, B1); PG8_BAR; PG8_SCHED; \
            PG8_LDB(B0, 1, 0); if (B1ON) PG8_LDB(B1, 1, 1); PG8_SCHED; PG8_LDA(At, 1, 0); PG8_STAGE(PG8_SA(0, 1), a2 + hstepA, voffA); \
            PG8_WAIT_V(8); PG8_WAIT_L(0); PG8_BAR; PG8_MMA(0, 0, At, B0); if (B1ON) PG8_MMA(0, 1, At, B1); PG8_BAR; PG8_SCHED; \
            PG8_LDA(At, 1, 1); PG8_STAGE(PG8_SB(1, 0), b3, voffB); PG8_STAGE(PG8_SB(1, 1), b3 + hb2, voffB); PG8_STAGE(PG8_SA(1, 0), a3, voffA); \
            PG8_WAIT_V(8); PG8_WAIT_L(0); PG8_BAR; PG8_MMA(1, 0, At, B0); if (B1ON) PG8_MMA(1, 1, At, B1); PG8_BAR; PG8_SCHED; \
        }
    for (;;) {
        const bool has_next = S.next(ui + 1, nxt);
        const char* nA = has_next ? (const char*)g.A + (size_t)nxt.pm * tstepA + (size_t)nxt.pn * g.apn + PG8_KO(nxt) : cA;
        const char* nB = has_next ? (const char*)g.Bt + (size_t)nxt.pn * tstepB + ((HT && nxt.half > 0) ? hstepB : 0) + PG8_KO(nxt) : cB;
        const size_t nhB = has_next ? ((HT && nxt.half >= 0) ? 0 : hstepB) : hBc;
        if (HT && cur.half >= 0) { PG8_KBODY(false) } else { PG8_KBODY(true) }
        if (wr == 0) PG8_BAR;
        E.run(acc, cur, wr, wc, fr, fq, (const LAS float*)(lds + EPI_LDS + (ui & 1) * 2048));
        if (!has_next) break;
#pragma unroll
        for (int a = 0; a < 2; ++a)
#pragma unroll
            for (int b = 0; b < 2; ++b)
#pragma unroll
                for (int m = 0; m < 4; ++m)
#pragma unroll
                    for (int n = 0; n < 2; ++n) acc[a][b][m][n] = (f32x4){0.f, 0.f, 0.f, 0.f};
        cur = nxt; cA = nA; cB = nB; hBc = nhB; ++ui; ntc = PG8_NT(cur);
        PG8_PREF(cur);
        if (wr == 1) PG8_BAR;
    }
    PG8_WAIT_V(0);
    PG8_BAR;
#undef PG8_KBODY
#undef PG8_NT
#undef PG8_KO
#undef PG8_PREF
#undef PG8_SA
#undef PG8_SB
#undef PG8_STAGE
#undef PG8_LDA
#undef PG8_LDB
#undef PG8_MMA
#undef PG8_WAIT_V
#undef PG8_WAIT_L
#undef PG8_BAR
#undef PG8_SCHED
}
}

namespace att {
constexpr int NW = 8, QBLK = 32, KVBLK = 64;
constexpr float SCALE = 0.10206207261596575f;
constexpr float THR = 8.f;
constexpr size_t SHM_V = 16384, SHM_K = 16384, SHM_ATTN = 2 * SHM_V + 2 * SHM_K + NW * 64 * 4;
#define KSWZ(row, colB) ((row) * 256 + ((colB) ^ (((row) & 7) << 4)))
#define SBAR() __builtin_amdgcn_sched_barrier(0)
__device__ __forceinline__ int crow(int r, int hi) { return (r & 3) + 8 * (r >> 2) + 4 * hi; }
__device__ __forceinline__ void partialSM(f32x16& p0, f32x16& p1, float& m_reg, float& mn, float& alpha) {
  constexpr float C = SCALE * 1.4426950408889634f;
  float pmax = p0[0];
#pragma unroll
  for (int r = 1; r < 16; ++r) pmax = fmaxf(pmax, p0[r]);
#pragma unroll
  for (int r = 0; r < 16; ++r) pmax = fmaxf(pmax, p1[r]);
  { auto rr = __builtin_amdgcn_permlane32_swap(__float_as_uint(pmax), __float_as_uint(pmax), false, false);
    pmax = fmaxf(__uint_as_float(rr[0]), __uint_as_float(rr[1])); }
  if (__builtin_expect(__all(pmax - m_reg <= THR / SCALE), 1)) { mn = m_reg; alpha = 1.f; }
  else { mn = fmaxf(m_reg, pmax); alpha = __builtin_amdgcn_exp2f((m_reg - mn) * C); m_reg = mn; }
  float mnC = -mn * C;
#pragma unroll
  for (int r = 0; r < 16; ++r) p0[r] = fmaf(p0[r], C, mnC);
#pragma unroll
  for (int r = 0; r < 16; ++r) p1[r] = fmaf(p1[r], C, mnC);
#pragma unroll
  for (int r = 0; r < 16; ++r) p0[r] = __builtin_amdgcn_exp2f(p0[r]);
}
__device__ __forceinline__ void finishSM(f32x16& p0, f32x16& p1, float alpha, float& l_reg, bf16x8& pa0, bf16x8& pa1, bf16x8& pa2, bf16x8& pa3) {
#pragma unroll
  for (int r = 0; r < 16; ++r) p1[r] = __builtin_amdgcn_exp2f(p1[r]);
  float ps = 0;
#pragma unroll
  for (int r = 0; r < 16; ++r) ps += p0[r];
#pragma unroll
  for (int r = 0; r < 16; ++r) ps += p1[r];
  { auto rr = __builtin_amdgcn_permlane32_swap(__float_as_uint(ps), __float_as_uint(ps), false, false);
    ps = __uint_as_float(rr[0]) + __uint_as_float(rr[1]); }
  l_reg = l_reg * alpha + ps;
#define PK4(P, BASE, OUT) do { unsigned a0 = cvt_pk_bf16(P[BASE + 0], P[BASE + 1]), a1 = cvt_pk_bf16(P[BASE + 2], P[BASE + 3]);   \
    unsigned b0 = cvt_pk_bf16(P[BASE + 4], P[BASE + 5]), b1 = cvt_pk_bf16(P[BASE + 6], P[BASE + 7]);                              \
    auto r0 = __builtin_amdgcn_permlane32_swap(a0, b0, false, false); auto r1 = __builtin_amdgcn_permlane32_swap(a1, b1, false, false); \
    u32x4 w = {r0[0], r1[0], r0[1], r1[1]}; OUT = *reinterpret_cast<bf16x8*>(&w); } while (0)
  PK4(p0, 0, pa0); PK4(p0, 8, pa1); PK4(p1, 0, pa2); PK4(p1, 8, pa3);
#undef PK4
}
__device__ __forceinline__ void qkt(f32x16& p0, f32x16& p1, const char* Ks, const bf16x8* qr, int r32, int hi) {
  p0 = f32x16{}; p1 = f32x16{};
#pragma unroll
  for (int d0 = 0; d0 < 6; ++d0) { int cb = (d0 * 16 + hi * 8) * 2;
    bf16x8 b0 = *reinterpret_cast<const bf16x8*>(Ks + KSWZ(r32, cb));
    bf16x8 b1 = *reinterpret_cast<const bf16x8*>(Ks + KSWZ(32 + r32, cb));
    p0 = __builtin_amdgcn_mfma_f32_32x32x16_bf16(b0, qr[d0], p0, 0, 0, 0);
    p1 = __builtin_amdgcn_mfma_f32_32x32x16_bf16(b1, qr[d0], p1, 0, 0, 0); }
}
__device__ __forceinline__ int v_st(int k, int c) { const int kk = (k & ~0xC) | ((k & 4) << 1) | ((k & 8) >> 1); return ((kk >> 3) * 4 + (c >> 5)) * 512 + ((kk & 7) * 32 + (c & 31)) * 2; }
__device__ __forceinline__ int v_rd_base(int lane) { return ((lane & 3) << 3) | (((lane >> 2) & 3) << 6) | (((lane >> 4) & 1) << 5) | (((lane >> 5) & 1) << 8); }
constexpr int v_rd_off(int d0, int ks, int half) { return d0 * 512 + ks * 4096 + half * 2048; }
template <int OFF> __device__ __forceinline__ s16x4 tr_read(int vb) {
  s16x4 r; asm volatile("ds_read_b64_tr_b16 %0, %1 offset:%2" : "=&v"(r) : "v"(vb), "i"(OFF) : "memory"); return r;
}
template <int D0> __device__ __forceinline__ void pv_one(f32x16& od, int vb, bf16x8 pa0, bf16x8 pa1, bf16x8 pa2, bf16x8 pa3) {
  const s16x4 l0 = tr_read<v_rd_off(D0, 0, 0)>(vb), h0 = tr_read<v_rd_off(D0, 0, 1)>(vb), l1 = tr_read<v_rd_off(D0, 1, 0)>(vb), h1 = tr_read<v_rd_off(D0, 1, 1)>(vb);
  const s16x4 l2 = tr_read<v_rd_off(D0, 2, 0)>(vb), h2 = tr_read<v_rd_off(D0, 2, 1)>(vb), l3 = tr_read<v_rd_off(D0, 3, 0)>(vb), h3 = tr_read<v_rd_off(D0, 3, 1)>(vb);
  asm volatile("s_waitcnt lgkmcnt(0)" ::: "memory"); SBAR();
#define PK(L, H) (bf16x8){L[0], L[1], L[2], L[3], H[0], H[1], H[2], H[3]}
  od = __builtin_amdgcn_mfma_f32_32x32x16_bf16(pa0, PK(l0, h0), od, 0, 0, 0);
  od = __builtin_amdgcn_mfma_f32_32x32x16_bf16(pa1, PK(l1, h1), od, 0, 0, 0);
  od = __builtin_amdgcn_mfma_f32_32x32x16_bf16(pa2, PK(l2, h2), od, 0, 0, 0);
  od = __builtin_amdgcn_mfma_f32_32x32x16_bf16(pa3, PK(l3, h3), od, 0, 0, 0);
#undef PK
}
__device__ __forceinline__ void pv_d0(f32x16* o, int vb, bf16x8 pa0, bf16x8 pa1, bf16x8 pa2, bf16x8 pa3) {
  pv_one<0>(o[0], vb, pa0, pa1, pa2, pa3); pv_one<1>(o[1], vb, pa0, pa1, pa2, pa3);
}
__device__ __forceinline__ void attn_unit(const bf16_t* __restrict__ Qb, const bf16_t* __restrict__ Kh, const bf16_t* __restrict__ Vh,
                                          bf16_t* __restrict__ Ob, int seq, char* lds) {
  int tid = threadIdx.x; asm volatile("" : "+v"(tid));
  const int wid = tid >> 6, lane = tid & 63, r32 = lane & 31, hi = lane >> 5;
  char* V_lds = lds; char* K_lds = lds + 2 * SHM_V;
  float* ws = (float*)(lds + 2 * SHM_V + 2 * SHM_K) + wid * 64; float* li_l = ws; float* al_l = ws + 32;
  float m_reg = -1e30f, l_reg = 0; f32x16 o[2] = {}; bf16x8 qr[6];
  const bf16_t* Qw = Qb + (long)(wid * QBLK + r32) * QLD + hi * 8;
#pragma unroll
  for (int d0 = 0; d0 < 6; ++d0) qr[d0] = *reinterpret_cast<const bf16x8*>(Qw + d0 * 16);
  const bool kld = wid < 6;
  const int ksr = tid / 12, ksc = (tid - ksr * 12) * 8;
  const int vsr = tid >> 3, vsc = (tid & 7) * 8, vst0 = v_st(vsr, vsc);
  const int vb0 = (int)(uintptr_t)V_lds + v_rd_base(lane);
  struct { bf16x8 vs0, ks0, ks1; } sr_[2];
#define SLOAD(i, k0) do { sr_[i].vs0 = *reinterpret_cast<const bf16x8*>(&Vh[(long)((k0) + vsr) * QLD + vsc]); \
    if (kld) { sr_[i].ks0 = *reinterpret_cast<const bf16x8*>(&Kh[(long)((k0) + ksr) * QLD + ksc]); sr_[i].ks1 = *reinterpret_cast<const bf16x8*>(&Kh[(long)((k0) + 32 + ksr) * QLD + ksc]); } } while (0)
#define SWRITE(b, i) do { *(bf16x8*)(V_lds + (b) * SHM_V + vst0) = sr_[i].vs0; \
    if (kld) { int kc = ksc * 2; *(bf16x8*)(K_lds + (b) * SHM_K + KSWZ(ksr, kc)) = sr_[i].ks0; *(bf16x8*)(K_lds + (b) * SHM_K + KSWZ(32 + ksr, kc)) = sr_[i].ks1; } } while (0)
#define SWAIT() asm volatile("s_waitcnt vmcnt(3)" ::: "memory")
#define RESC(a) do { if (__any((a) < 1.f)) { if (hi == 0) al_l[r32] = (a); asm volatile("s_waitcnt lgkmcnt(0)" ::: "memory"); \
    _Pragma("unroll") for (int d = 0; d < 2; ++d) _Pragma("unroll") for (int r = 0; r < 16; ++r) o[d][r] *= al_l[crow(r, hi)]; } } while (0)
  f32x16 pA0, pA1, pB0, pB1; float mnA, mnB, alA, alB; bf16x8 pa0, pa1, pa2, pa3; const int NT = seq / KVBLK;
  constexpr int SE = 0, SO = 1;
  SLOAD(SE, 0); asm volatile("s_waitcnt vmcnt(0)" ::: "memory"); SWRITE(0, SE); __syncthreads();
  qkt(pA0, pA1, K_lds, qr, r32, hi); partialSM(pA0, pA1, m_reg, mnA, alA);
  SLOAD(SO, KVBLK); if (2 < NT) SLOAD(SE, 2 * KVBLK);
  SWAIT(); SWRITE(1, SO); __syncthreads();
  for (int j = 1; j + 1 < NT; j += 2) {
    SBAR(); qkt(pB0, pB1, K_lds + SHM_K, qr, r32, hi);
    finishSM(pA0, pA1, alA, l_reg, pa0, pa1, pa2, pa3); SBAR();
    SLOAD(SO, (j + 2) * KVBLK); SBAR();
    pv_d0(o, vb0, pa0, pa1, pa2, pa3); partialSM(pB0, pB1, m_reg, mnB, alB);
    __syncthreads(); SWAIT(); SWRITE(0, SE);
    RESC(alB); __syncthreads();
    SBAR(); qkt(pA0, pA1, K_lds, qr, r32, hi);
    finishSM(pB0, pB1, alB, l_reg, pa0, pa1, pa2, pa3); SBAR();
    if (j + 3 < NT) SLOAD(SE, (j + 3) * KVBLK); SBAR();
    pv_d0(o, vb0 + (int)SHM_V, pa0, pa1, pa2, pa3); partialSM(pA0, pA1, m_reg, mnA, alA);
    __syncthreads(); SWAIT(); SWRITE(1, SO);
    RESC(alA); __syncthreads();
  }
  SBAR(); qkt(pB0, pB1, K_lds + SHM_K, qr, r32, hi);
  finishSM(pA0, pA1, alA, l_reg, pa0, pa1, pa2, pa3); SBAR();
  pv_d0(o, vb0, pa0, pa1, pa2, pa3); partialSM(pB0, pB1, m_reg, mnB, alB);
  __syncthreads(); RESC(alB);
  finishSM(pB0, pB1, alB, l_reg, pa0, pa1, pa2, pa3); SBAR();
  pv_d0(o, vb0 + (int)SHM_V, pa0, pa1, pa2, pa3);
  if (hi == 0) li_l[r32] = l_reg; asm volatile("s_waitcnt lgkmcnt(0)" ::: "memory");
  bf16_t* Ow = Ob + (long)(wid * QBLK) * 1024;
#pragma unroll
  for (int r = 0; r < 16; ++r) { const int orow = crow(r, hi); const float rl = __builtin_amdgcn_rcpf(li_l[orow]);
#pragma unroll
    for (int d0 = 0; d0 < 2; ++d0) Ow[(long)orow * 1024 + d0 * 32 + r32] = (bf16_t)(cvt_pk_bf16(o[d0][r] * rl, 0.f) & 0xffffu); }
#undef SLOAD
#undef SWRITE
#undef SWAIT
#undef RESC
}
}


#define XB_TMO      128
#define XB_XCNT(j)  (256  + 64 * (j))
#define XB_XSUB(j)  (1280 + 64 * (j))
#define XB_XGEN(j)  (2304 + 64 * (j))
#define XB_TOP      3328
#define XB_TOPGEN   3392
#define XCD_BAR_WORDS 3456
#define XB_SPIN_CAP (1u << 20)
__device__ __forceinline__ unsigned xb_ld(unsigned* p)              { return __hip_atomic_load(p, __ATOMIC_RELAXED, __HIP_MEMORY_SCOPE_AGENT); }
__device__ __forceinline__ unsigned xb_add(unsigned* p, unsigned v) { return __hip_atomic_fetch_add(p, v, __ATOMIC_RELAXED, __HIP_MEMORY_SCOPE_AGENT); }
__device__ __forceinline__ unsigned xb_xcc_id() { return (unsigned)__builtin_amdgcn_s_getreg((3 << 11) | 20) & 0xFu; }
#define XB_SPIN(cond, bar) do { unsigned _sp = 0; while (cond) { __builtin_amdgcn_s_sleep(1); \
    if ((++_sp & 255u) == 0u) { if (xb_ld(&(bar)[XB_TMO])) break; if (_sp > XB_SPIN_CAP) { atomicAdd(&(bar)[XB_TMO], 1u); break; } } } } while (0)
struct XcdBarrier { unsigned* bar; unsigned x; volatile LAS unsigned* st; };
__device__ __forceinline__ XcdBarrier xcd_barrier_post(unsigned* bar, volatile LAS unsigned* st) {
    XcdBarrier b; b.bar = bar; b.x = xb_xcc_id(); b.st = st;
    if (threadIdx.x == 0) (void)xb_add(&bar[XB_XCNT(b.x)], 1u);
    return b;
}
__device__ __forceinline__ void xcd_barrier_complete(unsigned* bar, unsigned x, unsigned& nloc, unsigned& nx) {
    const unsigned G = gridDim.x * gridDim.y * gridDim.z;
    unsigned sum, cnt, mine, sp = 0u;
    for (;;) {
        sum = 0u; cnt = 0u; mine = 0u;
#pragma unroll
        for (unsigned j = 0; j < 16; ++j) { const unsigned c = xb_ld(&bar[XB_XCNT(j)]); sum += c; cnt += (c > 0u) ? 1u : 0u; mine = (j == x) ? c : mine; }
        if (sum == G) break;
        __builtin_amdgcn_s_sleep(1);
        if ((++sp & 255u) == 0u) { if (xb_ld(&bar[XB_TMO])) break; if (sp > XB_SPIN_CAP) { atomicAdd(&bar[XB_TMO], 1u); break; } }
    }
    nloc = mine > 0u ? mine : 1u; nx = cnt > 0u ? cnt : 1u;
}
__device__ __forceinline__ void xcd_barrier(const XcdBarrier& b) {
    asm volatile("s_waitcnt vmcnt(0)" ::: "memory");
    __syncthreads();
    if (threadIdx.x == 0) {
        unsigned* bar = b.bar;
        __builtin_amdgcn_s_waitcnt(0);
        unsigned nloc = b.st[0], nx = b.st[1];
        if (nloc == 0u) { xcd_barrier_complete(bar, b.x, nloc, nx); b.st[0] = nloc; b.st[1] = nx; }
        const unsigned old = xb_add(&bar[XB_XSUB(b.x)], 1u);
        const unsigned gen = old / nloc;
        if (old + 1u == (gen + 1u) * nloc) {
            __builtin_amdgcn_fence(__ATOMIC_RELEASE, "agent");
            asm volatile("s_waitcnt vmcnt(0)" ::: "memory");
            const unsigned og = xb_add(&bar[XB_TOP], 1u);
            const unsigned tg = og / nx;
            if (og + 1u == (tg + 1u) * nx) xb_add(&bar[XB_TOPGEN], 1u);
            else XB_SPIN(xb_ld(&bar[XB_TOPGEN]) == tg, bar);
            __builtin_amdgcn_fence(__ATOMIC_ACQUIRE, "agent");
            xb_add(&bar[XB_XGEN(b.x)], 1u);
            asm volatile("s_waitcnt vmcnt(0)" ::: "memory");
        } else {
            XB_SPIN(xb_ld(&bar[XB_XGEN(b.x)]) == gen, bar);
            __builtin_amdgcn_fence(__ATOMIC_ACQUIRE, "agent");
            asm volatile("s_waitcnt vmcnt(0)" ::: "memory");
        }
    }
    __syncthreads();
}

constexpr int LDS_BYTES = 139264;
struct Args { const float* in[25]; float* out; unsigned char* ws; int ph_lo, ph_hi; };

__device__ __forceinline__ void tr_item(const float* W, int ldw, bf16_t* dst, int ldd, LAS float* scr, int lane) {
    float tv[32];
#pragma unroll
    for (int i = 0; i < 32; ++i) tv[i] = W[(size_t)(2 * i + (lane >> 5)) * ldw + (lane & 31)];
#pragma unroll
    for (int i = 0; i < 32; ++i) scr[(2 * i + (lane >> 5)) * 33 + (lane & 31)] = tv[i];
    asm volatile("s_waitcnt lgkmcnt(0)" ::: "memory");
    const int c = lane & 7;
#pragma unroll
    for (int j = 0; j < 4; ++j) { const int n = (lane >> 3) + 8 * j; const LAS float* s = scr + (8 * c) * 33 + n;
        u32x4 o; o.x = cvt_pk_bf16(s[0 * 33], s[1 * 33]); o.y = cvt_pk_bf16(s[2 * 33], s[3 * 33]); o.z = cvt_pk_bf16(s[4 * 33], s[5 * 33]); o.w = cvt_pk_bf16(s[6 * 33], s[7 * 33]);
        *(u32x4*)(dst + (size_t)n * ldd + 8 * c) = o; }
    asm volatile("s_waitcnt lgkmcnt(0)" ::: "memory");
}


struct P2Row { f32x4 q[3], k[3]; u32x2 v[2]; int kind, t, e; };
__device__ __forceinline__ f32x4 ld_bf4(const bf16_t* p) { const u32x2 w = *(const u32x2*)p; return (f32x4){bflo(w.x), bfhi(w.x), bflo(w.y), bfhi(w.y)}; }
__device__ __forceinline__ void p2_load(P2Row& r, int e, int j, int hh, int s, const bf16_t* QKV, const float* KROPE, const float* cache_kr) {
    const float* krp; r.e = e; r.t = 0;
    if (e < NCTX) { r.kind = 0; krp = KROPE + (size_t)e * 32; }
    else { const int b = (e - NCTX) / KVB, tt = (e - NCTX) - b * KVB;
        if (tt < LLAT) { r.kind = 1; r.t = tt; krp = KROPE + (size_t)(NCTX + b * LLAT + tt) * 32; }
        else { r.kind = 2; krp = cache_kr + (((size_t)b * 2 + j) * 512 + (tt - LLAT)) * 32; } }
    const bf16_t* raw = QKV + (size_t)e * QLD;
#pragma unroll
    for (int jj = 0; jj < 3; ++jj) r.q[jj] = ld_bf4(raw + hh * 96 + 4 * (s + 8 * jj));
#pragma unroll
    for (int jj = 0; jj < 2; ++jj) { r.k[jj] = ld_bf4(raw + 768 + hh * 128 + 4 * (s + 8 * jj)); r.v[jj] = *(const u32x2*)(raw + 768 + hh * 128 + 64 + 4 * (s + 8 * jj)); }
    r.k[2] = *(const f32x4*)(krp + 4 * s);
}
__device__ __forceinline__ void p2_compute(P2Row& r, int s, const float* qn, const float* kn, const float* ROPE) {
    float sq = 0.f, sk = 0.f;
#pragma unroll
    for (int jj = 0; jj < 3; ++jj) { sq += (r.q[jj][0] * r.q[jj][0] + r.q[jj][1] * r.q[jj][1]) + (r.q[jj][2] * r.q[jj][2] + r.q[jj][3] * r.q[jj][3]);
                                     sk += (r.k[jj][0] * r.k[jj][0] + r.k[jj][1] * r.k[jj][1]) + (r.k[jj][2] * r.k[jj][2] + r.k[jj][3] * r.k[jj][3]); }
    sq += __shfl_xor(sq, 1); sq += __shfl_xor(sq, 2); sq += __shfl_xor(sq, 4);
    sk += __shfl_xor(sk, 1); sk += __shfl_xor(sk, 2); sk += __shfl_xor(sk, 4);
    const float rq = 1.0f / sqrtf(sq * (1.0f / 96.0f) + EPS), rk = 1.0f / sqrtf(sk * (1.0f / 96.0f) + EPS);
#pragma unroll
    for (int jj = 0; jj < 3; ++jj) { r.q[jj] = r.q[jj] * rq * *(const f32x4*)(qn + 4 * (s + 8 * jj)); r.k[jj] = r.k[jj] * rk * *(const f32x4*)(kn + 4 * (s + 8 * jj)); }
    f32x4 qp, kp;
#pragma unroll
    for (int c = 0; c < 4; ++c) { qp[c] = __shfl_xor(r.q[2][c], 2); kp[c] = __shfl_xor(r.k[2][c], 2); }
    if (r.kind == 1) {
        const int a = s >> 2, fi0 = (s & 1) * 4; const bool second = (s & 2) != 0;
        const f32x4 cs = *(const f32x4*)(ROPE + (size_t)r.t * 16 + a * 8 + fi0), sn = *(const f32x4*)(ROPE + 65536 + (size_t)r.t * 16 + a * 8 + fi0);
        if (!second) { r.q[2] = r.q[2] * cs - qp * sn; r.k[2] = r.k[2] * cs - kp * sn; }
        else { r.q[2] = qp * sn + r.q[2] * cs; r.k[2] = kp * sn + r.k[2] * cs; }
    }
}
__device__ __forceinline__ void p2_store(const P2Row& r, int hh, int s, bf16_t* QKV) {
    bf16_t* orow = QKV + (size_t)r.e * QLD;
#pragma unroll
    for (int jj = 0; jj < 3; ++jj) {
        if (r.kind != 2) { u32x2 w; w.x = cvt_pk_bf16(r.q[jj][0], r.q[jj][1]); w.y = cvt_pk_bf16(r.q[jj][2], r.q[jj][3]); *(u32x2*)(orow + hh * 96 + 4 * (s + 8 * jj)) = w; }
        u32x2 w2; w2.x = cvt_pk_bf16(r.k[jj][0], r.k[jj][1]); w2.y = cvt_pk_bf16(r.k[jj][2], r.k[jj][3]); *(u32x2*)(orow + 768 + hh * 96 + 4 * (s + 8 * jj)) = w2; }
#pragma unroll
    for (int jj = 0; jj < 2; ++jj) *(u32x2*)(orow + 1536 + hh * 64 + 4 * (s + 8 * jj)) = r.v[jj];
}
struct P1Row { f32x4 q4, k4, r4; };
__device__ __forceinline__ void p1_load(P1Row& p, const float* pr, int lane) {
    p.q4 = *(const f32x4*)(pr + 4 * lane);
    p.k4 = (f32x4){0.f, 0.f, 0.f, 0.f}; if (lane < 32) p.k4 = *(const f32x4*)(pr + 256 + 4 * lane);
    p.r4 = (f32x4){0.f, 0.f, 0.f, 0.f}; if (lane < 8) p.r4 = *(const f32x4*)(pr + 384 + 4 * lane);
}
__device__ __forceinline__ void p1_finish(const P1Row& p, int r, int j, int lane, const float* qan, const float* kvan, bf16_t* QKVLAT, float* KROPE, float* OUT_CKV, float* OUT_KR) {
    const int e = r < NCTX ? r : NCTX + ((r - NCTX) >> 12) * KVB + ((r - NCTX) & 4095);
    const float ssq = wave_sum((p.q4[0] * p.q4[0] + p.q4[1] * p.q4[1]) + (p.q4[2] * p.q4[2] + p.q4[3] * p.q4[3]));
    const float ssk = wave_sum((p.k4[0] * p.k4[0] + p.k4[1] * p.k4[1]) + (p.k4[2] * p.k4[2] + p.k4[3] * p.k4[3]));
    const float rq = 1.0f / sqrtf(ssq * (1.0f / 256.0f) + EPS), rk = 1.0f / sqrtf(ssk * (1.0f / 128.0f) + EPS);
    const f32x4 qo = p.q4 * rq * *(const f32x4*)(qan + 4 * lane);
    u32x2 w; w.x = cvt_pk_bf16(qo[0], qo[1]); w.y = cvt_pk_bf16(qo[2], qo[3]); *(u32x2*)(QKVLAT + (size_t)e * 384 + 4 * lane) = w;
    if (lane < 32) { const f32x4 ko = p.k4 * rk * *(const f32x4*)(kvan + 4 * lane); u32x2 w2; w2.x = cvt_pk_bf16(ko[0], ko[1]); w2.y = cvt_pk_bf16(ko[2], ko[3]);
        *(u32x2*)(QKVLAT + (size_t)e * 384 + 256 + 4 * lane) = w2;
        if (r < NCTX) *(f32x4*)(OUT_CKV + (((size_t)(r >> 8) * 2 + j) * 256 + (r & 255)) * 128 + 4 * lane) = ko; }
    if (lane < 8) { *(f32x4*)(KROPE + (size_t)r * 32 + 4 * lane) = p.r4;
        if (r < NCTX) *(f32x4*)(OUT_KR + (((size_t)(r >> 8) * 2 + j) * 256 + (r & 255)) * 32 + 4 * lane) = p.r4; }
}

#define DERIVE_PTRS \
    unsigned char* ws = args.ws; \
    float* X = args.out; \
    float* OUT_CKV = args.out + (size_t)MTOK * 1024; float* OUT_KR = OUT_CKV + (size_t)32 * 2 * 256 * 128; \
    bf16_t* W13 = (bf16_t*)(ws + OFF_W13); bf16_t* W2 = (bf16_t*)(ws + OFF_W2); bf16_t* WIN = (bf16_t*)(ws + OFF_WIN); bf16_t* WQKV = (bf16_t*)(ws + OFF_WQKV); \
    bf16_t* WOUT = (bf16_t*)(ws + OFF_WOUT); bf16_t* POOLT = (bf16_t*)(ws + OFF_POOLT); bf16_t* WSB = (bf16_t*)(ws + OFF_WS); \
    float* MOD = (float*)(ws + OFF_MOD); float* ROPE = (float*)(ws + OFF_ROPE); \
    bf16_t* H = (bf16_t*)(ws + OFF_H); bf16_t* MIX = H; \
    unsigned char* R = ws + OFF_R; \
    bf16_t* U = (bf16_t*)(R + R_U); bf16_t* PB = (bf16_t*)R; bf16_t* H2 = (bf16_t*)R; \
    float* RSS = (float*)(ws + OFF_RSS); float* B13 = (float*)(ws + OFF_B13); float* BIN = (float*)(ws + OFF_BIN); \
    bf16_t* QKVLAT = (bf16_t*)(R + R_QKVLAT); float* KROPE = (float*)(R + R_KROPE); float* PROJ = (float*)(R + R_PROJ); \
    bf16_t* GM = (bf16_t*)(R + R_GM); float* QKVRAW = (float*)(R + R_QKVRAW); bf16_t* QKV = (bf16_t*)(R + R_QKVRAW);

__global__ void __launch_bounds__(512, 2) fwd_mega(Args args) {
    extern __shared__ __attribute__((aligned(16))) unsigned char lds[];
    cg::grid_group grid = cg::this_grid();
    int tid = threadIdx.x, lane = tid & 63, wave = __builtin_amdgcn_readfirstlane(tid >> 6);
    const int G = gridDim.x, bid = blockIdx.x;
    int gw = bid * 8 + wave; const int NGW = G * 8;
    long gt = (long)bid * 512 + tid; const long NGT = (long)G * 512;
    const int lo = args.ph_lo, hi = args.ph_hi;
    int pid = 0;
    unsigned* BARW = (unsigned*)(args.ws + OFF_CTL);
    volatile LAS unsigned* MISC = (volatile LAS unsigned*)((LAS unsigned char*)lds + 131072);
    if (tid < 16) MISC[tid] = 0u;
    if (bid == 0) for (int i = tid; i < XCD_BAR_WORDS; i += 512) BARW[i] = 0u;
    __syncthreads();
    XcdBarrier xbar; xbar.bar = BARW; xbar.x = 0; xbar.st = MISC;

    for (int rep0 = 0; rep0 < ((DUPMASK & 1) ? 2 : 1); ++rep0)
    if (EN_PRO && pid >= lo && pid < hi) {
        DERIVE_PTRS
        if (bid < 288) {
            LAS float* S = (LAS float*)lds; LAS float* P = (LAS float*)(lds + 36864);
            for (int idx = tid; idx < 9216; idx += 512) { const int cv = idx >> 10, k = idx & 1023; const float x = cv == 0 ? args.in[5][k] : args.in[4][(cv - 1) * 1024 + k]; S[idx] = x / (1.0f + expf(-x)); }
            __syncthreads();
            for (int item = bid; item < 288; item += G) {
                const int l = item / 72, cb = item % 72, j = tid & 127, s = tid >> 7;
                float acc[9];
#pragma unroll
                for (int cv = 0; cv < 9; ++cv) acc[cv] = 0.f;
                const float* wp = args.in[6] + ((size_t)l * 1024 + s * 256) * NMOD + cb * 128 + j;
                for (int k = 0; k < 256; k += 16) {
                    float wv[16];
#pragma unroll
                    for (int i = 0; i < 16; ++i) wv[i] = wp[(size_t)(k + i) * NMOD];
#pragma unroll
                    for (int cv = 0; cv < 9; ++cv) { const LAS float* sp = S + cv * 1024 + s * 256 + k;
#pragma unroll
                        for (int i = 0; i < 16; ++i) acc[cv] += sp[i] * wv[i]; }
                }
#pragma unroll
                for (int cv = 0; cv < 9; ++cv) P[(s * 9 + cv) * 128 + j] = acc[cv];
                __syncthreads();
                for (int idx = tid; idx < 1152; idx += 512) { const int cv = idx >> 7, jj = idx & 127;
                    const float v = P[(0 * 9 + cv) * 128 + jj] + P[(1 * 9 + cv) * 128 + jj] + P[(2 * 9 + cv) * 128 + jj] + P[(3 * 9 + cv) * 128 + jj] + args.in[7][l * NMOD + cb * 128 + jj];
                    MOD[((size_t)l * 9 + cv) * NMOD + cb * 128 + jj] = v; }
                __syncthreads();
            }
        }
        __syncthreads();
        {
            LAS float* scr = (LAS float*)(lds + 57344 + wave * 8448);
            for (int it0 = gw; it0 < 36832; it0 += NGW) {
                int it = it0; const float* src; int ldw, ldd; bf16_t* dst;
                if (it < 33792) { const int ls = it / 4224, r = it % 4224, which = r / 1408, q = r % 1408;
                    if (which < 2) { const int kb = q / 88, nb = q % 88, k0 = kb * 64, n0 = nb * 32; src = args.in[which ? 10 : 9] + (size_t)ls * 1024 * FF + (size_t)k0 * FF + n0; ldw = FF;
                        const int drow = (n0 >> 7) * 256 + (n0 & 127) + which * 128; dst = W13 + (size_t)ls * 5632 * 1024 + (size_t)drow * 1024 + k0; ldd = 1024; }
                    else { const int kb = q / 32, nb = q % 32, k0 = kb * 64, n0 = nb * 32; src = args.in[11] + (size_t)ls * FF * 1024 + (size_t)k0 * 1024 + n0; ldw = 1024;
                        dst = W2 + (size_t)ls * 1024 * FF + (size_t)n0 * FF + k0; ldd = FF; } }
                else { it -= 33792;
                if (it < 1440) { const int j = it / 720, q = it % 720, kb = q / 45, nb = q % 45, k0 = kb * 64, n0 = nb * 32; src = args.in[12] + (size_t)j * 1024 * 1440 + (size_t)k0 * 1440 + n0; ldw = 1440;
                    const int drow = n0 < 416 ? n0 : n0 + 96; dst = WIN + (size_t)j * 1536 * 1024 + (size_t)drow * 1024 + k0; ldd = 1024; }
                else { it -= 1440;
                if (it < 192) { const int j = it / 96, q = it % 96, kb = q / 24, nb = q % 24, k0 = kb * 64, n0 = nb * 32; src = args.in[15] + (size_t)j * 256 * 768 + (size_t)k0 * 768 + n0; ldw = 768;
                    dst = WQKV + (size_t)j * 1792 * 384 + (size_t)n0 * 384 + k0; ldd = 384; }
                else { it -= 192;
                if (it < 128) { const int j = it / 64, q = it % 64, kb = q / 32, nb = q % 32, k0 = kb * 64, n0 = nb * 32; src = args.in[16] + (size_t)j * 128 * 1024 + (size_t)k0 * 1024 + n0; ldw = 1024;
                    dst = WQKV + (size_t)j * 1792 * 384 + (size_t)(768 + n0) * 384 + 256 + k0; ldd = 384; }
                else { it -= 128;
                if (it < 1024) { const int j = it / 512, q = it % 512, kb = q / 32, nb = q % 32, k0 = kb * 64, n0 = nb * 32; src = args.in[22] + (size_t)j * 1024 * 1024 + (size_t)k0 * 1024 + n0; ldw = 1024;
                    dst = WOUT + (size_t)j * 1024 * 1024 + (size_t)n0 * 1024 + k0; ldd = 1024; }
                else { it -= 1024;
                    const int jg = it / 32, q = it % 32, kb = q / 8, nb = q % 8, k0 = kb * 64, n0 = nb * 32; src = args.in[23] + (size_t)jg * 65536 + (size_t)k0 * 256 + n0; ldw = 256;
                    dst = POOLT + (size_t)jg * 65536 + (size_t)n0 * 256 + k0; ldd = 256; } } } } }
                tr_item(src, ldw, dst, ldd, scr, lane);
            }
        }
        {
            const u32x4 z = {0u, 0u, 0u, 0u};
            for (long i = gt; i < 2 * 12288; i += NGT) { const int j = (int)(i / 12288); const long q = i % 12288; *(u32x4*)(WIN + (size_t)j * 1536 * 1024 + (size_t)416 * 1024 + q * 8) = z; }
            for (long i = gt; i < 2 * 45056; i += NGT) { const int j = (int)(i / 45056); const long q = i % 45056; bf16_t* base = WQKV + (size_t)j * 1792 * 384;
                if (q < 12288) { const int row = (int)(q >> 4), c = (int)(q & 15); *(u32x4*)(base + (size_t)row * 384 + 256 + c * 8) = z; }
                else { const long q2 = q - 12288; const int row = 768 + (int)(q2 >> 5), c = (int)(q2 & 31); *(u32x4*)(base + (size_t)row * 384 + c * 8) = z; } }
        }
        for (long i = gt; i < 131072 / 4; i += NGT) { const f32x4 v = *(const f32x4*)(args.in[20] + i * 4); u32x2 w; w.x = cvt_pk_bf16(v[0], v[1]); w.y = cvt_pk_bf16(v[2], v[3]); *(u32x2*)(WSB + i * 4) = w; }
        for (long i = gt; i < 65536; i += NGT) { const int t = (int)(i >> 4), ai = (int)(i & 15), a = ai >> 3, fi = ai & 7;
            const float inv = powf(10000.0f, -(float)(2 * fi) / 16.0f); const float pos = (float)(a == 0 ? (t >> 6) : (t & 63)); const float ang = pos * inv;
            ROPE[i] = cosf(ang); ROPE[65536 + i] = sinf(ang); }
        { const f32x4 z4 = {0.f, 0.f, 0.f, 0.f}; for (long i = gt; i < (long)12 * MTOK / 4; i += NGT) *(f32x4*)(RSS + i * 4) = z4; }
    }
    grid.sync();
    xbar = xcd_barrier_post(BARW, MISC);
    ++pid;
    for (int rep1 = 0; rep1 < ((DUPMASK & 2) ? 2 : 1); ++rep1)
    if (pid >= lo && pid < hi) {
        DERIVE_PTRS
        for (int it = gw; it < 8 * 5632 + 2 * 1536; it += NGW) {
            const bf16_t* wrow; const float* shp; float* outp; int cvs;
            if (it < 8 * 5632) { const int ls = it / 5632, n = it - ls * 5632, l = ls >> 1, sub = ls & 1; wrow = W13 + ((size_t)ls * 5632 + n) * 1024;
                shp = MOD + (size_t)l * 9 * NMOD + (sub ? 6 : 0) * 1024; outp = B13 + (size_t)ls * 9 * 5632 + n; cvs = 5632; }
            else { const int q = it - 8 * 5632, jj = q / 1536, n = q - jj * 1536; wrow = WIN + ((size_t)jj * 1536 + n) * 1024;
                shp = MOD + (size_t)(2 * jj) * 9 * NMOD + 3 * 1024; outp = BIN + (size_t)jj * 9 * 1536 + n; cvs = 1536; }
            const u32x4 w0 = *(const u32x4*)(wrow + lane * 8), w1 = *(const u32x4*)(wrow + 512 + lane * 8);
            float wv[16];
#pragma unroll
            for (int e = 0; e < 4; ++e) { wv[2 * e] = bflo(w0[e]); wv[2 * e + 1] = bfhi(w0[e]); wv[8 + 2 * e] = bflo(w1[e]); wv[8 + 2 * e + 1] = bfhi(w1[e]); }
            float res = 0.f;
#pragma unroll
            for (int cv = 0; cv < 9; ++cv) { const float* sp = shp + (size_t)cv * NMOD; float a = 0.f;
#pragma unroll
                for (int hf = 0; hf < 2; ++hf) { const f32x4 s0 = *(const f32x4*)(sp + hf * 512 + lane * 8), s1 = *(const f32x4*)(sp + hf * 512 + lane * 8 + 4);
                    a += (s0[0] * wv[hf * 8 + 0] + s0[1] * wv[hf * 8 + 1]) + (s0[2] * wv[hf * 8 + 2] + s0[3] * wv[hf * 8 + 3]) + (s1[0] * wv[hf * 8 + 4] + s1[1] * wv[hf * 8 + 5]) + (s1[2] * wv[hf * 8 + 6] + s1[3] * wv[hf * 8 + 7]); }
                a = wave_sum(a); if (lane == cv) res = a; }
            if (lane < 9) outp[(size_t)lane * cvs] = res;
        }
        for (int rb = gw; rb < MTOK; rb += 2 * NGW) {
            f32x4 v[2][4]; float ss[2]; int rr[2];
#pragma unroll
            for (int u2 = 0; u2 < 2; ++u2) { const int r = (rb + u2 * NGW < MTOK) ? rb + u2 * NGW : rb; rr[u2] = r;
                const float* xr = r < NCTX ? args.in[0] + (size_t)r * 1024 : args.in[1] + (size_t)(r - NCTX) * 1024; ss[u2] = 0.f;
#pragma unroll
                for (int q = 0; q < 4; ++q) { v[u2][q] = *(const f32x4*)(xr + 4 * lane + 256 * q); ss[u2] += (v[u2][q][0] * v[u2][q][0] + v[u2][q][1] * v[u2][q][1]) + (v[u2][q][2] * v[u2][q][2] + v[u2][q][3] * v[u2][q][3]); } }
#pragma unroll
            for (int u2 = 0; u2 < 2; ++u2) { if (u2 == 1 && rb + NGW >= MTOK) break; const int r = rr[u2]; const int cv = cv_of_row(r);
                const float* scp = MOD + (size_t)cv * NMOD + 1024; const float* gptr = args.in[8];
                const float st = wave_sum(ss[u2]); if (lane == 0) RSS[r] = st;
#pragma unroll
                for (int q = 0; q < 4; ++q) { const int c = 4 * lane + 256 * q; const f32x4 g4 = *(const f32x4*)(gptr + c), sc = *(const f32x4*)(scp + c);
                    *(f32x4*)(X + (size_t)r * 1024 + c) = v[u2][q];
                    const f32x4 hh = v[u2][q] * g4 * (sc + 1.0f); u32x2 w; w.x = cvt_pk_bf16(hh[0], hh[1]); w.y = cvt_pk_bf16(hh[2], hh[3]);
                    *(u32x2*)(H + (size_t)r * 1024 + c) = w; } }
        }
        if (pid + 1 < hi) xcd_barrier(xbar);
    }
    ++pid;

    for (int layer = 0; layer < 4; ++layer) {
        const int j = layer >> 1;
        const unsigned long long prog = (layer & 1) ? 0xDCFE32ull : 0xDCA9876532ull;
        const int nsteps = (layer & 1) ? 6 : 10;
        for (int step = 0; step < nsteps; ++step, ++pid) {
            if (!(pid >= lo && pid < hi)) continue;
            const int op = (int)((prog >> (4 * step)) & 15ull);
            const int reps = ((DUPMASK >> op) & 1) ? 2 : 1;
            for (int rep = 0; rep < reps; ++rep) {
            DERIVE_PTRS
            int bid = blockIdx.x; asm volatile("" : "+s"(bid)); int G = gridDim.x; asm volatile("" : "+s"(G));
            const int NGW = G * 8; const long NGT = (long)G * 512;
            const float* MODL = MOD + (size_t)layer * 9 * NMOD;
            tid = threadIdx.x; asm volatile("" : "+v"(tid)); lane = tid & 63; wave = __builtin_amdgcn_readfirstlane(tid >> 6); gw = bid * 8 + wave; gt = (long)bid * 512 + tid;
            if (EN_G1 && (op == 2 || op == 12)) {
                const int sub = op == 2 ? 0 : 1;
                const bf16_t* Ain = (sub == 1 && !(layer & 1)) ? H2 : H;
                pg8::Gemm g{Ain, W13 + (size_t)(layer * 2 + sub) * 5632 * 1024, MTOK, 5632, 1024, 1024, 1024, 0, 0, 0};
                pg8::StaticOrder S; S.init(MTOK, 5632, G, bid);
                pg8::EpiSwiglu E{U, RSS + (size_t)(layer * 3 + (sub ? 2 : 0)) * MTOK, B13 + (size_t)(layer * 2 + sub) * 9 * 5632};
                pg8::gemm_phase<pg8::EpiSwiglu>((LAS unsigned char*)lds, g, S, E);
            } else if (EN_GRES && (op == 3 || op == 13 || op == 10 || op == 15)) {
                const bf16_t* gA; const bf16_t* gB; int gK, glda, gldb, gapn; const float* egate; const float* escale; float ecoef;
                if (op == 3 || op == 13) { const int sub = op == 3 ? 0 : 1; gA = U; gB = W2 + (size_t)(layer * 2 + sub) * 1024 * FF; gK = FF; glda = FF; gldb = FF; gapn = 0;
                    egate = MODL + (sub ? 8 : 2) * 1024; escale = nullptr; ecoef = 0.5f; }
                else if (op == 10) { gA = MIX; gB = WOUT + (size_t)j * 1024 * 1024; gK = 1024; glda = 1024; gldb = 1024; gapn = 0; egate = MODL + 5 * 1024; escale = nullptr; ecoef = 1.0f; }
                else { gA = PB; gB = POOLT + (size_t)j * 1024 * 256; gK = 256; glda = 1024; gldb = 256; gapn = 512; egate = MODL + 5 * 1024; escale = args.in[24] + (size_t)j * 1024; ecoef = 1.0f; }
                int ln = layer, kn; bf16_t* an = H;
                if (op == 3) kn = 1; else if (op == 13) { ln = layer + 1; kn = 0; } else { kn = 2; if (op == 10) an = H2; }
                if (ln >= 4) { an = nullptr; ln = 0; }
                const pg8::Gemm g{gA, gB, MTOK, 1024, gK, glda, gldb, gapn, 0, 0};
                const pg8::EpiResid E{X, egate, escale, an, args.in[8] + ((size_t)ln * 3 + kn) * 1024, MOD + (size_t)ln * 9 * NMOD + (3 * kn + 1) * 1024, RSS + (size_t)(ln * 3 + kn) * MTOK, ecoef, 0};
                pg8::StaticOrder S; S.init(MTOK, 1024, G, bid, 1);
                pg8::gemm_phase<pg8::EpiResid, true>((LAS unsigned char*)lds, g, S, E);
            } else if (EN_GRAW && (op == 5 || op == 7)) {
                const bool gin = op == 5;
                const pg8::Gemm g{gin ? (const bf16_t*)H : (const bf16_t*)QKVLAT, gin ? WIN + (size_t)j * 1536 * 1024 : WQKV + (size_t)j * 1792 * 384, gin ? MTOK : MEXT, gin ? 1536 : 1792, gin ? 1024 : 384, gin ? 1024 : 384, gin ? 1024 : 384, 0, gin ? 0 : 3, 0};
                const pg8::EpiRaw E{PROJ, gin ? GM : QKV, gin ? RSS + (size_t)(layer * 3 + 1) * MTOK : (const float*)nullptr, BIN + (size_t)j * 9 * 1536, 512, gin ? 2 : 0, gin ? 1024 : QLD, gin ? 1 : 0};
                pg8::StaticOrder S; S.init(gin ? MTOK : MEXT, gin ? 1536 : 1792, G, bid);
                pg8::gemm_phase<pg8::EpiRaw>((LAS unsigned char*)lds, g, S, E);
            } else if (EN_POST1 && op == 6) {
                {
                    LAS float* rs = (LAS float*)lds; LAS bf16_t* tT = (LAS bf16_t*)(lds + 1024);
                    const float* vn = args.in[19] + (size_t)j * 512; const float* gb = args.in[21] + (size_t)j * 512;
                    for (int item = bid; item < 1280; item += G) {
                        const int chunk = item >> 2, gq = item & 3; const size_t tok0 = (size_t)chunk * 128;
                        { u32x4 wv[16];
#pragma unroll
                          for (int tt = 0; tt < 16; ++tt) wv[tt] = *(const u32x4*)(GM + (tok0 + wave * 16 + tt) * 1024 + 512 + lane * 8);
#pragma unroll
                          for (int tt = 0; tt < 16; ++tt) { float ss = 0.f;
#pragma unroll
                            for (int e = 0; e < 4; ++e) { const float a = bflo(wv[tt][e]), b = bfhi(wv[tt][e]); ss += a * a + b * b; }
                            ss = wave_sum(ss); if (lane == 0) rs[wave * 16 + tt] = 1.0f / sqrtf(ss * (1.0f / 512.0f) + EPS); } }
                        __syncthreads();
                        { const int q = tid >> 2, cp = tid & 3; const float rq = rs[q];
#pragma unroll
                          for (int cc = 0; cc < 4; ++cc) { const int c0 = cp * 32 + cc * 8; const u32x4 w = *(const u32x4*)(GM + (tok0 + q) * 1024 + 512 + gq * 128 + c0);
                              const f32x4 n0 = *(const f32x4*)(vn + gq * 128 + c0), n1 = *(const f32x4*)(vn + gq * 128 + c0 + 4);
                              float v[8] = {bflo(w[0]) * n0[0], bfhi(w[0]) * n0[1], bflo(w[1]) * n0[2], bfhi(w[1]) * n0[3], bflo(w[2]) * n1[0], bfhi(w[2]) * n1[1], bflo(w[3]) * n1[2], bfhi(w[3]) * n1[3]};
#pragma unroll
                              for (int e = 0; e < 8; ++e) tT[(c0 + e) * 136 + q] = (bf16_t)(cvt_pk_bf16(v[e] * rq, 0.f) & 0xffffu); } }
                        __syncthreads();
                        f32x4 acc[8];
#pragma unroll
                        for (int n = 0; n < 8; ++n) acc[n] = (f32x4){0.f, 0.f, 0.f, 0.f};
                        const bf16_t* wsp = WSB + ((size_t)(j * 4 + gq) * 128 + wave * 16 + (lane & 15)) * 128 + 8 * (lane >> 4);
#pragma unroll
                        for (int ks = 0; ks < 4; ++ks) { const bf16x8 a = *(const bf16x8*)(wsp + 32 * ks);
#pragma unroll
                            for (int n = 0; n < 8; ++n) { const bf16x8 b = *(const LAS bf16x8*)(tT + (16 * n + (lane & 15)) * 136 + 32 * ks + 8 * (lane >> 4));
                                acc[n] = __builtin_amdgcn_mfma_f32_16x16x32_bf16(b, a, acc[n], 0, 0, 0); } }
                        { const int p = wave * 16 + (lane & 15); const size_t tok = tok0 + p; const float bsp = gb[gq * 128 + p];
                          u32x2 uu[8];
#pragma unroll
                          for (int n = 0; n < 8; ++n) uu[n] = *(const u32x2*)(GM + tok * 1024 + gq * 128 + 16 * n + 4 * (lane >> 4));
#pragma unroll
                          for (int n = 0; n < 8; ++n) { u32x2 w; w.x = cvt_pk_bf16(bflo(uu[n].x) * (acc[n][0] + bsp), bfhi(uu[n].x) * (acc[n][1] + bsp)); w.y = cvt_pk_bf16(bflo(uu[n].y) * (acc[n][2] + bsp), bfhi(uu[n].y) * (acc[n][3] + bsp));
                              *(u32x2*)(MIX + tok * 1024 + 512 + gq * 128 + 16 * n + 4 * (lane >> 4)) = w; } }
                        __syncthreads();
                    }
                }
                const float* qan = args.in[13] + (size_t)j * 256; const float* kvan = args.in[14] + (size_t)j * 128;
                for (int r = gw; r < MTOK; r += 2 * NGW) {
                    const int r1 = r + NGW; const bool has1 = r1 < MTOK;
                    P1Row p0, p1; p1_load(p0, PROJ + (size_t)r * 512, lane); p1_load(p1, PROJ + (size_t)(has1 ? r1 : r) * 512, lane);
                    p1_finish(p0, r, j, lane, qan, kvan, QKVLAT, KROPE, OUT_CKV, OUT_KR); if (has1) p1_finish(p1, r1, j, lane, qan, kvan, QKVLAT, KROPE, OUT_CKV, OUT_KR);
                }
                for (int cidx = gw; cidx < 4096; cidx += NGW) {
                    const int b = cidx >> 9, p = cidx & 511; const int e = NCTX + b * KVB + LLAT + p;
                    const u32x2 z = {0u, 0u}; *(u32x2*)(QKVLAT + (size_t)e * 384 + 4 * lane) = z;
                    if (lane < 32) { const f32x4 kv = *(const f32x4*)(args.in[2] + (((size_t)b * 2 + j) * 512 + p) * 128 + 4 * lane); u32x2 w2; w2.x = cvt_pk_bf16(kv[0], kv[1]); w2.y = cvt_pk_bf16(kv[2], kv[3]);
                        *(u32x2*)(QKVLAT + (size_t)e * 384 + 256 + 4 * lane) = w2; }
                }
            } else if (EN_POST2 && op == 8) {
                const float* qn = args.in[17] + (size_t)j * 96; const float* kn = args.in[18] + (size_t)j * 96;
                const int hh = lane >> 3, s = lane & 7;
                for (int e = gw; e < MEXT; e += 2 * NGW) {
                    const int e1 = e + NGW; const bool has1 = e1 < MEXT;
                    P2Row r0, r1;
                    p2_load(r0, e, j, hh, s, QKV, KROPE, args.in[3]); p2_load(r1, has1 ? e1 : e, j, hh, s, QKV, KROPE, args.in[3]);
                    p2_compute(r0, s, qn, kn, ROPE); p2_compute(r1, s, qn, kn, ROPE);
                    asm volatile("s_waitcnt vmcnt(0)" ::: "memory");
                    p2_store(r0, hh, s, QKV); if (has1) p2_store(r1, hh, s, QKV);
                    asm volatile("" ::: "memory");
                }
            } else if (EN_ATT && op == 9) {
                const int vcu = (G % 8 == 0) ? (bid % 8) * (G / 8) + bid / 8 : bid;
                for (int u = vcu; u < 1280; u += G) {
                    const bf16_t *Qb, *Kh, *Vh; bf16_t* Ob; int seq;
                    if (u < 1024) { const int bh = u >> 4, qt = u & 15, b = bh >> 3, h = bh & 7; const size_t e0 = NCTX + (size_t)b * KVB;
                        Qb = QKV + (e0 + qt * 256) * QLD + h * 96; Kh = QKV + e0 * QLD + 768 + h * 96; Vh = QKV + e0 * QLD + 1536 + h * 64;
                        Ob = MIX + ((size_t)NCTX + (size_t)b * LLAT + qt * 256) * 1024 + h * 64; seq = KVB; }
                    else { const int vv = u - 1024, b = vv >> 3, h = vv & 7; const size_t e0 = (size_t)b * 256;
                        Qb = QKV + e0 * QLD + h * 96; Kh = QKV + e0 * QLD + 768 + h * 96; Vh = QKV + e0 * QLD + 1536 + h * 64; Ob = MIX + e0 * 1024 + h * 64; seq = 256; }
                    __syncthreads();
                    att::attn_unit(Qb, Kh, Vh, Ob, seq, (char*)lds);
                }
            } else if (EN_POOL && op == 14) {
                const float* rs = RSS + (size_t)(layer * 3 + 1) * MTOK;
                for (long i = gt; i < (long)(MTOK / 32) * 128; i += NGT) {
                    const int seg = (int)(i >> 7), ch = (int)(i & 127), hw = 1 << (ch >> 5);
                    const int r0 = seg * 32; int t0, L; if (r0 < NCTX) { t0 = r0 & 255; L = 256; } else { t0 = (r0 - NCTX) & 4095; L = 4096; }
                    const int base = r0 - t0; const bf16_t* __restrict__ hp = H + (size_t)base * 1024 + ch * 8; const float* __restrict__ rsp = rs + base; bf16_t* __restrict__ pbp = PB + (size_t)base * 1024 + ch * 8;
                    float sum[8];
#pragma unroll
                    for (int e2 = 0; e2 < 8; ++e2) sum[e2] = 0.f;
#define POOL_LD(tt, wgt) do { const u32x4 w_ = *(const u32x4*)(hp + (size_t)(tt) * 1024); const float q_ = (wgt) / sqrtf(rsp[tt] * (1.0f / 1024.0f) + EPS); \
                        _Pragma("unroll") for (int e2 = 0; e2 < 4; ++e2) { sum[2 * e2] += bflo(w_[e2]) * q_; sum[2 * e2 + 1] += bfhi(w_[e2]) * q_; } } while (0)
#pragma unroll
                    for (int i2 = 0; i2 < 16; ++i2) { const int tt = t0 - hw + i2; const bool ok = (i2 < 2 * hw) && tt >= 0; const int tc = tt < 0 ? 0 : (tt > L - 1 ? L - 1 : tt); POOL_LD(tc, ok ? 1.0f : 0.0f); }
#pragma unroll 4
                    for (int t = t0; t < t0 + 32; ++t) {
                        const int lo2 = t - hw < 0 ? 0 : t - hw, hi2 = t + hw > L ? L : t + hw; const float inv = 1.0f / (float)(hi2 - lo2);
                        const u32x4 w0 = *(const u32x4*)(hp + (size_t)t * 1024); const float q0 = 1.0f / sqrtf(rsp[t] * (1.0f / 1024.0f) + EPS); u32x4 o;
#pragma unroll
                        for (int e2 = 0; e2 < 4; ++e2) o[e2] = cvt_pk_bf16(sum[2 * e2] * inv - bflo(w0[e2]) * q0, sum[2 * e2 + 1] * inv - bfhi(w0[e2]) * q0);
                        *(u32x4*)(pbp + (size_t)t * 1024) = o;
                        { const int tp = t + hw, tm = t - hw; const int tpc = tp > L - 1 ? L - 1 : tp, tmc = tm < 0 ? 0 : tm;
                          POOL_LD(tpc, tp < L ? 1.0f : 0.0f); POOL_LD(tmc, tm >= 0 ? -1.0f : 0.0f); }
                    }
#undef POOL_LD
                }
            }
            if (rep + 1 < reps || pid + 1 < hi) xcd_barrier(xbar);
            }
        }
    }
}

extern "C" void kernel_launch(void* const* d_in, const int* in_sizes, int n_in, void* d_out, int out_size, void* d_ws, size_t ws_size, hipStream_t stream) {
    static int grid = 0;
    if (grid == 0) {
        if (n_in != 25 || ws_size < WS_NEED) { fprintf(stderr, "kernel_launch: n_in %d ws %zu (need %zu)\n", n_in, ws_size, (size_t)WS_NEED); grid = -1; return; }
        int dev = 0, cus = 0, per_cu = 0;
        hipGetDevice(&dev); hipDeviceGetAttribute(&cus, hipDeviceAttributeMultiprocessorCount, dev);
        if (hipFuncSetAttribute((const void*)fwd_mega, hipFuncAttributeMaxDynamicSharedMemorySize, LDS_BYTES) != hipSuccess) { fprintf(stderr, "kernel_launch: hipFuncSetAttribute failed\n"); grid = -1; return; }
        if (hipOccupancyMaxActiveBlocksPerMultiprocessor(&per_cu, (const void*)fwd_mega, 512, LDS_BYTES) != hipSuccess || per_cu < 1) { fprintf(stderr, "kernel_launch: occupancy query gave %d\n", per_cu); per_cu = 1; }
        (void)hipGetLastError();
        grid = cus * per_cu;
    }
    if (grid < 0) return;
    Args a{};
    for (int i = 0; i < 25; ++i) a.in[i] = (const float*)d_in[i];
    a.out = (float*)d_out; a.ws = (unsigned char*)d_ws; a.ph_lo = 0; a.ph_hi = 34;
    void* kargs[] = {&a};
    hipError_t e = hipLaunchCooperativeKernel((const void*)fwd_mega, dim3(grid), dim3(512), kargs, LDS_BYTES, stream);
    if (e != hipSuccess) fprintf(stderr, "kernel_launch: cooperative launch failed: %s (grid %d)\n", hipGetErrorString(e), grid);
}
```

```cpp
#include <hip/hip_runtime.h>
#include <hip/hip_cooperative_groups.h>
#include <cstdio>
#include <cstdint>
namespace cg = cooperative_groups;
#ifndef EN_NORM
#define EN_NORM 1
#endif
#ifndef EN_G1
#define EN_G1 1
#endif
#ifndef EN_GRES
#define EN_GRES 1
#endif
#ifndef EN_GRAW
#define EN_GRAW 1
#endif
#ifndef EN_POST1
#define EN_POST1 1
#endif
#ifndef EN_POST2
#define EN_POST2 1
#endif
#ifndef EN_ATT
#define EN_ATT 1
#endif
#ifndef EN_POOL
#define EN_POOL 1
#endif
#ifndef EN_PRO
#define EN_PRO 1
#endif
#ifndef DUPMASK
#define DUPMASK 0
#endif

#define LAS __attribute__((address_space(3)))
typedef unsigned short bf16_t;
typedef short bf16x8 __attribute__((ext_vector_type(8)));
typedef short s16x4 __attribute__((ext_vector_type(4)));
typedef float f32x4 __attribute__((ext_vector_type(4)));
typedef float f32x16 __attribute__((ext_vector_type(16)));
typedef unsigned u32x4 __attribute__((ext_vector_type(4)));
typedef unsigned u32x2 __attribute__((ext_vector_type(2)));

constexpr int DM = 1024, FF = 2816, MTOK = 40960, MEXT = 45056, NCTX = 8192, LLAT = 4096, PAST = 512, KVB = 4608;
constexpr int NMOD = 9216;
constexpr int QLD = 2048;
constexpr float EPS = 1e-6f;
constexpr size_t SZ_W13 = (size_t)8 * 5632 * 1024 * 2, SZ_W2 = (size_t)8 * 1024 * 2816 * 2, SZ_WIN = (size_t)2 * 1536 * 1024 * 2,
                 SZ_WQKV = (size_t)2 * 1792 * 384 * 2, SZ_WOUT = (size_t)2 * 1024 * 1024 * 2, SZ_POOLT = (size_t)2 * 1024 * 256 * 2,
                 SZ_WS = (size_t)2 * 4 * 128 * 128 * 2, SZ_MOD = (size_t)4 * 9 * NMOD * 4, SZ_ROPE = (size_t)2 * 4096 * 16 * 4,
                 SZ_H = (size_t)MTOK * 1024 * 2;
constexpr size_t OFF_W13 = 0, OFF_W2 = OFF_W13 + SZ_W13, OFF_WIN = OFF_W2 + SZ_W2, OFF_WQKV = OFF_WIN + SZ_WIN, OFF_WOUT = OFF_WQKV + SZ_WQKV,
                 OFF_POOLT = OFF_WOUT + SZ_WOUT, OFF_WS = OFF_POOLT + SZ_POOLT, OFF_MOD = OFF_WS + SZ_WS, OFF_ROPE = OFF_MOD + SZ_MOD,
                 OFF_H = OFF_ROPE + SZ_ROPE, OFF_R = OFF_H + SZ_H;
constexpr size_t R_QKVLAT = 0, R_KROPE = (size_t)MEXT * 384 * 2, R_PROJ = 41943040, R_GM = R_PROJ + (size_t)MTOK * 512 * 4,
                 R_QKVRAW = R_PROJ, SZ_R = SZ_H + (size_t)MTOK * 2816 * 2;
static_assert(R_KROPE + (size_t)MTOK * 32 * 4 <= R_PROJ, "ws map");
static_assert(R_QKVRAW + (size_t)MEXT * QLD * 2 <= SZ_R, "ws map");
constexpr size_t OFF_CTL = OFF_R + SZ_R, SZ_CTL = 16384;
constexpr size_t OFF_RSS = OFF_CTL + SZ_CTL, SZ_RSS = (size_t)12 * MTOK * 4;
constexpr size_t OFF_B13 = OFF_RSS + SZ_RSS, SZ_B13 = (size_t)8 * 9 * 5632 * 4;
constexpr size_t OFF_BIN = OFF_B13 + SZ_B13, SZ_BIN = (size_t)2 * 9 * 1536 * 4;
constexpr size_t R_U = SZ_H;
static_assert(R_U + (size_t)MTOK * 2816 * 2 <= SZ_R, "ws map");
constexpr size_t WS_NEED = OFF_BIN + SZ_BIN;

__device__ __forceinline__ unsigned cvt_pk_bf16(float lo, float hi) { unsigned r; asm volatile("v_cvt_pk_bf16_f32 %0, %1, %2" : "=v"(r) : "v"(lo), "v"(hi)); return r; }
__device__ __forceinline__ float bf2f(unsigned short b) { return __uint_as_float(((unsigned)b) << 16); }
__device__ __forceinline__ float bflo(unsigned w) { return __uint_as_float(w << 16); }
__device__ __forceinline__ float bfhi(unsigned w) { return __uint_as_float(w & 0xffff0000u); }
__device__ __forceinline__ float wave_sum(float v) {
#pragma unroll
    for (int o = 1; o < 64; o <<= 1) v += __shfl_xor(v, o);
    return v;
}
__device__ __forceinline__ float fast_sigmoid(float x) { return __builtin_amdgcn_rcpf(1.0f + __builtin_amdgcn_exp2f(-1.4426950408889634f * x)); }
__device__ __forceinline__ float silu_f(float x) { return x * fast_sigmoid(x); }
__device__ __forceinline__ float gelu_tanh_f(float x) { const float y = 0.7978845608028654f * (x + 0.044715f * x * x * x); return x * fast_sigmoid(2.0f * y); }
__device__ __forceinline__ f32x4 sigmoid4(f32x4 x) {
    const f32x4 t = x * -1.4426950408889634f; f32x4 e;
#pragma unroll
    for (int i = 0; i < 4; ++i) e[i] = __builtin_amdgcn_exp2f(t[i]);
    const f32x4 d = e + 1.0f; f32x4 r;
#pragma unroll
    for (int i = 0; i < 4; ++i) r[i] = __builtin_amdgcn_rcpf(d[i]);
    return r;
}
__device__ __forceinline__ f32x4 silu4(f32x4 x) { return x * sigmoid4(x); }
__device__ __forceinline__ f32x4 gelu_tanh4(f32x4 x) { const f32x4 y = (x + x * x * x * 0.044715f) * (2.0f * 0.7978845608028654f); return x * sigmoid4(y); }
__device__ __forceinline__ int cv_of_row(int r) { return r < NCTX ? 0 : 1 + ((r - NCTX) >> 12); }

#ifndef PROBE_KREP
#define PROBE_KREP 1
#endif
namespace pg8 {
constexpr int BM = 256, BK = 64, HALF = 128, HTB = HALF * BK * 2, STAGE_BYTES = 8 * HTB, NXCD = 8, WGM = 8;
__host__ __device__ __forceinline__ int lds_byte(int r, int c) { const int st = (r >> 4) * 2 + (c >> 5), rr = r & 15, cc = c & 31, ob = rr * 64 + cc * 2; return st * 1024 + (ob ^ (((ob >> 9) & 1) << 5)); }
__host__ __device__ __forceinline__ void stage_rc(int b, int& R, int& C) { const int st = b / 1024, sb = b % 1024, swz = sb ^ (((sb >> 9) & 1) << 5); R = (st >> 1) * 16 + swz / 64; C = (st & 1) * 32 + (swz % 64) / 2; }
__host__ __device__ __forceinline__ int perm32(int rho) { const int n = rho >> 4, i = rho & 15; return 8 * (i >> 2) + 4 * n + (i & 3); }

struct Unit { int pm, pn, half; };
struct Gemm { const bf16_t* A; const bf16_t* Bt; int M, N, K, lda, ldb, apn; };

struct StaticOrder {
    int nM, nN, nwg, G, c, ht;
    __device__ void init(int M, int N, int G_, int c_, int ht_ = 0) { nM = M / BM; nN = N / BM; nwg = nM * nN; G = G_; c = c_; ht = ht_; }
    __device__ bool next(int i, Unit& u) const {
        long L = (long)i * G + c; u.half = -1;
        if (ht) { const int nfull = nwg / G, rem = nwg - nfull * G;
            if (rem > 0 && 2 * rem <= G && i >= nfull) { if (i > nfull || (c >> 1) >= rem) return false; L = (long)nfull * G + (c >> 1); u.half = c & 1; } }
        if (L >= nwg) return false;
        int wgid = (int)L; { const int q = nwg / NXCD, r = nwg % NXCD, xcd = wgid % NXCD, off = wgid / NXCD; wgid = (xcd < r ? xcd * (q + 1) : r * (q + 1) + (xcd - r) * q) + off; }
        const int nig = WGM * nN, gid = wgid / nig, fm = gid * WGM, gsz = (nM - fm) < WGM ? (nM - fm) : WGM;
        u.pm = fm + ((wgid % nig) % gsz); u.pn = (wgid % nig) / gsz; return true;
    }
};

struct EpiSwiglu {
    static constexpr bool PERM = true; static constexpr int KREP = PROBE_KREP;
    bf16_t* U; const float* rss; const float* bias;
    static constexpr bool PREF = true;
    __device__ __forceinline__ bool pref_on() const { return true; }
    __device__ __forceinline__ const float* pref_ptr(const Unit& u, int tid) const { const int cv = u.pm < 32 ? 0 : 1 + ((u.pm - 32) >> 4);
        return tid < 256 ? rss + u.pm * BM + tid : bias + (size_t)cv * 5632 + u.pn * BM + (tid - 256); }
    __device__ __forceinline__ void run(f32x4 (&acc)[2][2][4][2], const Unit& u, int wr, int wc, int fr, int fq, const LAS float* sc) const {
        const int row0 = u.pm * BM + wr * 64 + fr, col0 = u.pn * HALF + wc * 32 + 8 * fq;
        const LAS float* bp = sc + 256 + wc * 32 + 8 * fq;
        const f32x4 ba0 = *(const LAS f32x4*)(bp), ba1 = *(const LAS f32x4*)(bp + 4), bb0 = *(const LAS f32x4*)(bp + HALF), bb1 = *(const LAS f32x4*)(bp + HALF + 4);
#pragma unroll
        for (int ai = 0; ai < 2; ++ai)
#pragma unroll
            for (int m = 0; m < 4; ++m) {
                const int row = row0 + ai * HALF + m * 16;
                bf16_t* rowp = U + (size_t)row * FF + col0;
                const float rstd = (1.0f / (float)KREP) / sqrtf(sc[ai * HALF + wr * 64 + m * 16 + fr] * (1.0f / 1024.0f) + EPS);
                const f32x4 a0 = acc[ai][0][m][0] * rstd + ba0, a1 = acc[ai][0][m][1] * rstd + ba1, b0 = acc[ai][1][m][0] * rstd + bb0, b1 = acc[ai][1][m][1] * rstd + bb1;
                const f32x4 v0 = silu4(a0) * b0, v1 = silu4(a1) * b1;
                u32x4 w; w.x = cvt_pk_bf16(v0[0], v0[1]); w.y = cvt_pk_bf16(v0[2], v0[3]); w.z = cvt_pk_bf16(v1[0], v1[1]); w.w = cvt_pk_bf16(v1[2], v1[3]);
                *(u32x4*)rowp = w;
            }
    }
};
struct EpiResid {
    static constexpr bool PERM = true; static constexpr int KREP = 1;
    float* X; const float* gate; const float* scale;
    bf16_t* An; const float* gn; const float* scn; float* rssn;
    float coef; int pad_;
    static constexpr bool PREF = false;
    __device__ __forceinline__ bool pref_on() const { return false; }
    __device__ __forceinline__ const float* pref_ptr(const Unit&, int) const { return nullptr; }
    __device__ __forceinline__ void run(f32x4 (&acc)[2][2][4][2], const Unit& u, int wr, int wc, int fr, int fq, const LAS float*) const {
        const int row0 = u.pm * BM + wr * 64 + fr; int col0 = u.pn * BM + wc * 32 + 8 * fq;
        const int cv = u.pm < 32 ? 0 : 1 + ((u.pm - 32) >> 4);
        const bool nx = An != nullptr;
        const int hb = u.half > 0 ? HALF : 0, nbj = u.half < 0 ? 2 : 1;
        col0 += hb;
        f32x4 gv[2][2], gm[2][2];
#pragma unroll
        for (int bj = 0; bj < 2; ++bj)
#pragma unroll
            for (int n = 0; n < 2; ++n) { const int c = col0 + (bj < nbj ? bj : 0) * HALF + 4 * n; f32x4 g = *(const f32x4*)(gate + (size_t)cv * NMOD + c) * coef;
                if (scale) g = g * *(const f32x4*)(scale + c); gv[bj][n] = g;
                gm[bj][n] = nx ? *(const f32x4*)(gn + c) * (*(const f32x4*)(scn + (size_t)cv * NMOD + c) + 1.0f) : (f32x4){0.f, 0.f, 0.f, 0.f}; }
#pragma unroll
        for (int ai = 0; ai < 2; ++ai)
#pragma unroll
            for (int m = 0; m < 4; ++m) { const int row = row0 + ai * HALF + m * 16; float* rowp = X + (size_t)row * DM + col0;
                float ss = 0.f;
#pragma unroll
                for (int bj = 0; bj < 2; ++bj) if (bj < nbj) { f32x4* p = (f32x4*)(rowp + bj * HALF);
                    const f32x4 x0 = __builtin_nontemporal_load(p) + acc[ai][bj][m][0] * gv[bj][0], x1 = __builtin_nontemporal_load(p + 1) + acc[ai][bj][m][1] * gv[bj][1];
                    __builtin_nontemporal_store(x0, p); __builtin_nontemporal_store(x1, p + 1);
                    if (nx) { ss += ((x0[0] * x0[0] + x0[1] * x0[1]) + (x0[2] * x0[2] + x0[3] * x0[3])) + ((x1[0] * x1[0] + x1[1] * x1[1]) + (x1[2] * x1[2] + x1[3] * x1[3]));
                        const f32x4 a0 = x0 * gm[bj][0], a1 = x1 * gm[bj][1]; u32x4 w; w.x = cvt_pk_bf16(a0[0], a0[1]); w.y = cvt_pk_bf16(a0[2], a0[3]); w.z = cvt_pk_bf16(a1[0], a1[1]); w.w = cvt_pk_bf16(a1[2], a1[3]);
                        *(u32x4*)(An + (size_t)row * DM + col0 + bj * HALF) = w; } }
                if (nx) { ss += __shfl_xor(ss, 16); ss += __shfl_xor(ss, 32);
                    if (fq == 0) (void)__hip_atomic_fetch_add(rssn + row, ss, __ATOMIC_RELAXED, __HIP_MEMORY_SCOPE_AGENT); } }
    }
};
struct EpiRaw {
    static constexpr bool PERM = true; static constexpr int KREP = 1;
    float* R; bf16_t* G; const float* rss; const float* bias; int ldr, nraw, ldg, act;
    static constexpr bool PREF = true;
    __device__ __forceinline__ bool pref_on() const { return rss != nullptr; }
    __device__ __forceinline__ const float* pref_ptr(const Unit& u, int tid) const { const int cv = u.pm < 32 ? 0 : 1 + ((u.pm - 32) >> 4);
        return tid < 256 ? rss + u.pm * BM + tid : bias + (size_t)cv * 1536 + u.pn * BM + (tid - 256); }
    __device__ __forceinline__ void run(f32x4 (&acc)[2][2][4][2], const Unit& u, int wr, int wc, int fr, int fq, const LAS float* sc) const {
        const int row0 = u.pm * BM + wr * 64 + fr, cw = wc * 32 + 8 * fq;
        if (rss) {
            f32x4 bv[2][2];
#pragma unroll
            for (int bj = 0; bj < 2; ++bj)
#pragma unroll
                for (int n = 0; n < 2; ++n) bv[bj][n] = *(const LAS f32x4*)(sc + 256 + cw + bj * HALF + 4 * n);
#pragma unroll
            for (int ai = 0; ai < 2; ++ai)
#pragma unroll
                for (int m = 0; m < 4; ++m) { const float rstd = 1.0f / sqrtf(sc[ai * HALF + wr * 64 + m * 16 + fr] * (1.0f / 1024.0f) + EPS);
#pragma unroll
                    for (int bj = 0; bj < 2; ++bj)
#pragma unroll
                        for (int n = 0; n < 2; ++n) acc[ai][bj][m][n] = acc[ai][bj][m][n] * rstd + bv[bj][n]; }
        }
        if (u.pn < nraw) {
#pragma unroll
            for (int ai = 0; ai < 2; ++ai)
#pragma unroll
                for (int m = 0; m < 4; ++m) { float* rowp = R + (size_t)(row0 + ai * HALF + m * 16) * ldr + u.pn * BM + cw;
#pragma unroll
                    for (int bj = 0; bj < 2; ++bj) { *(f32x4*)(rowp + bj * HALF) = acc[ai][bj][m][0]; *(f32x4*)(rowp + bj * HALF + 4) = acc[ai][bj][m][1]; } }
        } else {
#pragma unroll
            for (int ai = 0; ai < 2; ++ai)
#pragma unroll
                for (int m = 0; m < 4; ++m) { bf16_t* rowp = G + (size_t)(row0 + ai * HALF + m * 16) * ldg + (u.pn - nraw) * BM + cw;
#pragma unroll
                    for (int bj = 0; bj < 2; ++bj) { f32x4 v0 = acc[ai][bj][m][0], v1 = acc[ai][bj][m][1];
                        if (act) { v0 = gelu_tanh4(v0); v1 = gelu_tanh4(v1); }
                        u32x4 w; w.x = cvt_pk_bf16(v0[0], v0[1]); w.y = cvt_pk_bf16(v0[2], v0[3]); w.z = cvt_pk_bf16(v1[0], v1[1]); w.w = cvt_pk_bf16(v1[2], v1[3]);
                        *(u32x4*)(rowp + bj * HALF) = w; } }
        }
    }
};

template <class Epi, bool HT = false>
__device__ __forceinline__ void gemm_phase(LAS unsigned char* lds, const Gemm g, const StaticOrder S, const Epi E) {
    int tid = threadIdx.x; asm volatile("" : "+v"(tid));
    const int wid = __builtin_amdgcn_readfirstlane(tid >> 6), lane = tid & 63, wr = wid >> 2, wc = wid & 3, fr = lane & 15, fq = lane >> 4;
    const int nt = g.K / BK;
    unsigned voffA[2], voffB[2];
#pragma unroll
    for (int i = 0; i < 2; ++i) { int R, C; stage_rc(tid * 16 + i * 8192, R, C); const int Rb = Epi::PERM ? ((R & ~31) + perm32(R & 31)) : R;
        voffA[i] = (unsigned)(R * g.lda + C) * 2u; voffB[i] = (unsigned)(Rb * g.ldb + C) * 2u; }
    const size_t kstep = (size_t)(BK * 2);
    const size_t hstepA = (size_t)HALF * g.lda * 2, hstepB = (size_t)HALF * g.ldb * 2;
    const size_t tstepA = 2 * hstepA, tstepB = 2 * hstepB;
    const unsigned ldsw = (unsigned)wid * 1024u;
    const int aoff = lds_byte(wr * 64 + fr, fq * 8), boff = lds_byte(wc * 32 + fr, fq * 8);
#define PG8_SA(b, h) (((b) * 2 + (h)) * HTB)
#define PG8_SB(b, h) ((4 + (b) * 2 + (h)) * HTB)
#define PG8_STAGE(bufoff, gbase, voff) do { _Pragma("unroll") for (int _i = 0; _i < 2; ++_i) \
        __builtin_amdgcn_global_load_lds((const unsigned*)((const char*)(gbase) + (voff)[_i]), (LAS unsigned*)(lds + (bufoff) + ldsw + _i * 8192), 16, 0, 0); } while (0)
#define PG8_LDA(dst, b, h) do { _Pragma("unroll") for (int m = 0; m < 4; ++m) _Pragma("unroll") for (int k = 0; k < 2; ++k) dst[m][k] = *(const LAS bf16x8*)(lds + PG8_SA(b, h) + aoff + m * 2048 + k * 1024); } while (0)
#define PG8_LDB(dst, b, h) do { _Pragma("unroll") for (int n = 0; n < 2; ++n) _Pragma("unroll") for (int k = 0; k < 2; ++k) dst[n][k] = *(const LAS bf16x8*)(lds + PG8_SB(b, h) + boff + n * 2048 + k * 1024); } while (0)
#define PG8_MMA(ai, bj, At, Bt) do { __builtin_amdgcn_s_setprio(1); _Pragma("unroll") for (int m = 0; m < 4; ++m) _Pragma("unroll") for (int n = 0; n < 2; ++n) _Pragma("unroll") for (int k = 0; k < 2; ++k) \
        acc[ai][bj][m][n] = __builtin_amdgcn_mfma_f32_16x16x32_bf16(Bt[n][k], At[m][k], acc[ai][bj][m][n], 0, 0, 0); __builtin_amdgcn_s_setprio(0); } while (0)
#define PG8_WAIT_V(n) asm volatile("s_waitcnt vmcnt(" #n ")" ::: "memory")
#define PG8_WAIT_L(n) asm volatile("s_waitcnt lgkmcnt(" #n ")" ::: "memory")
#define PG8_BAR __builtin_amdgcn_s_barrier()
#define PG8_SCHED __builtin_amdgcn_sched_barrier(0)
    Unit cur, nxt; int ui = 0;
    if (!S.next(0, cur)) return;
    constexpr int EPI_LDS = 131328;
#define PG8_PREF(u) do { if (Epi::PREF && E.pref_on()) __builtin_amdgcn_global_load_lds((const unsigned*)E.pref_ptr(u, tid), (LAS unsigned*)(lds + EPI_LDS + (ui & 1) * 2048 + wid * 256), 4, 0, 0); } while (0)
    PG8_PREF(cur);
    f32x4 acc[2][2][4][2];
#pragma unroll
    for (int a = 0; a < 2; ++a)
#pragma unroll
        for (int b = 0; b < 2; ++b)
#pragma unroll
            for (int m = 0; m < 4; ++m)
#pragma unroll
                for (int n = 0; n < 2; ++n) acc[a][b][m][n] = (f32x4){0.f, 0.f, 0.f, 0.f};
    bf16x8 At[4][2], B0[2][2], B1[2][2];
    const char* cA = (const char*)g.A + (size_t)cur.pm * tstepA + (size_t)cur.pn * g.apn; const char* cB = (const char*)g.Bt + (size_t)cur.pn * tstepB + ((HT && cur.half > 0) ? hstepB : 0);
    size_t hBc = (HT && cur.half >= 0) ? 0 : hstepB;
    PG8_STAGE(PG8_SB(0, 0), cB, voffB); PG8_STAGE(PG8_SB(0, 1), cB + hBc, voffB); PG8_STAGE(PG8_SA(0, 0), cA, voffA); PG8_STAGE(PG8_SA(0, 1), cA + hstepA, voffA);
    if (wr == 1) PG8_BAR;
    PG8_WAIT_V(2); PG8_BAR;
    PG8_STAGE(PG8_SB(1, 0), cB + kstep, voffB); PG8_STAGE(PG8_SA(1, 0), cA + kstep, voffA); PG8_STAGE(PG8_SB(1, 1), cB + hBc + kstep, voffB);
    PG8_WAIT_V(6); PG8_BAR;
#define PG8_KBODY(B1ON) \
        for (int t = 0, tk = 0; t < nt * Epi::KREP; t += 2) { \
            const bool last = (t == nt * Epi::KREP - 2); \
            const int tk2 = (tk + 2 >= nt) ? tk + 2 - nt : tk + 2; \
            const char* a1 = cA + (size_t)(tk + 1) * kstep; \
            const char* a2 = last ? nA : cA + (size_t)tk2 * kstep; const char* b2 = last ? nB : cB + (size_t)tk2 * kstep; const size_t hb2 = last ? nhB : hBc; tk = tk2; \
            const char* a3 = a2 + kstep; const char* b3 = b2 + kstep; \
            PG8_LDB(B0, 0, 0); if (B1ON) PG8_LDB(B1, 0, 1); PG8_SCHED; PG8_LDA(At, 0, 0); PG8_STAGE(PG8_SA(1, 1), a1 + hstepA, voffA); \
            PG8_WAIT_V(8); PG8_WAIT_L(0); PG8_BAR; PG8_MMA(0, 0, At, B0); if (B1ON) PG8_MMA(0, 1, At, B1); PG8_BAR; PG8_SCHED; \
            PG8_LDA(At, 0, 1); PG8_STAGE(PG8_SB(0, 0), b2, voffB); PG8_STAGE(PG8_SB(0, 1), b2 + hb2, voffB); PG8_STAGE(PG8_SA(0, 0), a2, voffA); \
            PG8_WAIT_V(8); PG8_WAIT_L(0); PG8_BAR; PG8_MMA(1, 0, At, B0); if (B1ON) PG8_MMA(1, 1, At, B1); PG8_BAR; PG8_SCHED; \
            PG8_LDB(B0, 1, 0); if (B1ON) PG8_LDB(B1, 1, 1); PG8_SCHED; PG8_LDA(At, 1, 0); PG8_STAGE(PG8_SA(0, 1), a2 + hstepA, voffA); \
            PG8_WAIT_V(8); PG8_WAIT_L(0); PG8_BAR; PG8_MMA(0, 0, At, B0); if (B1ON) PG8_MMA(0, 1, At, B1); PG8_BAR; PG8_SCHED; \
            PG8_LDA(At, 1, 1); PG8_STAGE(PG8_SB(1, 0), b3, voffB); PG8_STAGE(PG8_SB(1, 1), b3 + hb2, voffB); PG8_STAGE(PG8_SA(1, 0), a3, voffA); \
            PG8_WAIT_V(8); PG8_WAIT_L(0); PG8_BAR; PG8_MMA(1, 0, At, B0); if (B1ON) PG8_MMA(1, 1, At, B1); PG8_BAR; PG8_SCHED; \
        }
    for (;;) {
        const bool has_next = S.next(ui + 1, nxt);
        const char* nA = has_next ? (const char*)g.A + (size_t)nxt.pm * tstepA + (size_t)nxt.pn * g.apn : cA;
        const char* nB = has_next ? (const char*)g.Bt + (size_t)nxt.pn * tstepB + ((HT && nxt.half > 0) ? hstepB : 0) : cB;
        const size_t nhB = has_next ? ((HT && nxt.half >= 0) ? 0 : hstepB) : hBc;
        if (HT && cur.half >= 0) { PG8_KBODY(false) } else { PG8_KBODY(true) }
        if (wr == 0) PG8_BAR;
        E.run(acc, cur, wr, wc, fr, fq, (const LAS float*)(lds + EPI_LDS + (ui & 1) * 2048));
        if (!has_next) break;
#pragma unroll
        for (int a = 0; a < 2; ++a)
#pragma unroll
            for (int b = 0; b < 2; ++b)
#pragma unroll
                for (int m = 0; m < 4; ++m)
#pragma unroll
                    for (int n = 0; n < 2; ++n) acc[a][b][m][n] = (f32x4){0.f, 0.f, 0.f, 0.f};
        cur = nxt; cA = nA; cB = nB; hBc = nhB; ++ui;
        PG8_PREF(cur);
        if (wr == 1) PG8_BAR;
    }
    PG8_WAIT_V(0);
    PG8_BAR;
#undef PG8_KBODY
#undef PG8_PREF
#undef PG8_SA
#undef PG8_SB
#undef PG8_STAGE
#undef PG8_LDA
#undef PG8_LDB
#undef PG8_MMA
#undef PG8_WAIT_V
#undef PG8_WAIT_L
#undef PG8_BAR
#undef PG8_SCHED
}
}

namespace att {
constexpr int NW = 8, QBLK = 32, KVBLK = 64;
constexpr float SCALE = 0.10206207261596575f;
constexpr float THR = 8.f;
constexpr size_t SHM_V = 16384, SHM_K = 16384, SHM_ATTN = 2 * SHM_V + 2 * SHM_K + NW * 64 * 4;
#define KSWZ(row, colB) ((row) * 256 + ((colB) ^ (((row) & 7) << 4)))
#define SBAR() __builtin_amdgcn_sched_barrier(0)
__device__ __forceinline__ int crow(int r, int hi) { return (r & 3) + 8 * (r >> 2) + 4 * hi; }
__device__ __forceinline__ void partialSM(f32x16& p0, f32x16& p1, float& m_reg, float& mn, float& alpha) {
  constexpr float C = SCALE * 1.4426950408889634f;
  float pmax = p0[0];
#pragma unroll
  for (int r = 1; r < 16; ++r) pmax = fmaxf(pmax, p0[r]);
#pragma unroll
  for (int r = 0; r < 16; ++r) pmax = fmaxf(pmax, p1[r]);
  { auto rr = __builtin_amdgcn_permlane32_swap(__float_as_uint(pmax), __float_as_uint(pmax), false, false);
    pmax = fmaxf(__uint_as_float(rr[0]), __uint_as_float(rr[1])); }
  if (__builtin_expect(__all(pmax - m_reg <= THR / SCALE), 1)) { mn = m_reg; alpha = 1.f; }
  else { mn = fmaxf(m_reg, pmax); alpha = __builtin_amdgcn_exp2f((m_reg - mn) * C); m_reg = mn; }
  float mnC = -mn * C;
#pragma unroll
  for (int r = 0; r < 16; ++r) p0[r] = fmaf(p0[r], C, mnC);
#pragma unroll
  for (int r = 0; r < 16; ++r) p1[r] = fmaf(p1[r], C, mnC);
#pragma unroll
  for (int r = 0; r < 16; ++r) p0[r] = __builtin_amdgcn_exp2f(p0[r]);
}
__device__ __forceinline__ void finishSM(f32x16& p0, f32x16& p1, float alpha, float& l_reg, bf16x8& pa0, bf16x8& pa1, bf16x8& pa2, bf16x8& pa3) {
#pragma unroll
  for (int r = 0; r < 16; ++r) p1[r] = __builtin_amdgcn_exp2f(p1[r]);
  float ps = 0;
#pragma unroll
  for (int r = 0; r < 16; ++r) ps += p0[r];
#pragma unroll
  for (int r = 0; r < 16; ++r) ps += p1[r];
  { auto rr = __builtin_amdgcn_permlane32_swap(__float_as_uint(ps), __float_as_uint(ps), false, false);
    ps = __uint_as_float(rr[0]) + __uint_as_float(rr[1]); }
  l_reg = l_reg * alpha + ps;
#define PK4(P, BASE, OUT) do { unsigned a0 = cvt_pk_bf16(P[BASE + 0], P[BASE + 1]), a1 = cvt_pk_bf16(P[BASE + 2], P[BASE + 3]);   \
    unsigned b0 = cvt_pk_bf16(P[BASE + 4], P[BASE + 5]), b1 = cvt_pk_bf16(P[BASE + 6], P[BASE + 7]);                              \
    auto r0 = __builtin_amdgcn_permlane32_swap(a0, b0, false, false); auto r1 = __builtin_amdgcn_permlane32_swap(a1, b1, false, false); \
    u32x4 w = {r0[0], r1[0], r0[1], r1[1]}; OUT = *reinterpret_cast<bf16x8*>(&w); } while (0)
  PK4(p0, 0, pa0); PK4(p0, 8, pa1); PK4(p1, 0, pa2); PK4(p1, 8, pa3);
#undef PK4
}
__device__ __forceinline__ void qkt(f32x16& p0, f32x16& p1, const char* Ks, const bf16x8* qr, int r32, int hi) {
  p0 = f32x16{}; p1 = f32x16{};
#pragma unroll
  for (int d0 = 0; d0 < 6; ++d0) { int cb = (d0 * 16 + hi * 8) * 2;
    bf16x8 b0 = *reinterpret_cast<const bf16x8*>(Ks + KSWZ(r32, cb));
    bf16x8 b1 = *reinterpret_cast<const bf16x8*>(Ks + KSWZ(32 + r32, cb));
    p0 = __builtin_amdgcn_mfma_f32_32x32x16_bf16(b0, qr[d0], p0, 0, 0, 0);
    p1 = __builtin_amdgcn_mfma_f32_32x32x16_bf16(b1, qr[d0], p1, 0, 0, 0); }
}
__device__ __forceinline__ int v_st(int k, int c) { const int kk = (k & ~0xC) | ((k & 4) << 1) | ((k & 8) >> 1); return ((kk >> 3) * 4 + (c >> 5)) * 512 + ((kk & 7) * 32 + (c & 31)) * 2; }
__device__ __forceinline__ int v_rd_base(int lane) { return ((lane & 3) << 3) | (((lane >> 2) & 3) << 6) | (((lane >> 4) & 1) << 5) | (((lane >> 5) & 1) << 8); }
constexpr int v_rd_off(int d0, int ks, int half) { return d0 * 512 + ks * 4096 + half * 2048; }
template <int OFF> __device__ __forceinline__ s16x4 tr_read(int vb) {
  s16x4 r; asm volatile("ds_read_b64_tr_b16 %0, %1 offset:%2" : "=&v"(r) : "v"(vb), "i"(OFF) : "memory"); return r;
}
template <int D0> __device__ __forceinline__ void pv_one(f32x16& od, int vb, bf16x8 pa0, bf16x8 pa1, bf16x8 pa2, bf16x8 pa3) {
  const s16x4 l0 = tr_read<v_rd_off(D0, 0, 0)>(vb), h0 = tr_read<v_rd_off(D0, 0, 1)>(vb), l1 = tr_read<v_rd_off(D0, 1, 0)>(vb), h1 = tr_read<v_rd_off(D0, 1, 1)>(vb);
  const s16x4 l2 = tr_read<v_rd_off(D0, 2, 0)>(vb), h2 = tr_read<v_rd_off(D0, 2, 1)>(vb), l3 = tr_read<v_rd_off(D0, 3, 0)>(vb), h3 = tr_read<v_rd_off(D0, 3, 1)>(vb);
  asm volatile("s_waitcnt lgkmcnt(0)" ::: "memory"); SBAR();
#define PK(L, H) (bf16x8){L[0], L[1], L[2], L[3], H[0], H[1], H[2], H[3]}
  od = __builtin_amdgcn_mfma_f32_32x32x16_bf16(pa0, PK(l0, h0), od, 0, 0, 0);
  od = __builtin_amdgcn_mfma_f32_32x32x16_bf16(pa1, PK(l1, h1), od, 0, 0, 0);
  od = __builtin_amdgcn_mfma_f32_32x32x16_bf16(pa2, PK(l2, h2), od, 0, 0, 0);
  od = __builtin_amdgcn_mfma_f32_32x32x16_bf16(pa3, PK(l3, h3), od, 0, 0, 0);
#undef PK
}
__device__ __forceinline__ void pv_d0(f32x16* o, int vb, bf16x8 pa0, bf16x8 pa1, bf16x8 pa2, bf16x8 pa3) {
  pv_one<0>(o[0], vb, pa0, pa1, pa2, pa3); pv_one<1>(o[1], vb, pa0, pa1, pa2, pa3);
}
__device__ __forceinline__ void attn_unit(const bf16_t* __restrict__ Qb, const bf16_t* __restrict__ Kh, const bf16_t* __restrict__ Vh,
                                          bf16_t* __restrict__ Ob, int seq, char* lds) {
  int tid = threadIdx.x; asm volatile("" : "+v"(tid));
  const int wid = tid >> 6, lane = tid & 63, r32 = lane & 31, hi = lane >> 5;
  char* V_lds = lds; char* K_lds = lds + 2 * SHM_V;
  float* ws = (float*)(lds + 2 * SHM_V + 2 * SHM_K) + wid * 64; float* li_l = ws; float* al_l = ws + 32;
  float m_reg = -1e30f, l_reg = 0; f32x16 o[2] = {}; bf16x8 qr[6];
  const bf16_t* Qw = Qb + (long)(wid * QBLK + r32) * QLD + hi * 8;
#pragma unroll
  for (int d0 = 0; d0 < 6; ++d0) qr[d0] = *reinterpret_cast<const bf16x8*>(Qw + d0 * 16);
  const bool kld = wid < 6;
  const int ksr = tid / 12, ksc = (tid - ksr * 12) * 8;
  const int vsr = tid >> 3, vsc = (tid & 7) * 8, vst0 = v_st(vsr, vsc);
  const int vb0 = (int)(uintptr_t)V_lds + v_rd_base(lane);
  struct { bf16x8 vs0, ks0, ks1; } sr_[2];
#define SLOAD(i, k0) do { sr_[i].vs0 = *reinterpret_cast<const bf16x8*>(&Vh[(long)((k0) + vsr) * QLD + vsc]); \
    if (kld) { sr_[i].ks0 = *reinterpret_cast<const bf16x8*>(&Kh[(long)((k0) + ksr) * QLD + ksc]); sr_[i].ks1 = *reinterpret_cast<const bf16x8*>(&Kh[(long)((k0) + 32 + ksr) * QLD + ksc]); } } while (0)
#define SWRITE(b, i) do { *(bf16x8*)(V_lds + (b) * SHM_V + vst0) = sr_[i].vs0; \
    if (kld) { int kc = ksc * 2; *(bf16x8*)(K_lds + (b) * SHM_K + KSWZ(ksr, kc)) = sr_[i].ks0; *(bf16x8*)(K_lds + (b) * SHM_K + KSWZ(32 + ksr, kc)) = sr_[i].ks1; } } while (0)
#define SWAIT() asm volatile("s_waitcnt vmcnt(3)" ::: "memory")
#define RESC(a) do { if (__any((a) < 1.f)) { if (hi == 0) al_l[r32] = (a); asm volatile("s_waitcnt lgkmcnt(0)" ::: "memory"); \
    _Pragma("unroll") for (int d = 0; d < 2; ++d) _Pragma("unroll") for (int r = 0; r < 16; ++r) o[d][r] *= al_l[crow(r, hi)]; } } while (0)
  f32x16 pA0, pA1, pB0, pB1; float mnA, mnB, alA, alB; bf16x8 pa0, pa1, pa2, pa3; const int NT = seq / KVBLK;
  constexpr int SE = 0, SO = 1;
  SLOAD(SE, 0); asm volatile("s_waitcnt vmcnt(0)" ::: "memory"); SWRITE(0, SE); __syncthreads();
  qkt(pA0, pA1, K_lds, qr, r32, hi); partialSM(pA0, pA1, m_reg, mnA, alA);
  SLOAD(SO, KVBLK); if (2 < NT) SLOAD(SE, 2 * KVBLK);
  SWAIT(); SWRITE(1, SO); __syncthreads();
  for (int j = 1; j + 1 < NT; j += 2) {
    SBAR(); qkt(pB0, pB1, K_lds + SHM_K, qr, r32, hi);
    finishSM(pA0, pA1, alA, l_reg, pa0, pa1, pa2, pa3); SBAR();
    SLOAD(SO, (j + 2) * KVBLK); SBAR();
    pv_d0(o, vb0, pa0, pa1, pa2, pa3); partialSM(pB0, pB1, m_reg, mnB, alB);
    __syncthreads(); SWAIT(); SWRITE(0, SE);
    RESC(alB); __syncthreads();
    SBAR(); qkt(pA0, pA1, K_lds, qr, r32, hi);
    finishSM(pB0, pB1, alB, l_reg, pa0, pa1, pa2, pa3); SBAR();
    if (j + 3 < NT) SLOAD(SE, (j + 3) * KVBLK); SBAR();
    pv_d0(o, vb0 + (int)SHM_V, pa0, pa1, pa2, pa3); partialSM(pA0, pA1, m_reg, mnA, alA);
    __syncthreads(); SWAIT(); SWRITE(1, SO);
    RESC(alA); __syncthreads();
  }
  SBAR(); qkt(pB0, pB1, K_lds + SHM_K, qr, r32, hi);
  finishSM(pA0, pA1, alA, l_reg, pa0, pa1, pa2, pa3); SBAR();
  pv_d0(o, vb0, pa0, pa1, pa2, pa3); partialSM(pB0, pB1, m_reg, mnB, alB);
  __syncthreads(); RESC(alB);
  finishSM(pB0, pB1, alB, l_reg, pa0, pa1, pa2, pa3); SBAR();
  pv_d0(o, vb0 + (int)SHM_V, pa0, pa1, pa2, pa3);
  if (hi == 0) li_l[r32] = l_reg; asm volatile("s_waitcnt lgkmcnt(0)" ::: "memory");
  bf16_t* Ow = Ob + (long)(wid * QBLK) * 1024;
#pragma unroll
  for (int r = 0; r < 16; ++r) { const int orow = crow(r, hi); const float rl = __builtin_amdgcn_rcpf(li_l[orow]);
#pragma unroll
    for (int d0 = 0; d0 < 2; ++d0) Ow[(long)orow * 1024 + d0 * 32 + r32] = (bf16_t)(cvt_pk_bf16(o[d0][r] * rl, 0.f) & 0xffffu); }
#undef SLOAD
#undef SWRITE
#undef SWAIT
#undef RESC
}
}


#define XB_TMO      128
#define XB_XCNT(j)  (256  + 64 * (j))
#define XB_XSUB(j)  (1280 + 64 * (j))
#define XB_XGEN(j)  (2304 + 64 * (j))
#define XB_TOP      3328
#define XB_TOPGEN   3392
#define XCD_BAR_WORDS 3456
#define XB_SPIN_CAP (1u << 20)
__device__ __forceinline__ unsigned xb_ld(unsigned* p)              { return __hip_atomic_load(p, __ATOMIC_RELAXED, __HIP_MEMORY_SCOPE_AGENT); }
__device__ __forceinline__ unsigned xb_add(unsigned* p, unsigned v) { return __hip_atomic_fetch_add(p, v, __ATOMIC_RELAXED, __HIP_MEMORY_SCOPE_AGENT); }
__device__ __forceinline__ unsigned xb_xcc_id() { return (unsigned)__builtin_amdgcn_s_getreg((3 << 11) | 20) & 0xFu; }
#define XB_SPIN(cond, bar) do { unsigned _sp = 0; while (cond) { __builtin_amdgcn_s_sleep(1); \
    if ((++_sp & 255u) == 0u) { if (xb_ld(&(bar)[XB_TMO])) break; if (_sp > XB_SPIN_CAP) { atomicAdd(&(bar)[XB_TMO], 1u); break; } } } } while (0)
struct XcdBarrier { unsigned* bar; unsigned x; volatile LAS unsigned* st; };
__device__ __forceinline__ XcdBarrier xcd_barrier_post(unsigned* bar, volatile LAS unsigned* st) {
    XcdBarrier b; b.bar = bar; b.x = xb_xcc_id(); b.st = st;
    if (threadIdx.x == 0) (void)xb_add(&bar[XB_XCNT(b.x)], 1u);
    return b;
}
__device__ __forceinline__ void xcd_barrier_complete(unsigned* bar, unsigned x, unsigned& nloc, unsigned& nx) {
    const unsigned G = gridDim.x * gridDim.y * gridDim.z;
    unsigned sum, cnt, mine, sp = 0u;
    for (;;) {
        sum = 0u; cnt = 0u; mine = 0u;
#pragma unroll
        for (unsigned j = 0; j < 16; ++j) { const unsigned c = xb_ld(&bar[XB_XCNT(j)]); sum += c; cnt += (c > 0u) ? 1u : 0u; mine = (j == x) ? c : mine; }
        if (sum == G) break;
        __builtin_amdgcn_s_sleep(1);
        if ((++sp & 255u) == 0u) { if (xb_ld(&bar[XB_TMO])) break; if (sp > XB_SPIN_CAP) { atomicAdd(&bar[XB_TMO], 1u); break; } }
    }
    nloc = mine > 0u ? mine : 1u; nx = cnt > 0u ? cnt : 1u;
}
__device__ __forceinline__ void xcd_barrier(const XcdBarrier& b) {
    asm volatile("s_waitcnt vmcnt(0)" ::: "memory");
    __syncthreads();
    if (threadIdx.x == 0) {
        unsigned* bar = b.bar;
        __builtin_amdgcn_s_waitcnt(0);
        unsigned nloc = b.st[0], nx = b.st[1];
        if (nloc == 0u) { xcd_barrier_complete(bar, b.x, nloc, nx); b.st[0] = nloc; b.st[1] = nx; }
        const unsigned old = xb_add(&bar[XB_XSUB(b.x)], 1u);
        const unsigned gen = old / nloc;
        if (old + 1u == (gen + 1u) * nloc) {
            __builtin_amdgcn_fence(__ATOMIC_RELEASE, "agent");
            asm volatile("s_waitcnt vmcnt(0)" ::: "memory");
            const unsigned og = xb_add(&bar[XB_TOP], 1u);
            const unsigned tg = og / nx;
            if (og + 1u == (tg + 1u) * nx) xb_add(&bar[XB_TOPGEN], 1u);
            else XB_SPIN(xb_ld(&bar[XB_TOPGEN]) == tg, bar);
            __builtin_amdgcn_fence(__ATOMIC_ACQUIRE, "agent");
            xb_add(&bar[XB_XGEN(b.x)], 1u);
            asm volatile("s_waitcnt vmcnt(0)" ::: "memory");
        } else {
            XB_SPIN(xb_ld(&bar[XB_XGEN(b.x)]) == gen, bar);
            __builtin_amdgcn_fence(__ATOMIC_ACQUIRE, "agent");
            asm volatile("s_waitcnt vmcnt(0)" ::: "memory");
        }
    }
    __syncthreads();
}

constexpr int LDS_BYTES = 139264;
struct Args { const float* in[25]; float* out; unsigned char* ws; int ph_lo, ph_hi; };

__device__ __forceinline__ void tr_item(const float* W, int ldw, bf16_t* dst, int ldd, LAS float* scr, int lane) {
    float tv[32];
#pragma unroll
    for (int i = 0; i < 32; ++i) tv[i] = W[(size_t)(2 * i + (lane >> 5)) * ldw + (lane & 31)];
#pragma unroll
    for (int i = 0; i < 32; ++i) scr[(2 * i + (lane >> 5)) * 33 + (lane & 31)] = tv[i];
    asm volatile("s_waitcnt lgkmcnt(0)" ::: "memory");
    const int c = lane & 7;
#pragma unroll
    for (int j = 0; j < 4; ++j) { const int n = (lane >> 3) + 8 * j; const LAS float* s = scr + (8 * c) * 33 + n;
        u32x4 o; o.x = cvt_pk_bf16(s[0 * 33], s[1 * 33]); o.y = cvt_pk_bf16(s[2 * 33], s[3 * 33]); o.z = cvt_pk_bf16(s[4 * 33], s[5 * 33]); o.w = cvt_pk_bf16(s[6 * 33], s[7 * 33]);
        *(u32x4*)(dst + (size_t)n * ldd + 8 * c) = o; }
    asm volatile("s_waitcnt lgkmcnt(0)" ::: "memory");
}


struct P2Row { f32x4 q[3], k[3]; u32x2 v[2]; int kind, t, e; };
__device__ __forceinline__ f32x4 ld_bf4(const bf16_t* p) { const u32x2 w = *(const u32x2*)p; return (f32x4){bflo(w.x), bfhi(w.x), bflo(w.y), bfhi(w.y)}; }
__device__ __forceinline__ void p2_load(P2Row& r, int e, int j, int hh, int s, const bf16_t* QKV, const float* KROPE, const float* cache_kr) {
    const float* krp; r.e = e; r.t = 0;
    if (e < NCTX) { r.kind = 0; krp = KROPE + (size_t)e * 32; }
    else { const int b = (e - NCTX) / KVB, tt = (e - NCTX) - b * KVB;
        if (tt < LLAT) { r.kind = 1; r.t = tt; krp = KROPE + (size_t)(NCTX + b * LLAT + tt) * 32; }
        else { r.kind = 2; krp = cache_kr + (((size_t)b * 2 + j) * 512 + (tt - LLAT)) * 32; } }
    const bf16_t* raw = QKV + (size_t)e * QLD;
#pragma unroll
    for (int jj = 0; jj < 3; ++jj) r.q[jj] = ld_bf4(raw + hh * 96 + 4 * (s + 8 * jj));
#pragma unroll
    for (int jj = 0; jj < 2; ++jj) { r.k[jj] = ld_bf4(raw + 768 + hh * 128 + 4 * (s + 8 * jj)); r.v[jj] = *(const u32x2*)(raw + 768 + hh * 128 + 64 + 4 * (s + 8 * jj)); }
    r.k[2] = *(const f32x4*)(krp + 4 * s);
}
__device__ __forceinline__ void p2_compute(P2Row& r, int s, const float* qn, const float* kn, const float* ROPE) {
    float sq = 0.f, sk = 0.f;
#pragma unroll
    for (int jj = 0; jj < 3; ++jj) { sq += (r.q[jj][0] * r.q[jj][0] + r.q[jj][1] * r.q[jj][1]) + (r.q[jj][2] * r.q[jj][2] + r.q[jj][3] * r.q[jj][3]);
                                     sk += (r.k[jj][0] * r.k[jj][0] + r.k[jj][1] * r.k[jj][1]) + (r.k[jj][2] * r.k[jj][2] + r.k[jj][3] * r.k[jj][3]); }
    sq += __shfl_xor(sq, 1); sq += __shfl_xor(sq, 2); sq += __shfl_xor(sq, 4);
    sk += __shfl_xor(sk, 1); sk += __shfl_xor(sk, 2); sk += __shfl_xor(sk, 4);
    const float rq = 1.0f / sqrtf(sq * (1.0f / 96.0f) + EPS), rk = 1.0f / sqrtf(sk * (1.0f / 96.0f) + EPS);
#pragma unroll
    for (int jj = 0; jj < 3; ++jj) { r.q[jj] = r.q[jj] * rq * *(const f32x4*)(qn + 4 * (s + 8 * jj)); r.k[jj] = r.k[jj] * rk * *(const f32x4*)(kn + 4 * (s + 8 * jj)); }
    f32x4 qp, kp;
#pragma unroll
    for (int c = 0; c < 4; ++c) { qp[c] = __shfl_xor(r.q[2][c], 2); kp[c] = __shfl_xor(r.k[2][c], 2); }
    if (r.kind == 1) {
        const int a = s >> 2, fi0 = (s & 1) * 4; const bool second = (s & 2) != 0;
        const f32x4 cs = *(const f32x4*)(ROPE + (size_t)r.t * 16 + a * 8 + fi0), sn = *(const f32x4*)(ROPE + 65536 + (size_t)r.t * 16 + a * 8 + fi0);
        if (!second) { r.q[2] = r.q[2] * cs - qp * sn; r.k[2] = r.k[2] * cs - kp * sn; }
        else { r.q[2] = qp * sn + r.q[2] * cs; r.k[2] = kp * sn + r.k[2] * cs; }
    }
}
__device__ __forceinline__ void p2_store(const P2Row& r, int hh, int s, bf16_t* QKV) {
    bf16_t* orow = QKV + (size_t)r.e * QLD;
#pragma unroll
    for (int jj = 0; jj < 3; ++jj) {
        if (r.kind != 2) { u32x2 w; w.x = cvt_pk_bf16(r.q[jj][0], r.q[jj][1]); w.y = cvt_pk_bf16(r.q[jj][2], r.q[jj][3]); *(u32x2*)(orow + hh * 96 + 4 * (s + 8 * jj)) = w; }
        u32x2 w2; w2.x = cvt_pk_bf16(r.k[jj][0], r.k[jj][1]); w2.y = cvt_pk_bf16(r.k[jj][2], r.k[jj][3]); *(u32x2*)(orow + 768 + hh * 96 + 4 * (s + 8 * jj)) = w2; }
#pragma unroll
    for (int jj = 0; jj < 2; ++jj) *(u32x2*)(orow + 1536 + hh * 64 + 4 * (s + 8 * jj)) = r.v[jj];
}
struct P1Row { f32x4 q4, k4, r4; };
__device__ __forceinline__ void p1_load(P1Row& p, const float* pr, int lane) {
    p.q4 = *(const f32x4*)(pr + 4 * lane);
    p.k4 = (f32x4){0.f, 0.f, 0.f, 0.f}; if (lane < 32) p.k4 = *(const f32x4*)(pr + 256 + 4 * lane);
    p.r4 = (f32x4){0.f, 0.f, 0.f, 0.f}; if (lane < 8) p.r4 = *(const f32x4*)(pr + 384 + 4 * lane);
}
__device__ __forceinline__ void p1_finish(const P1Row& p, int r, int j, int lane, const float* qan, const float* kvan, bf16_t* QKVLAT, float* KROPE, float* OUT_CKV, float* OUT_KR) {
    const int e = r < NCTX ? r : NCTX + ((r - NCTX) >> 12) * KVB + ((r - NCTX) & 4095);
    const float ssq = wave_sum((p.q4[0] * p.q4[0] + p.q4[1] * p.q4[1]) + (p.q4[2] * p.q4[2] + p.q4[3] * p.q4[3]));
    const float ssk = wave_sum((p.k4[0] * p.k4[0] + p.k4[1] * p.k4[1]) + (p.k4[2] * p.k4[2] + p.k4[3] * p.k4[3]));
    const float rq = 1.0f / sqrtf(ssq * (1.0f / 256.0f) + EPS), rk = 1.0f / sqrtf(ssk * (1.0f / 128.0f) + EPS);
    const f32x4 qo = p.q4 * rq * *(const f32x4*)(qan + 4 * lane);
    u32x2 w; w.x = cvt_pk_bf16(qo[0], qo[1]); w.y = cvt_pk_bf16(qo[2], qo[3]); *(u32x2*)(QKVLAT + (size_t)e * 384 + 4 * lane) = w;
    if (lane < 32) { const f32x4 ko = p.k4 * rk * *(const f32x4*)(kvan + 4 * lane); u32x2 w2; w2.x = cvt_pk_bf16(ko[0], ko[1]); w2.y = cvt_pk_bf16(ko[2], ko[3]);
        *(u32x2*)(QKVLAT + (size_t)e * 384 + 256 + 4 * lane) = w2;
        if (r < NCTX) *(f32x4*)(OUT_CKV + (((size_t)(r >> 8) * 2 + j) * 256 + (r & 255)) * 128 + 4 * lane) = ko; }
    if (lane < 8) { *(f32x4*)(KROPE + (size_t)r * 32 + 4 * lane) = p.r4;
        if (r < NCTX) *(f32x4*)(OUT_KR + (((size_t)(r >> 8) * 2 + j) * 256 + (r & 255)) * 32 + 4 * lane) = p.r4; }
}

#define DERIVE_PTRS \
    unsigned char* ws = args.ws; \
    float* X = args.out; \
    float* OUT_CKV = args.out + (size_t)MTOK * 1024; float* OUT_KR = OUT_CKV + (size_t)32 * 2 * 256 * 128; \
    bf16_t* W13 = (bf16_t*)(ws + OFF_W13); bf16_t* W2 = (bf16_t*)(ws + OFF_W2); bf16_t* WIN = (bf16_t*)(ws + OFF_WIN); bf16_t* WQKV = (bf16_t*)(ws + OFF_WQKV); \
    bf16_t* WOUT = (bf16_t*)(ws + OFF_WOUT); bf16_t* POOLT = (bf16_t*)(ws + OFF_POOLT); bf16_t* WSB = (bf16_t*)(ws + OFF_WS); \
    float* MOD = (float*)(ws + OFF_MOD); float* ROPE = (float*)(ws + OFF_ROPE); \
    bf16_t* H = (bf16_t*)(ws + OFF_H); bf16_t* MIX = H; \
    unsigned char* R = ws + OFF_R; \
    bf16_t* U = (bf16_t*)(R + R_U); bf16_t* PB = (bf16_t*)R; bf16_t* H2 = (bf16_t*)R; \
    float* RSS = (float*)(ws + OFF_RSS); float* B13 = (float*)(ws + OFF_B13); float* BIN = (float*)(ws + OFF_BIN); \
    bf16_t* QKVLAT = (bf16_t*)(R + R_QKVLAT); float* KROPE = (float*)(R + R_KROPE); float* PROJ = (float*)(R + R_PROJ); \
    bf16_t* GM = (bf16_t*)(R + R_GM); float* QKVRAW = (float*)(R + R_QKVRAW); bf16_t* QKV = (bf16_t*)(R + R_QKVRAW);

__global__ void __launch_bounds__(512, 2) fwd_mega(Args args) {
    extern __shared__ __attribute__((aligned(16))) unsigned char lds[];
    cg::grid_group grid = cg::this_grid();
    int tid = threadIdx.x, lane = tid & 63, wave = __builtin_amdgcn_readfirstlane(tid >> 6);
    const int G = gridDim.x, bid = blockIdx.x;
    int gw = bid * 8 + wave; const int NGW = G * 8;
    long gt = (long)bid * 512 + tid; const long NGT = (long)G * 512;
    const int lo = args.ph_lo, hi = args.ph_hi;
    int pid = 0;
    unsigned* BARW = (unsigned*)(args.ws + OFF_CTL);
    volatile LAS unsigned* MISC = (volatile LAS unsigned*)((LAS unsigned char*)lds + 131072);
    if (tid < 16) MISC[tid] = 0u;
    if (bid == 0) for (int i = tid; i < XCD_BAR_WORDS; i += 512) BARW[i] = 0u;
    __syncthreads();
    XcdBarrier xbar; xbar.bar = BARW; xbar.x = 0; xbar.st = MISC;

    for (int rep0 = 0; rep0 < ((DUPMASK & 1) ? 2 : 1); ++rep0)
    if (EN_PRO && pid >= lo && pid < hi) {
        DERIVE_PTRS
        if (bid < 288) {
            LAS float* S = (LAS float*)lds; LAS float* P = (LAS float*)(lds + 36864);
            for (int idx = tid; idx < 9216; idx += 512) { const int cv = idx >> 10, k = idx & 1023; const float x = cv == 0 ? args.in[5][k] : args.in[4][(cv - 1) * 1024 + k]; S[idx] = x / (1.0f + expf(-x)); }
            __syncthreads();
            for (int item = bid; item < 288; item += G) {
                const int l = item / 72, cb = item % 72, j = tid & 127, s = tid >> 7;
                float acc[9];
#pragma unroll
                for (int cv = 0; cv < 9; ++cv) acc[cv] = 0.f;
                const float* wp = args.in[6] + ((size_t)l * 1024 + s * 256) * NMOD + cb * 128 + j;
                for (int k = 0; k < 256; k += 16) {
                    float wv[16];
#pragma unroll
                    for (int i = 0; i < 16; ++i) wv[i] = wp[(size_t)(k + i) * NMOD];
#pragma unroll
                    for (int cv = 0; cv < 9; ++cv) { const LAS float* sp = S + cv * 1024 + s * 256 + k;
#pragma unroll
                        for (int i = 0; i < 16; ++i) acc[cv] += sp[i] * wv[i]; }
                }
#pragma unroll
                for (int cv = 0; cv < 9; ++cv) P[(s * 9 + cv) * 128 + j] = acc[cv];
                __syncthreads();
                for (int idx = tid; idx < 1152; idx += 512) { const int cv = idx >> 7, jj = idx & 127;
                    const float v = P[(0 * 9 + cv) * 128 + jj] + P[(1 * 9 + cv) * 128 + jj] + P[(2 * 9 + cv) * 128 + jj] + P[(3 * 9 + cv) * 128 + jj] + args.in[7][l * NMOD + cb * 128 + jj];
                    MOD[((size_t)l * 9 + cv) * NMOD + cb * 128 + jj] = v; }
                __syncthreads();
            }
        }
        __syncthreads();
        {
            LAS float* scr = (LAS float*)(lds + 57344 + wave * 8448);
            for (int it0 = gw; it0 < 36832; it0 += NGW) {
                int it = it0; const float* src; int ldw, ldd; bf16_t* dst;
                if (it < 33792) { const int ls = it / 4224, r = it % 4224, which = r / 1408, q = r % 1408;
                    if (which < 2) { const int kb = q / 88, nb = q % 88, k0 = kb * 64, n0 = nb * 32; src = args.in[which ? 10 : 9] + (size_t)ls * 1024 * FF + (size_t)k0 * FF + n0; ldw = FF;
                        const int drow = (n0 >> 7) * 256 + (n0 & 127) + which * 128; dst = W13 + (size_t)ls * 5632 * 1024 + (size_t)drow * 1024 + k0; ldd = 1024; }
                    else { const int kb = q / 32, nb = q % 32, k0 = kb * 64, n0 = nb * 32; src = args.in[11] + (size_t)ls * FF * 1024 + (size_t)k0 * 1024 + n0; ldw = 1024;
                        dst = W2 + (size_t)ls * 1024 * FF + (size_t)n0 * FF + k0; ldd = FF; } }
                else { it -= 33792;
                if (it < 1440) { const int j = it / 720, q = it % 720, kb = q / 45, nb = q % 45, k0 = kb * 64, n0 = nb * 32; src = args.in[12] + (size_t)j * 1024 * 1440 + (size_t)k0 * 1440 + n0; ldw = 1440;
                    const int drow = n0 < 416 ? n0 : n0 + 96; dst = WIN + (size_t)j * 1536 * 1024 + (size_t)drow * 1024 + k0; ldd = 1024; }
                else { it -= 1440;
                if (it < 192) { const int j = it / 96, q = it % 96, kb = q / 24, nb = q % 24, k0 = kb * 64, n0 = nb * 32; src = args.in[15] + (size_t)j * 256 * 768 + (size_t)k0 * 768 + n0; ldw = 768;
                    dst = WQKV + (size_t)j * 1792 * 384 + (size_t)n0 * 384 + k0; ldd = 384; }
                else { it -= 192;
                if (it < 128) { const int j = it / 64, q = it % 64, kb = q / 32, nb = q % 32, k0 = kb * 64, n0 = nb * 32; src = args.in[16] + (size_t)j * 128 * 1024 + (size_t)k0 * 1024 + n0; ldw = 1024;
                    dst = WQKV + (size_t)j * 1792 * 384 + (size_t)(768 + n0) * 384 + 256 + k0; ldd = 384; }
                else { it -= 128;
                if (it < 1024) { const int j = it / 512, q = it % 512, kb = q / 32, nb = q % 32, k0 = kb * 64, n0 = nb * 32; src = args.in[22] + (size_t)j * 1024 * 1024 + (size_t)k0 * 1024 + n0; ldw = 1024;
                    dst = WOUT + (size_t)j * 1024 * 1024 + (size_t)n0 * 1024 + k0; ldd = 1024; }
                else { it -= 1024;
                    const int jg = it / 32, q = it % 32, kb = q / 8, nb = q % 8, k0 = kb * 64, n0 = nb * 32; src = args.in[23] + (size_t)jg * 65536 + (size_t)k0 * 256 + n0; ldw = 256;
                    dst = POOLT + (size_t)jg * 65536 + (size_t)n0 * 256 + k0; ldd = 256; } } } } }
                tr_item(src, ldw, dst, ldd, scr, lane);
            }
        }
        {
            const u32x4 z = {0u, 0u, 0u, 0u};
            for (long i = gt; i < 2 * 12288; i += NGT) { const int j = (int)(i / 12288); const long q = i % 12288; *(u32x4*)(WIN + (size_t)j * 1536 * 1024 + (size_t)416 * 1024 + q * 8) = z; }
            for (long i = gt; i < 2 * 45056; i += NGT) { const int j = (int)(i / 45056); const long q = i % 45056; bf16_t* base = WQKV + (size_t)j * 1792 * 384;
                if (q < 12288) { const int row = (int)(q >> 4), c = (int)(q & 15); *(u32x4*)(base + (size_t)row * 384 + 256 + c * 8) = z; }
                else { const long q2 = q - 12288; const int row = 768 + (int)(q2 >> 5), c = (int)(q2 & 31); *(u32x4*)(base + (size_t)row * 384 + c * 8) = z; } }
        }
        for (long i = gt; i < 131072 / 4; i += NGT) { const f32x4 v = *(const f32x4*)(args.in[20] + i * 4); u32x2 w; w.x = cvt_pk_bf16(v[0], v[1]); w.y = cvt_pk_bf16(v[2], v[3]); *(u32x2*)(WSB + i * 4) = w; }
        for (long i = gt; i < 65536; i += NGT) { const int t = (int)(i >> 4), ai = (int)(i & 15), a = ai >> 3, fi = ai & 7;
            const float inv = powf(10000.0f, -(float)(2 * fi) / 16.0f); const float pos = (float)(a == 0 ? (t >> 6) : (t & 63)); const float ang = pos * inv;
            ROPE[i] = cosf(ang); ROPE[65536 + i] = sinf(ang); }
        { const f32x4 z4 = {0.f, 0.f, 0.f, 0.f}; for (long i = gt; i < (long)12 * MTOK / 4; i += NGT) *(f32x4*)(RSS + i * 4) = z4; }
    }
    grid.sync();
    xbar = xcd_barrier_post(BARW, MISC);
    ++pid;
    for (int rep1 = 0; rep1 < ((DUPMASK & 2) ? 2 : 1); ++rep1)
    if (pid >= lo && pid < hi) {
        DERIVE_PTRS
        for (int it = gw; it < 8 * 5632 + 2 * 1536; it += NGW) {
            const bf16_t* wrow; const float* shp; float* outp; int cvs;
            if (it < 8 * 5632) { const int ls = it / 5632, n = it - ls * 5632, l = ls >> 1, sub = ls & 1; wrow = W13 + ((size_t)ls * 5632 + n) * 1024;
                shp = MOD + (size_t)l * 9 * NMOD + (sub ? 6 : 0) * 1024; outp = B13 + (size_t)ls * 9 * 5632 + n; cvs = 5632; }
            else { const int q = it - 8 * 5632, jj = q / 1536, n = q - jj * 1536; wrow = WIN + ((size_t)jj * 1536 + n) * 1024;
                shp = MOD + (size_t)(2 * jj) * 9 * NMOD + 3 * 1024; outp = BIN + (size_t)jj * 9 * 1536 + n; cvs = 1536; }
            const u32x4 w0 = *(const u32x4*)(wrow + lane * 8), w1 = *(const u32x4*)(wrow + 512 + lane * 8);
            float wv[16];
#pragma unroll
            for (int e = 0; e < 4; ++e) { wv[2 * e] = bflo(w0[e]); wv[2 * e + 1] = bfhi(w0[e]); wv[8 + 2 * e] = bflo(w1[e]); wv[8 + 2 * e + 1] = bfhi(w1[e]); }
            float res = 0.f;
#pragma unroll
            for (int cv = 0; cv < 9; ++cv) { const float* sp = shp + (size_t)cv * NMOD; float a = 0.f;
#pragma unroll
                for (int hf = 0; hf < 2; ++hf) { const f32x4 s0 = *(const f32x4*)(sp + hf * 512 + lane * 8), s1 = *(const f32x4*)(sp + hf * 512 + lane * 8 + 4);
                    a += (s0[0] * wv[hf * 8 + 0] + s0[1] * wv[hf * 8 + 1]) + (s0[2] * wv[hf * 8 + 2] + s0[3] * wv[hf * 8 + 3]) + (s1[0] * wv[hf * 8 + 4] + s1[1] * wv[hf * 8 + 5]) + (s1[2] * wv[hf * 8 + 6] + s1[3] * wv[hf * 8 + 7]); }
                a = wave_sum(a); if (lane == cv) res = a; }
            if (lane < 9) outp[(size_t)lane * cvs] = res;
        }
        for (int rb = gw; rb < MTOK; rb += 2 * NGW) {
            f32x4 v[2][4]; float ss[2]; int rr[2];
#pragma unroll
            for (int u2 = 0; u2 < 2; ++u2) { const int r = (rb + u2 * NGW < MTOK) ? rb + u2 * NGW : rb; rr[u2] = r;
                const float* xr = r < NCTX ? args.in[0] + (size_t)r * 1024 : args.in[1] + (size_t)(r - NCTX) * 1024; ss[u2] = 0.f;
#pragma unroll
                for (int q = 0; q < 4; ++q) { v[u2][q] = *(const f32x4*)(xr + 4 * lane + 256 * q); ss[u2] += (v[u2][q][0] * v[u2][q][0] + v[u2][q][1] * v[u2][q][1]) + (v[u2][q][2] * v[u2][q][2] + v[u2][q][3] * v[u2][q][3]); } }
#pragma unroll
            for (int u2 = 0; u2 < 2; ++u2) { if (u2 == 1 && rb + NGW >= MTOK) break; const int r = rr[u2]; const int cv = cv_of_row(r);
                const float* scp = MOD + (size_t)cv * NMOD + 1024; const float* gptr = args.in[8];
                const float st = wave_sum(ss[u2]); if (lane == 0) RSS[r] = st;
#pragma unroll
                for (int q = 0; q < 4; ++q) { const int c = 4 * lane + 256 * q; const f32x4 g4 = *(const f32x4*)(gptr + c), sc = *(const f32x4*)(scp + c);
                    *(f32x4*)(X + (size_t)r * 1024 + c) = v[u2][q];
                    const f32x4 hh = v[u2][q] * g4 * (sc + 1.0f); u32x2 w; w.x = cvt_pk_bf16(hh[0], hh[1]); w.y = cvt_pk_bf16(hh[2], hh[3]);
                    *(u32x2*)(H + (size_t)r * 1024 + c) = w; } }
        }
        if (pid + 1 < hi) xcd_barrier(xbar);
    }
    ++pid;

    for (int layer = 0; layer < 4; ++layer) {
        const int j = layer >> 1;
        const unsigned long long prog = (layer & 1) ? 0xDCFE32ull : 0xDCA9876532ull;
        const int nsteps = (layer & 1) ? 6 : 10;
        for (int step = 0; step < nsteps; ++step, ++pid) {
            if (!(pid >= lo && pid < hi)) continue;
            const int op = (int)((prog >> (4 * step)) & 15ull);
            const int reps = ((DUPMASK >> op) & 1) ? 2 : 1;
            for (int rep = 0; rep < reps; ++rep) {
            DERIVE_PTRS
            int bid = blockIdx.x; asm volatile("" : "+s"(bid)); int G = gridDim.x; asm volatile("" : "+s"(G));
            const int NGW = G * 8; const long NGT = (long)G * 512;
            const float* MODL = MOD + (size_t)layer * 9 * NMOD;
            tid = threadIdx.x; asm volatile("" : "+v"(tid)); lane = tid & 63; wave = __builtin_amdgcn_readfirstlane(tid >> 6); gw = bid * 8 + wave; gt = (long)bid * 512 + tid;
            if (EN_G1 && (op == 2 || op == 12)) {
                const int sub = op == 2 ? 0 : 1;
                const bf16_t* Ain = (sub == 1 && !(layer & 1)) ? H2 : H;
                pg8::Gemm g{Ain, W13 + (size_t)(layer * 2 + sub) * 5632 * 1024, MTOK, 5632, 1024, 1024, 1024, 0};
                pg8::StaticOrder S; S.init(MTOK, 5632, G, bid);
                pg8::EpiSwiglu E{U, RSS + (size_t)(layer * 3 + (sub ? 2 : 0)) * MTOK, B13 + (size_t)(layer * 2 + sub) * 9 * 5632};
                pg8::gemm_phase<pg8::EpiSwiglu>((LAS unsigned char*)lds, g, S, E);
            } else if (EN_GRES && (op == 3 || op == 13 || op == 10 || op == 15)) {
                const bf16_t* gA; const bf16_t* gB; int gK, glda, gldb, gapn; const float* egate; const float* escale; float ecoef;
                if (op == 3 || op == 13) { const int sub = op == 3 ? 0 : 1; gA = U; gB = W2 + (size_t)(layer * 2 + sub) * 1024 * FF; gK = FF; glda = FF; gldb = FF; gapn = 0;
                    egate = MODL + (sub ? 8 : 2) * 1024; escale = nullptr; ecoef = 0.5f; }
                else if (op == 10) { gA = MIX; gB = WOUT + (size_t)j * 1024 * 1024; gK = 1024; glda = 1024; gldb = 1024; gapn = 0; egate = MODL + 5 * 1024; escale = nullptr; ecoef = 1.0f; }
                else { gA = PB; gB = POOLT + (size_t)j * 1024 * 256; gK = 256; glda = 1024; gldb = 256; gapn = 512; egate = MODL + 5 * 1024; escale = args.in[24] + (size_t)j * 1024; ecoef = 1.0f; }
                int ln = layer, kn; bf16_t* an = H;
                if (op == 3) kn = 1; else if (op == 13) { ln = layer + 1; kn = 0; } else { kn = 2; if (op == 10) an = H2; }
                if (ln >= 4) { an = nullptr; ln = 0; }
                const pg8::Gemm g{gA, gB, MTOK, 1024, gK, glda, gldb, gapn};
                const pg8::EpiResid E{X, egate, escale, an, args.in[8] + ((size_t)ln * 3 + kn) * 1024, MOD + (size_t)ln * 9 * NMOD + (3 * kn + 1) * 1024, RSS + (size_t)(ln * 3 + kn) * MTOK, ecoef, 0};
                pg8::StaticOrder S; S.init(MTOK, 1024, G, bid, 1);
                pg8::gemm_phase<pg8::EpiResid, true>((LAS unsigned char*)lds, g, S, E);
            } else if (EN_GRAW && (op == 5 || op == 7)) {
                const bool gin = op == 5;
                const pg8::Gemm g{gin ? (const bf16_t*)H : (const bf16_t*)QKVLAT, gin ? WIN + (size_t)j * 1536 * 1024 : WQKV + (size_t)j * 1792 * 384, gin ? MTOK : MEXT, gin ? 1536 : 1792, gin ? 1024 : 384, gin ? 1024 : 384, gin ? 1024 : 384, 0};
                const pg8::EpiRaw E{PROJ, gin ? GM : QKV, gin ? RSS + (size_t)(layer * 3 + 1) * MTOK : (const float*)nullptr, BIN + (size_t)j * 9 * 1536, 512, gin ? 2 : 0, gin ? 1024 : QLD, gin ? 1 : 0};
                pg8::StaticOrder S; S.init(gin ? MTOK : MEXT, gin ? 1536 : 1792, G, bid);
                pg8::gemm_phase<pg8::EpiRaw>((LAS unsigned char*)lds, g, S, E);
            } else if (EN_POST1 && op == 6) {
                {
                    LAS float* rs = (LAS float*)lds; LAS bf16_t* tT = (LAS bf16_t*)(lds + 1024);
                    const float* vn = args.in[19] + (size_t)j * 512; const float* gb = args.in[21] + (size_t)j * 512;
                    for (int item = bid; item < 1280; item += G) {
                        const int chunk = item >> 2, gq = item & 3; const size_t tok0 = (size_t)chunk * 128;
                        { u32x4 wv[16];
#pragma unroll
                          for (int tt = 0; tt < 16; ++tt) wv[tt] = *(const u32x4*)(GM + (tok0 + wave * 16 + tt) * 1024 + 512 + lane * 8);
#pragma unroll
                          for (int tt = 0; tt < 16; ++tt) { float ss = 0.f;
#pragma unroll
                            for (int e = 0; e < 4; ++e) { const float a = bflo(wv[tt][e]), b = bfhi(wv[tt][e]); ss += a * a + b * b; }
                            ss = wave_sum(ss); if (lane == 0) rs[wave * 16 + tt] = 1.0f / sqrtf(ss * (1.0f / 512.0f) + EPS); } }
                        __syncthreads();
                        { const int q = tid >> 2, cp = tid & 3; const float rq = rs[q];
#pragma unroll
                          for (int cc = 0; cc < 4; ++cc) { const int c0 = cp * 32 + cc * 8; const u32x4 w = *(const u32x4*)(GM + (tok0 + q) * 1024 + 512 + gq * 128 + c0);
                              const f32x4 n0 = *(const f32x4*)(vn + gq * 128 + c0), n1 = *(const f32x4*)(vn + gq * 128 + c0 + 4);
                              float v[8] = {bflo(w[0]) * n0[0], bfhi(w[0]) * n0[1], bflo(w[1]) * n0[2], bfhi(w[1]) * n0[3], bflo(w[2]) * n1[0], bfhi(w[2]) * n1[1], bflo(w[3]) * n1[2], bfhi(w[3]) * n1[3]};
#pragma unroll
                              for (int e = 0; e < 8; ++e) tT[(c0 + e) * 136 + q] = (bf16_t)(cvt_pk_bf16(v[e] * rq, 0.f) & 0xffffu); } }
                        __syncthreads();
                        f32x4 acc[8];
#pragma unroll
                        for (int n = 0; n < 8; ++n) acc[n] = (f32x4){0.f, 0.f, 0.f, 0.f};
                        const bf16_t* wsp = WSB + ((size_t)(j * 4 + gq) * 128 + wave * 16 + (lane & 15)) * 128 + 8 * (lane >> 4);
#pragma unroll
                        for (int ks = 0; ks < 4; ++ks) { const bf16x8 a = *(const bf16x8*)(wsp + 32 * ks);
#pragma unroll
                            for (int n = 0; n < 8; ++n) { const bf16x8 b = *(const LAS bf16x8*)(tT + (16 * n + (lane & 15)) * 136 + 32 * ks + 8 * (lane >> 4));
                                acc[n] = __builtin_amdgcn_mfma_f32_16x16x32_bf16(b, a, acc[n], 0, 0, 0); } }
                        { const int p = wave * 16 + (lane & 15); const size_t tok = tok0 + p; const float bsp = gb[gq * 128 + p];
                          u32x2 uu[8];
#pragma unroll
                          for (int n = 0; n < 8; ++n) uu[n] = *(const u32x2*)(GM + tok * 1024 + gq * 128 + 16 * n + 4 * (lane >> 4));
#pragma unroll
                          for (int n = 0; n < 8; ++n) { u32x2 w; w.x = cvt_pk_bf16(bflo(uu[n].x) * (acc[n][0] + bsp), bfhi(uu[n].x) * (acc[n][1] + bsp)); w.y = cvt_pk_bf16(bflo(uu[n].y) * (acc[n][2] + bsp), bfhi(uu[n].y) * (acc[n][3] + bsp));
                              *(u32x2*)(MIX + tok * 1024 + 512 + gq * 128 + 16 * n + 4 * (lane >> 4)) = w; } }
                        __syncthreads();
                    }
                }
                const float* qan = args.in[13] + (size_t)j * 256; const float* kvan = args.in[14] + (size_t)j * 128;
                for (int r = gw; r < MTOK; r += 2 * NGW) {
                    const int r1 = r + NGW; const bool has1 = r1 < MTOK;
                    P1Row p0, p1; p1_load(p0, PROJ + (size_t)r * 512, lane); p1_load(p1, PROJ + (size_t)(has1 ? r1 : r) * 512, lane);
                    p1_finish(p0, r, j, lane, qan, kvan, QKVLAT, KROPE, OUT_CKV, OUT_KR); if (has1) p1_finish(p1, r1, j, lane, qan, kvan, QKVLAT, KROPE, OUT_CKV, OUT_KR);
                }
                for (int cidx = gw; cidx < 4096; cidx += NGW) {
                    const int b = cidx >> 9, p = cidx & 511; const int e = NCTX + b * KVB + LLAT + p;
                    const u32x2 z = {0u, 0u}; *(u32x2*)(QKVLAT + (size_t)e * 384 + 4 * lane) = z;
                    if (lane < 32) { const f32x4 kv = *(const f32x4*)(args.in[2] + (((size_t)b * 2 + j) * 512 + p) * 128 + 4 * lane); u32x2 w2; w2.x = cvt_pk_bf16(kv[0], kv[1]); w2.y = cvt_pk_bf16(kv[2], kv[3]);
                        *(u32x2*)(QKVLAT + (size_t)e * 384 + 256 + 4 * lane) = w2; }
                }
            } else if (EN_POST2 && op == 8) {
                const float* qn = args.in[17] + (size_t)j * 96; const float* kn = args.in[18] + (size_t)j * 96;
                const int hh = lane >> 3, s = lane & 7;
                for (int e = gw; e < MEXT; e += 2 * NGW) {
                    const int e1 = e + NGW; const bool has1 = e1 < MEXT;
                    P2Row r0, r1;
                    p2_load(r0, e, j, hh, s, QKV, KROPE, args.in[3]); p2_load(r1, has1 ? e1 : e, j, hh, s, QKV, KROPE, args.in[3]);
                    p2_compute(r0, s, qn, kn, ROPE); p2_compute(r1, s, qn, kn, ROPE);
                    asm volatile("s_waitcnt vmcnt(0)" ::: "memory");
                    p2_store(r0, hh, s, QKV); if (has1) p2_store(r1, hh, s, QKV);
                    asm volatile("" ::: "memory");
                }
            } else if (EN_ATT && op == 9) {
                const int vcu = (G % 8 == 0) ? (bid % 8) * (G / 8) + bid / 8 : bid;
                for (int u = vcu; u < 1280; u += G) {
                    const bf16_t *Qb, *Kh, *Vh; bf16_t* Ob; int seq;
                    if (u < 1024) { const int bh = u >> 4, qt = u & 15, b = bh >> 3, h = bh & 7; const size_t e0 = NCTX + (size_t)b * KVB;
                        Qb = QKV + (e0 + qt * 256) * QLD + h * 96; Kh = QKV + e0 * QLD + 768 + h * 96; Vh = QKV + e0 * QLD + 1536 + h * 64;
                        Ob = MIX + ((size_t)NCTX + (size_t)b * LLAT + qt * 256) * 1024 + h * 64; seq = KVB; }
                    else { const int vv = u - 1024, b = vv >> 3, h = vv & 7; const size_t e0 = (size_t)b * 256;
                        Qb = QKV + e0 * QLD + h * 96; Kh = QKV + e0 * QLD + 768 + h * 96; Vh = QKV + e0 * QLD + 1536 + h * 64; Ob = MIX + e0 * 1024 + h * 64; seq = 256; }
                    __syncthreads();
                    att::attn_unit(Qb, Kh, Vh, Ob, seq, (char*)lds);
                }
            } else if (EN_POOL && op == 14) {
                const float* rs = RSS + (size_t)(layer * 3 + 1) * MTOK;
                for (long i = gt; i < (long)(MTOK / 32) * 128; i += NGT) {
                    const int seg = (int)(i >> 7), ch = (int)(i & 127), hw = 1 << (ch >> 5);
                    const int r0 = seg * 32; int t0, L; if (r0 < NCTX) { t0 = r0 & 255; L = 256; } else { t0 = (r0 - NCTX) & 4095; L = 4096; }
                    const int base = r0 - t0; const bf16_t* __restrict__ hp = H + (size_t)base * 1024 + ch * 8; const float* __restrict__ rsp = rs + base; bf16_t* __restrict__ pbp = PB + (size_t)base * 1024 + ch * 8;
                    float sum[8];
#pragma unroll
                    for (int e2 = 0; e2 < 8; ++e2) sum[e2] = 0.f;
#define POOL_LD(tt, wgt) do { const u32x4 w_ = *(const u32x4*)(hp + (size_t)(tt) * 1024); const float q_ = (wgt) / sqrtf(rsp[tt] * (1.0f / 1024.0f) + EPS); \
                        _Pragma("unroll") for (int e2 = 0; e2 < 4; ++e2) { sum[2 * e2] += bflo(w_[e2]) * q_; sum[2 * e2 + 1] += bfhi(w_[e2]) * q_; } } while (0)
#pragma unroll
                    for (int i2 = 0; i2 < 16; ++i2) { const int tt = t0 - hw + i2; const bool ok = (i2 < 2 * hw) && tt >= 0; const int tc = tt < 0 ? 0 : (tt > L - 1 ? L - 1 : tt); POOL_LD(tc, ok ? 1.0f : 0.0f); }
#pragma unroll 4
                    for (int t = t0; t < t0 + 32; ++t) {
                        const int lo2 = t - hw < 0 ? 0 : t - hw, hi2 = t + hw > L ? L : t + hw; const float inv = 1.0f / (float)(hi2 - lo2);
                        const u32x4 w0 = *(const u32x4*)(hp + (size_t)t * 1024); const float q0 = 1.0f / sqrtf(rsp[t] * (1.0f / 1024.0f) + EPS); u32x4 o;
#pragma unroll
                        for (int e2 = 0; e2 < 4; ++e2) o[e2] = cvt_pk_bf16(sum[2 * e2] * inv - bflo(w0[e2]) * q0, sum[2 * e2 + 1] * inv - bfhi(w0[e2]) * q0);
                        *(u32x4*)(pbp + (size_t)t * 1024) = o;
                        { const int tp = t + hw, tm = t - hw; const int tpc = tp > L - 1 ? L - 1 : tp, tmc = tm < 0 ? 0 : tm;
                          POOL_LD(tpc, tp < L ? 1.0f : 0.0f); POOL_LD(tmc, tm >= 0 ? -1.0f : 0.0f); }
                    }
#undef POOL_LD
                }
            }
            if (rep + 1 < reps || pid + 1 < hi) xcd_barrier(xbar);
            }
        }
    }
}

extern "C" void kernel_launch(void* const* d_in, const int* in_sizes, int n_in, void* d_out, int out_size, void* d_ws, size_t ws_size, hipStream_t stream) {
    static int grid = 0;
    if (grid == 0) {
        if (n_in != 25 || ws_size < WS_NEED) { fprintf(stderr, "kernel_launch: n_in %d ws %zu (need %zu)\n", n_in, ws_size, (size_t)WS_NEED); grid = -1; return; }
        int dev = 0, cus = 0, per_cu = 0;
        hipGetDevice(&dev); hipDeviceGetAttribute(&cus, hipDeviceAttributeMultiprocessorCount, dev);
        if (hipFuncSetAttribute((const void*)fwd_mega, hipFuncAttributeMaxDynamicSharedMemorySize, LDS_BYTES) != hipSuccess) { fprintf(stderr, "kernel_launch: hipFuncSetAttribute failed\n"); grid = -1; return; }
        if (hipOccupancyMaxActiveBlocksPerMultiprocessor(&per_cu, (const void*)fwd_mega, 512, LDS_BYTES) != hipSuccess || per_cu < 1) { fprintf(stderr, "kernel_launch: occupancy query gave %d\n", per_cu); per_cu = 1; }
        (void)hipGetLastError();
        grid = cus * per_cu;
    }
    if (grid < 0) return;
    Args a{};
    for (int i = 0; i < 25; ++i) a.in[i] = (const float*)d_in[i];
    a.out = (float*)d_out; a.ws = (unsigned char*)d_ws; a.ph_lo = 0; a.ph_hi = 34;
    void* kargs[] = {&a};
    hipError_t e = hipLaunchCooperativeKernel((const void*)fwd_mega, dim3(grid), dim3(512), kargs, LDS_BYTES, stream);
    if (e != hipSuccess) fprintf(stderr, "kernel_launch: cooperative launch failed: %s (grid %d)\n", hipGetErrorString(e), grid);
}
```

```cpp
#include <hip/hip_runtime.h>
#include <hip/hip_cooperative_groups.h>
#include <cstdio>
#include <cstdint>
namespace cg = cooperative_groups;
#ifndef EN_NORM
#define EN_NORM 1
#endif
#ifndef EN_G1
#define EN_G1 1
#endif
#ifndef EN_GRES
#define EN_GRES 1
#endif
#ifndef EN_GRAW
#define EN_GRAW 1
#endif
#ifndef EN_POST1
#define EN_POST1 1
#endif
#ifndef EN_POST2
#define EN_POST2 1
#endif
#ifndef EN_ATT
#define EN_ATT 1
#endif
#ifndef EN_POOL
#define EN_POOL 1
#endif
#ifndef EN_PRO
#define EN_PRO 1
#endif
#ifndef DUPMASK
#define DUPMASK 0
#endif

#define LAS __attribute__((address_space(3)))
typedef unsigned short bf16_t;
typedef short bf16x8 __attribute__((ext_vector_type(8)));
typedef short s16x4 __attribute__((ext_vector_type(4)));
typedef float f32x4 __attribute__((ext_vector_type(4)));
typedef float f32x16 __attribute__((ext_vector_type(16)));
typedef unsigned u32x4 __attribute__((ext_vector_type(4)));
typedef unsigned u32x2 __attribute__((ext_vector_type(2)));

constexpr int DM = 1024, FF = 2816, MTOK = 40960, MEXT = 45056, NCTX = 8192, LLAT = 4096, PAST = 512, KVB = 4608;
constexpr int NMOD = 9216;
constexpr int QLD = 2048;
constexpr float EPS = 1e-6f;
constexpr size_t SZ_W13 = (size_t)8 * 5632 * 1024 * 2, SZ_W2 = (size_t)8 * 1024 * 2816 * 2, SZ_WIN = (size_t)2 * 1536 * 1024 * 2,
                 SZ_WQKV = (size_t)2 * 1792 * 384 * 2, SZ_WOUT = (size_t)2 * 1024 * 1024 * 2, SZ_POOLT = (size_t)2 * 1024 * 256 * 2,
                 SZ_WS = (size_t)2 * 4 * 128 * 128 * 2, SZ_MOD = (size_t)4 * 9 * NMOD * 4, SZ_ROPE = (size_t)2 * 4096 * 16 * 4,
                 SZ_H = (size_t)MTOK * 1024 * 2;
constexpr size_t OFF_W13 = 0, OFF_W2 = OFF_W13 + SZ_W13, OFF_WIN = OFF_W2 + SZ_W2, OFF_WQKV = OFF_WIN + SZ_WIN, OFF_WOUT = OFF_WQKV + SZ_WQKV,
                 OFF_POOLT = OFF_WOUT + SZ_WOUT, OFF_WS = OFF_POOLT + SZ_POOLT, OFF_MOD = OFF_WS + SZ_WS, OFF_ROPE = OFF_MOD + SZ_MOD,
                 OFF_H = OFF_ROPE + SZ_ROPE, OFF_R = OFF_H + SZ_H;
constexpr size_t R_QKVLAT = 0, R_KROPE = (size_t)MEXT * 384 * 2, R_PROJ = 41943040, R_GM = R_PROJ + (size_t)MTOK * 512 * 4,
                 R_QKVRAW = R_PROJ, SZ_R = SZ_H + (size_t)MTOK * 2816 * 2;
static_assert(R_KROPE + (size_t)MTOK * 32 * 4 <= R_PROJ, "ws map");
static_assert(R_QKVRAW + (size_t)MEXT * QLD * 2 <= SZ_R, "ws map");
constexpr size_t OFF_CTL = OFF_R + SZ_R, SZ_CTL = 16384;
constexpr size_t OFF_RSS = OFF_CTL + SZ_CTL, SZ_RSS = (size_t)12 * MTOK * 4;
constexpr size_t OFF_B13 = OFF_RSS + SZ_RSS, SZ_B13 = (size_t)8 * 9 * 5632 * 4;
constexpr size_t OFF_BIN = OFF_B13 + SZ_B13, SZ_BIN = (size_t)2 * 9 * 1536 * 4;
constexpr size_t R_U = SZ_H;
static_assert(R_U + (size_t)MTOK * 2816 * 2 <= SZ_R, "ws map");
constexpr size_t WS_NEED = OFF_BIN + SZ_BIN;

__device__ __forceinline__ unsigned cvt_pk_bf16(float lo, float hi) { unsigned r; asm volatile("v_cvt_pk_bf16_f32 %0, %1, %2" : "=v"(r) : "v"(lo), "v"(hi)); return r; }
__device__ __forceinline__ float bf2f(unsigned short b) { return __uint_as_float(((unsigned)b) << 16); }
__device__ __forceinline__ float bflo(unsigned w) { return __uint_as_float(w << 16); }
__device__ __forceinline__ float bfhi(unsigned w) { return __uint_as_float(w & 0xffff0000u); }
__device__ __forceinline__ float wave_sum(float v) {
#pragma unroll
    for (int o = 1; o < 64; o <<= 1) v += __shfl_xor(v, o);
    return v;
}
__device__ __forceinline__ float fast_sigmoid(float x) { return __builtin_amdgcn_rcpf(1.0f + __builtin_amdgcn_exp2f(-1.4426950408889634f * x)); }
__device__ __forceinline__ float silu_f(float x) { return x * fast_sigmoid(x); }
__device__ __forceinline__ float gelu_tanh_f(float x) { const float y = 0.7978845608028654f * (x + 0.044715f * x * x * x); return x * fast_sigmoid(2.0f * y); }
__device__ __forceinline__ f32x4 sigmoid4(f32x4 x) {
    const f32x4 t = x * -1.4426950408889634f; f32x4 e;
#pragma unroll
    for (int i = 0; i < 4; ++i) e[i] = __builtin_amdgcn_exp2f(t[i]);
    const f32x4 d = e + 1.0f; f32x4 r;
#pragma unroll
    for (int i = 0; i < 4; ++i) r[i] = __builtin_amdgcn_rcpf(d[i]);
    return r;
}
__device__ __forceinline__ f32x4 silu4(f32x4 x) { return x * sigmoid4(x); }
__device__ __forceinline__ f32x4 gelu_tanh4(f32x4 x) { const f32x4 y = (x + x * x * x * 0.044715f) * (2.0f * 0.7978845608028654f); return x * sigmoid4(y); }
__device__ __forceinline__ int cv_of_row(int r) { return r < NCTX ? 0 : 1 + ((r - NCTX) >> 12); }

#ifndef PROBE_KREP
#define PROBE_KREP 1
#endif
namespace pg8 {
constexpr int BM = 256, BK = 64, HALF = 128, HTB = HALF * BK * 2, STAGE_BYTES = 8 * HTB, NXCD = 8, WGM = 8;
__host__ __device__ __forceinline__ int lds_byte(int r, int c) { const int st = (r >> 4) * 2 + (c >> 5), rr = r & 15, cc = c & 31, ob = rr * 64 + cc * 2; return st * 1024 + (ob ^ (((ob >> 9) & 1) << 5)); }
__host__ __device__ __forceinline__ void stage_rc(int b, int& R, int& C) { const int st = b / 1024, sb = b % 1024, swz = sb ^ (((sb >> 9) & 1) << 5); R = (st >> 1) * 16 + swz / 64; C = (st & 1) * 32 + (swz % 64) / 2; }
__host__ __device__ __forceinline__ int perm32(int rho) { const int n = rho >> 4, i = rho & 15; return 8 * (i >> 2) + 4 * n + (i & 3); }

struct Unit { int pm, pn, half; };
struct Gemm { const bf16_t* A; const bf16_t* Bt; int M, N, K, lda, ldb, apn; };

struct StaticOrder {
    int nM, nN, nwg, G, c, ht;
    __device__ void init(int M, int N, int G_, int c_, int ht_ = 0) { nM = M / BM; nN = N / BM; nwg = nM * nN; G = G_; c = c_; ht = ht_; }
    __device__ bool next(int i, Unit& u) const {
        long L = (long)i * G + c; u.half = -1;
        if (ht) { const int nfull = nwg / G, rem = nwg - nfull * G;
            if (rem > 0 && 2 * rem <= G && i >= nfull) { if (i > nfull || (c >> 1) >= rem) return false; L = (long)nfull * G + (c >> 1); u.half = c & 1; } }
        if (L >= nwg) return false;
        int wgid = (int)L; { const int q = nwg / NXCD, r = nwg % NXCD, xcd = wgid % NXCD, off = wgid / NXCD; wgid = (xcd < r ? xcd * (q + 1) : r * (q + 1) + (xcd - r) * q) + off; }
        const int nig = WGM * nN, gid = wgid / nig, fm = gid * WGM, gsz = (nM - fm) < WGM ? (nM - fm) : WGM;
        u.pm = fm + ((wgid % nig) % gsz); u.pn = (wgid % nig) / gsz; return true;
    }
};

struct EpiSwiglu {
    static constexpr bool PERM = true; static constexpr int KREP = PROBE_KREP;
    bf16_t* U; const float* rss; const float* bias;
    static constexpr bool PREF = true;
    __device__ __forceinline__ bool pref_on() const { return true; }
    __device__ __forceinline__ const float* pref_ptr(const Unit& u, int tid) const { const int cv = u.pm < 32 ? 0 : 1 + ((u.pm - 32) >> 4);
        return tid < 256 ? rss + u.pm * BM + tid : bias + (size_t)cv * 5632 + u.pn * BM + (tid - 256); }
    __device__ __forceinline__ void run(f32x4 (&acc)[2][2][4][2], const Unit& u, int wr, int wc, int fr, int fq, const LAS float* sc) const {
        const int row0 = u.pm * BM + wr * 64 + fr, col0 = u.pn * HALF + wc * 32 + 8 * fq;
        const LAS float* bp = sc + 256 + wc * 32 + 8 * fq;
        const f32x4 ba0 = *(const LAS f32x4*)(bp), ba1 = *(const LAS f32x4*)(bp + 4), bb0 = *(const LAS f32x4*)(bp + HALF), bb1 = *(const LAS f32x4*)(bp + HALF + 4);
#pragma unroll
        for (int ai = 0; ai < 2; ++ai)
#pragma unroll
            for (int m = 0; m < 4; ++m) {
                const int row = row0 + ai * HALF + m * 16;
                bf16_t* rowp = U + (size_t)row * FF + col0;
                const float rstd = (1.0f / (float)KREP) * __builtin_amdgcn_rsqf(sc[ai * HALF + wr * 64 + m * 16 + fr] * (1.0f / 1024.0f) + EPS);
                const f32x4 a0 = acc[ai][0][m][0] * rstd + ba0, a1 = acc[ai][0][m][1] * rstd + ba1, b0 = acc[ai][1][m][0] * rstd + bb0, b1 = acc[ai][1][m][1] * rstd + bb1;
                const f32x4 v0 = silu4(a0) * b0, v1 = silu4(a1) * b1;
                u32x4 w; w.x = cvt_pk_bf16(v0[0], v0[1]); w.y = cvt_pk_bf16(v0[2], v0[3]); w.z = cvt_pk_bf16(v1[0], v1[1]); w.w = cvt_pk_bf16(v1[2], v1[3]);
                *(u32x4*)rowp = w;
            }
    }
};
struct EpiResid {
    static constexpr bool PERM = true; static constexpr int KREP = 1;
    float* X; const float* gate; const float* scale;
    bf16_t* An; const float* gn; const float* scn; float* rssn;
    float coef; int pad_;
    static constexpr bool PREF = false;
    __device__ __forceinline__ bool pref_on() const { return false; }
    __device__ __forceinline__ const float* pref_ptr(const Unit&, int) const { return nullptr; }
    __device__ __forceinline__ void run(f32x4 (&acc)[2][2][4][2], const Unit& u, int wr, int wc, int fr, int fq, const LAS float*) const {
        const int row0 = u.pm * BM + wr * 64 + fr; int col0 = u.pn * BM + wc * 32 + 8 * fq;
        const int cv = u.pm < 32 ? 0 : 1 + ((u.pm - 32) >> 4);
        const bool nx = An != nullptr;
        const int hb = u.half > 0 ? HALF : 0, nbj = u.half < 0 ? 2 : 1;
        col0 += hb;
        f32x4 gv[2][2], gm[2][2];
#pragma unroll
        for (int bj = 0; bj < 2; ++bj)
#pragma unroll
            for (int n = 0; n < 2; ++n) { const int c = col0 + (bj < nbj ? bj : 0) * HALF + 4 * n; f32x4 g = *(const f32x4*)(gate + (size_t)cv * NMOD + c) * coef;
                if (scale) g = g * *(const f32x4*)(scale + c); gv[bj][n] = g;
                gm[bj][n] = nx ? *(const f32x4*)(gn + c) * (*(const f32x4*)(scn + (size_t)cv * NMOD + c) + 1.0f) : (f32x4){0.f, 0.f, 0.f, 0.f}; }
#pragma unroll
        for (int ai = 0; ai < 2; ++ai)
#pragma unroll
            for (int m = 0; m < 4; ++m) { const int row = row0 + ai * HALF + m * 16; float* rowp = X + (size_t)row * DM + col0;
                float ss = 0.f;
#pragma unroll
                for (int bj = 0; bj < 2; ++bj) if (bj < nbj) { f32x4* p = (f32x4*)(rowp + bj * HALF);
                    const f32x4 x0 = __builtin_nontemporal_load(p) + acc[ai][bj][m][0] * gv[bj][0], x1 = __builtin_nontemporal_load(p + 1) + acc[ai][bj][m][1] * gv[bj][1];
                    __builtin_nontemporal_store(x0, p); __builtin_nontemporal_store(x1, p + 1);
                    if (nx) { ss += ((x0[0] * x0[0] + x0[1] * x0[1]) + (x0[2] * x0[2] + x0[3] * x0[3])) + ((x1[0] * x1[0] + x1[1] * x1[1]) + (x1[2] * x1[2] + x1[3] * x1[3]));
                        const f32x4 a0 = x0 * gm[bj][0], a1 = x1 * gm[bj][1]; u32x4 w; w.x = cvt_pk_bf16(a0[0], a0[1]); w.y = cvt_pk_bf16(a0[2], a0[3]); w.z = cvt_pk_bf16(a1[0], a1[1]); w.w = cvt_pk_bf16(a1[2], a1[3]);
                        *(u32x4*)(An + (size_t)row * DM + col0 + bj * HALF) = w; } }
                if (nx) { ss += __shfl_xor(ss, 16); ss += __shfl_xor(ss, 32);
                    if (fq == 0) (void)__hip_atomic_fetch_add(rssn + row, ss, __ATOMIC_RELAXED, __HIP_MEMORY_SCOPE_AGENT); } }
    }
};
struct EpiRaw {
    static constexpr bool PERM = true; static constexpr int KREP = 1;
    float* R; bf16_t* G; const float* rss; const float* bias; int ldr, nraw, ldg, act;
    static constexpr bool PREF = true;
    __device__ __forceinline__ bool pref_on() const { return rss != nullptr; }
    __device__ __forceinline__ const float* pref_ptr(const Unit& u, int tid) const { const int cv = u.pm < 32 ? 0 : 1 + ((u.pm - 32) >> 4);
        return tid < 256 ? rss + u.pm * BM + tid : bias + (size_t)cv * 1536 + u.pn * BM + (tid - 256); }
    __device__ __forceinline__ void run(f32x4 (&acc)[2][2][4][2], const Unit& u, int wr, int wc, int fr, int fq, const LAS float* sc) const {
        const int row0 = u.pm * BM + wr * 64 + fr, cw = wc * 32 + 8 * fq;
        if (rss) {
            f32x4 bv[2][2];
#pragma unroll
            for (int bj = 0; bj < 2; ++bj)
#pragma unroll
                for (int n = 0; n < 2; ++n) bv[bj][n] = *(const LAS f32x4*)(sc + 256 + cw + bj * HALF + 4 * n);
#pragma unroll
            for (int ai = 0; ai < 2; ++ai)
#pragma unroll
                for (int m = 0; m < 4; ++m) { const float rstd = __builtin_amdgcn_rsqf(sc[ai * HALF + wr * 64 + m * 16 + fr] * (1.0f / 1024.0f) + EPS);
#pragma unroll
                    for (int bj = 0; bj < 2; ++bj)
#pragma unroll
                        for (int n = 0; n < 2; ++n) acc[ai][bj][m][n] = acc[ai][bj][m][n] * rstd + bv[bj][n]; }
        }
        if (u.pn < nraw) {
#pragma unroll
            for (int ai = 0; ai < 2; ++ai)
#pragma unroll
                for (int m = 0; m < 4; ++m) { float* rowp = R + (size_t)(row0 + ai * HALF + m * 16) * ldr + u.pn * BM + cw;
#pragma unroll
                    for (int bj = 0; bj < 2; ++bj) { *(f32x4*)(rowp + bj * HALF) = acc[ai][bj][m][0]; *(f32x4*)(rowp + bj * HALF + 4) = acc[ai][bj][m][1]; } }
        } else {
#pragma unroll
            for (int ai = 0; ai < 2; ++ai)
#pragma unroll
                for (int m = 0; m < 4; ++m) { bf16_t* rowp = G + (size_t)(row0 + ai * HALF + m * 16) * ldg + (u.pn - nraw) * BM + cw;
#pragma unroll
                    for (int bj = 0; bj < 2; ++bj) { f32x4 v0 = acc[ai][bj][m][0], v1 = acc[ai][bj][m][1];
                        if (act) { v0 = gelu_tanh4(v0); v1 = gelu_tanh4(v1); }
                        u32x4 w; w.x = cvt_pk_bf16(v0[0], v0[1]); w.y = cvt_pk_bf16(v0[2], v0[3]); w.z = cvt_pk_bf16(v1[0], v1[1]); w.w = cvt_pk_bf16(v1[2], v1[3]);
                        *(u32x4*)(rowp + bj * HALF) = w; } }
        }
    }
};

template <class Epi, bool HT = false>
__device__ __forceinline__ void gemm_phase(LAS unsigned char* lds, const Gemm g, const StaticOrder S, const Epi E) {
    int tid = threadIdx.x; asm volatile("" : "+v"(tid));
    const int wid = __builtin_amdgcn_readfirstlane(tid >> 6), lane = tid & 63, wr = wid >> 2, wc = wid & 3, fr = lane & 15, fq = lane >> 4;
    const int nt = g.K / BK;
    unsigned voffA[2], voffB[2];
#pragma unroll
    for (int i = 0; i < 2; ++i) { int R, C; stage_rc(tid * 16 + i * 8192, R, C); const int Rb = Epi::PERM ? ((R & ~31) + perm32(R & 31)) : R;
        voffA[i] = (unsigned)(R * g.lda + C) * 2u; voffB[i] = (unsigned)(Rb * g.ldb + C) * 2u; }
    const size_t kstep = (size_t)(BK * 2);
    const size_t hstepA = (size_t)HALF * g.lda * 2, hstepB = (size_t)HALF * g.ldb * 2;
    const size_t tstepA = 2 * hstepA, tstepB = 2 * hstepB;
    const unsigned ldsw = (unsigned)wid * 1024u;
    const int aoff = lds_byte(wr * 64 + fr, fq * 8), boff = lds_byte(wc * 32 + fr, fq * 8);
#define PG8_SA(b, h) (((b) * 2 + (h)) * HTB)
#define PG8_SB(b, h) ((4 + (b) * 2 + (h)) * HTB)
#define PG8_STAGE(bufoff, gbase, voff) do { _Pragma("unroll") for (int _i = 0; _i < 2; ++_i) \
        __builtin_amdgcn_global_load_lds((const unsigned*)((const char*)(gbase) + (voff)[_i]), (LAS unsigned*)(lds + (bufoff) + ldsw + _i * 8192), 16, 0, 0); } while (0)
#define PG8_LDA(dst, b, h) do { _Pragma("unroll") for (int m = 0; m < 4; ++m) _Pragma("unroll") for (int k = 0; k < 2; ++k) dst[m][k] = *(const LAS bf16x8*)(lds + PG8_SA(b, h) + aoff + m * 2048 + k * 1024); } while (0)
#define PG8_LDB(dst, b, h) do { _Pragma("unroll") for (int n = 0; n < 2; ++n) _Pragma("unroll") for (int k = 0; k < 2; ++k) dst[n][k] = *(const LAS bf16x8*)(lds + PG8_SB(b, h) + boff + n * 2048 + k * 1024); } while (0)
#define PG8_MMA(ai, bj, At, Bt) do { __builtin_amdgcn_s_setprio(1); _Pragma("unroll") for (int m = 0; m < 4; ++m) _Pragma("unroll") for (int n = 0; n < 2; ++n) _Pragma("unroll") for (int k = 0; k < 2; ++k) \
        acc[ai][bj][m][n] = __builtin_amdgcn_mfma_f32_16x16x32_bf16(Bt[n][k], At[m][k], acc[ai][bj][m][n], 0, 0, 0); __builtin_amdgcn_s_setprio(0); } while (0)
#define PG8_WAIT_V(n) asm volatile("s_waitcnt vmcnt(" #n ")" ::: "memory")
#define PG8_WAIT_L(n) asm volatile("s_waitcnt lgkmcnt(" #n ")" ::: "memory")
#define PG8_BAR __builtin_amdgcn_s_barrier()
#define PG8_SCHED __builtin_amdgcn_sched_barrier(0)
    Unit cur, nxt; int ui = 0;
    if (!S.next(0, cur)) return;
    constexpr int EPI_LDS = 131328;
#define PG8_PREF(u) do { if (Epi::PREF && E.pref_on()) __builtin_amdgcn_global_load_lds((const unsigned*)E.pref_ptr(u, tid), (LAS unsigned*)(lds + EPI_LDS + (ui & 1) * 2048 + wid * 256), 4, 0, 0); } while (0)
    PG8_PREF(cur);
    f32x4 acc[2][2][4][2];
#pragma unroll
    for (int a = 0; a < 2; ++a)
#pragma unroll
        for (int b = 0; b < 2; ++b)
#pragma unroll
            for (int m = 0; m < 4; ++m)
#pragma unroll
                for (int n = 0; n < 2; ++n) acc[a][b][m][n] = (f32x4){0.f, 0.f, 0.f, 0.f};
    bf16x8 At[4][2], B0[2][2], B1[2][2];
    const char* cA = (const char*)g.A + (size_t)cur.pm * tstepA + (size_t)cur.pn * g.apn; const char* cB = (const char*)g.Bt + (size_t)cur.pn * tstepB + ((HT && cur.half > 0) ? hstepB : 0);
    size_t hBc = (HT && cur.half >= 0) ? 0 : hstepB;
    PG8_STAGE(PG8_SB(0, 0), cB, voffB); PG8_STAGE(PG8_SB(0, 1), cB + hBc, voffB); PG8_STAGE(PG8_SA(0, 0), cA, voffA); PG8_STAGE(PG8_SA(0, 1), cA + hstepA, voffA);
    if (wr == 1) PG8_BAR;
    PG8_WAIT_V(2); PG8_BAR;
    PG8_STAGE(PG8_SB(1, 0), cB + kstep, voffB); PG8_STAGE(PG8_SA(1, 0), cA + kstep, voffA); PG8_STAGE(PG8_SB(1, 1), cB + hBc + kstep, voffB);
    PG8_WAIT_V(6); PG8_BAR;
#define PG8_KBODY(B1ON) \
        for (int t = 0, tk = 0; t < nt * Epi::KREP; t += 2) { \
            const bool last = (t == nt * Epi::KREP - 2); \
            const int tk2 = (tk + 2 >= nt) ? tk + 2 - nt : tk + 2; \
            const char* a1 = cA + (size_t)(tk + 1) * kstep; \
            const char* a2 = last ? nA : cA + (size_t)tk2 * kstep; const char* b2 = last ? nB : cB + (size_t)tk2 * kstep; const size_t hb2 = last ? nhB : hBc; tk = tk2; \
            const char* a3 = a2 + kstep; const char* b3 = b2 + kstep; \
            PG8_LDB(B0, 0, 0); if (B1ON) PG8_LDB(B1, 0, 1); PG8_SCHED; PG8_LDA(At, 0, 0); PG8_STAGE(PG8_SA(1, 1), a1 + hstepA, voffA); \
            PG8_WAIT_V(8); PG8_WAIT_L(0); PG8_BAR; PG8_MMA(0, 0, At, B0); if (B1ON) PG8_MMA(0, 1, At, B1); PG8_BAR; PG8_SCHED; \
            PG8_LDA(At, 0, 1); PG8_STAGE(PG8_SB(0, 0), b2, voffB); PG8_STAGE(PG8_SB(0, 1), b2 + hb2, voffB); PG8_STAGE(PG8_SA(0, 0), a2, voffA); \
            PG8_WAIT_V(8); PG8_WAIT_L(0); PG8_BAR; PG8_MMA(1, 0, At, B0); if (B1ON) PG8_MMA(1, 1, At, B1); PG8_BAR; PG8_SCHED; \
            PG8_LDB(B0, 1, 0); if (B1ON) PG8_LDB(B1, 1, 1); PG8_SCHED; PG8_LDA(At, 1, 0); PG8_STAGE(PG8_SA(0, 1), a2 + hstepA, voffA); \
            PG8_WAIT_V(8); PG8_WAIT_L(0); PG8_BAR; PG8_MMA(0, 0, At, B0); if (B1ON) PG8_MMA(0, 1, At, B1); PG8_BAR; PG8_SCHED; \
            PG8_LDA(At, 1, 1); PG8_STAGE(PG8_SB(1, 0), b3, voffB); PG8_STAGE(PG8_SB(1, 1), b3 + hb2, voffB); PG8_STAGE(PG8_SA(1, 0), a3, voffA); \
            PG8_WAIT_V(8); PG8_WAIT_L(0); PG8_BAR; PG8_MMA(1, 0, At, B0); if (B1ON) PG8_MMA(1, 1, At, B1); PG8_BAR; PG8_SCHED; \
        }
    for (;;) {
        const bool has_next = S.next(ui + 1, nxt);
        const char* nA = has_next ? (const char*)g.A + (size_t)nxt.pm * tstepA + (size_t)nxt.pn * g.apn : cA;
        const char* nB = has_next ? (const char*)g.Bt + (size_t)nxt.pn * tstepB + ((HT && nxt.half > 0) ? hstepB : 0) : cB;
        const size_t nhB = has_next ? ((HT && nxt.half >= 0) ? 0 : hstepB) : hBc;
        if (HT && cur.half >= 0) { PG8_KBODY(false) } else { PG8_KBODY(true) }
        if (wr == 0) PG8_BAR;
        E.run(acc, cur, wr, wc, fr, fq, (const LAS float*)(lds + EPI_LDS + (ui & 1) * 2048));
        if (!has_next) break;
#pragma unroll
        for (int a = 0; a < 2; ++a)
#pragma unroll
            for (int b = 0; b < 2; ++b)
#pragma unroll
                for (int m = 0; m < 4; ++m)
#pragma unroll
                    for (int n = 0; n < 2; ++n) acc[a][b][m][n] = (f32x4){0.f, 0.f, 0.f, 0.f};
        cur = nxt; cA = nA; cB = nB; hBc = nhB; ++ui;
        PG8_PREF(cur);
        if (wr == 1) PG8_BAR;
    }
    PG8_WAIT_V(0);
    PG8_BAR;
#undef PG8_KBODY
#undef PG8_PREF
#undef PG8_SA
#undef PG8_SB
#undef PG8_STAGE
#undef PG8_LDA
#undef PG8_LDB
#undef PG8_MMA
#undef PG8_WAIT_V
#undef PG8_WAIT_L
#undef PG8_BAR
#undef PG8_SCHED
}
}

namespace att {
constexpr int NW = 8, QBLK = 32, KVBLK = 64;
constexpr float SCALE = 0.10206207261596575f;
constexpr float THR = 8.f;
constexpr size_t SHM_V = 16384, SHM_K = 16384, SHM_ATTN = 2 * SHM_V + 2 * SHM_K + NW * 64 * 4;
#define KSWZ(row, colB) ((row) * 256 + ((colB) ^ (((row) & 7) << 4)))
#define SBAR() __builtin_amdgcn_sched_barrier(0)
__device__ __forceinline__ int crow(int r, int hi) { return (r & 3) + 8 * (r >> 2) + 4 * hi; }
__device__ __forceinline__ void partialSM(f32x16& p0, f32x16& p1, float& m_reg, float& mn, float& alpha) {
  constexpr float C = SCALE * 1.4426950408889634f;
  float pmax = p0[0];
#pragma unroll
  for (int r = 1; r < 16; ++r) pmax = fmaxf(pmax, p0[r]);
#pragma unroll
  for (int r = 0; r < 16; ++r) pmax = fmaxf(pmax, p1[r]);
  { auto rr = __builtin_amdgcn_permlane32_swap(__float_as_uint(pmax), __float_as_uint(pmax), false, false);
    pmax = fmaxf(__uint_as_float(rr[0]), __uint_as_float(rr[1])); }
  if (__builtin_expect(__all(pmax - m_reg <= THR / SCALE), 1)) { mn = m_reg; alpha = 1.f; }
  else { mn = fmaxf(m_reg, pmax); alpha = __builtin_amdgcn_exp2f((m_reg - mn) * C); m_reg = mn; }
  float mnC = -mn * C;
#pragma unroll
  for (int r = 0; r < 16; ++r) p0[r] = fmaf(p0[r], C, mnC);
#pragma unroll
  for (int r = 0; r < 16; ++r) p1[r] = fmaf(p1[r], C, mnC);
#pragma unroll
  for (int r = 0; r < 16; ++r) p0[r] = __builtin_amdgcn_exp2f(p0[r]);
}
__device__ __forceinline__ void finishSM(f32x16& p0, f32x16& p1, float alpha, float& l_reg, bf16x8& pa0, bf16x8& pa1, bf16x8& pa2, bf16x8& pa3) {
#pragma unroll
  for (int r = 0; r < 16; ++r) p1[r] = __builtin_amdgcn_exp2f(p1[r]);
  float ps = 0;
#pragma unroll
  for (int r = 0; r < 16; ++r) ps += p0[r];
#pragma unroll
  for (int r = 0; r < 16; ++r) ps += p1[r];
  { auto rr = __builtin_amdgcn_permlane32_swap(__float_as_uint(ps), __float_as_uint(ps), false, false);
    ps = __uint_as_float(rr[0]) + __uint_as_float(rr[1]); }
  l_reg = l_reg * alpha + ps;
#define PK4(P, BASE, OUT) do { unsigned a0 = cvt_pk_bf16(P[BASE + 0], P[BASE + 1]), a1 = cvt_pk_bf16(P[BASE + 2], P[BASE + 3]);   \
    unsigned b0 = cvt_pk_bf16(P[BASE + 4], P[BASE + 5]), b1 = cvt_pk_bf16(P[BASE + 6], P[BASE + 7]);                              \
    auto r0 = __builtin_amdgcn_permlane32_swap(a0, b0, false, false); auto r1 = __builtin_amdgcn_permlane32_swap(a1, b1, false, false); \
    u32x4 w = {r0[0], r1[0], r0[1], r1[1]}; OUT = *reinterpret_cast<bf16x8*>(&w); } while (0)
  PK4(p0, 0, pa0); PK4(p0, 8, pa1); PK4(p1, 0, pa2); PK4(p1, 8, pa3);
#undef PK4
}
__device__ __forceinline__ void qkt(f32x16& p0, f32x16& p1, const char* Ks, const bf16x8* qr, int r32, int hi) {
  p0 = f32x16{}; p1 = f32x16{};
#pragma unroll
  for (int d0 = 0; d0 < 6; ++d0) { int cb = (d0 * 16 + hi * 8) * 2;
    bf16x8 b0 = *reinterpret_cast<const bf16x8*>(Ks + KSWZ(r32, cb));
    bf16x8 b1 = *reinterpret_cast<const bf16x8*>(Ks + KSWZ(32 + r32, cb));
    p0 = __builtin_amdgcn_mfma_f32_32x32x16_bf16(b0, qr[d0], p0, 0, 0, 0);
    p1 = __builtin_amdgcn_mfma_f32_32x32x16_bf16(b1, qr[d0], p1, 0, 0, 0); }
}
__device__ __forceinline__ int v_st(int k, int c) { const int kk = (k & ~0xC) | ((k & 4) << 1) | ((k & 8) >> 1); return ((kk >> 3) * 4 + (c >> 5)) * 512 + ((kk & 7) * 32 + (c & 31)) * 2; }
__device__ __forceinline__ int v_rd_base(int lane) { return ((lane & 3) << 3) | (((lane >> 2) & 3) << 6) | (((lane >> 4) & 1) << 5) | (((lane >> 5) & 1) << 8); }
constexpr int v_rd_off(int d0, int ks, int half) { return d0 * 512 + ks * 4096 + half * 2048; }
template <int OFF> __device__ __forceinline__ s16x4 tr_read(int vb) {
  s16x4 r; asm volatile("ds_read_b64_tr_b16 %0, %1 offset:%2" : "=&v"(r) : "v"(vb), "i"(OFF) : "memory"); return r;
}
template <int D0> __device__ __forceinline__ void pv_one(f32x16& od, int vb, bf16x8 pa0, bf16x8 pa1, bf16x8 pa2, bf16x8 pa3) {
  const s16x4 l0 = tr_read<v_rd_off(D0, 0, 0)>(vb), h0 = tr_read<v_rd_off(D0, 0, 1)>(vb), l1 = tr_read<v_rd_off(D0, 1, 0)>(vb), h1 = tr_read<v_rd_off(D0, 1, 1)>(vb);
  const s16x4 l2 = tr_read<v_rd_off(D0, 2, 0)>(vb), h2 = tr_read<v_rd_off(D0, 2, 1)>(vb), l3 = tr_read<v_rd_off(D0, 3, 0)>(vb), h3 = tr_read<v_rd_off(D0, 3, 1)>(vb);
  asm volatile("s_waitcnt lgkmcnt(0)" ::: "memory"); SBAR();
#define PK(L, H) (bf16x8){L[0], L[1], L[2], L[3], H[0], H[1], H[2], H[3]}
  od = __builtin_amdgcn_mfma_f32_32x32x16_bf16(pa0, PK(l0, h0), od, 0, 0, 0);
  od = __builtin_amdgcn_mfma_f32_32x32x16_bf16(pa1, PK(l1, h1), od, 0, 0, 0);
  od = __builtin_amdgcn_mfma_f32_32x32x16_bf16(pa2, PK(l2, h2), od, 0, 0, 0);
  od = __builtin_amdgcn_mfma_f32_32x32x16_bf16(pa3, PK(l3, h3), od, 0, 0, 0);
#undef PK
}
__device__ __forceinline__ void pv_d0(f32x16* o, int vb, bf16x8 pa0, bf16x8 pa1, bf16x8 pa2, bf16x8 pa3) {
  pv_one<0>(o[0], vb, pa0, pa1, pa2, pa3); pv_one<1>(o[1], vb, pa0, pa1, pa2, pa3);
}
__device__ __forceinline__ void attn_unit(const bf16_t* __restrict__ Qb, const bf16_t* __restrict__ Kh, const bf16_t* __restrict__ Vh,
                                          bf16_t* __restrict__ Ob, int seq, char* lds) {
  int tid = threadIdx.x; asm volatile("" : "+v"(tid));
  const int wid = tid >> 6, lane = tid & 63, r32 = lane & 31, hi = lane >> 5;
  char* V_lds = lds; char* K_lds = lds + 2 * SHM_V;
  float* ws = (float*)(lds + 2 * SHM_V + 2 * SHM_K) + wid * 64; float* li_l = ws; float* al_l = ws + 32;
  float m_reg = -1e30f, l_reg = 0; f32x16 o[2] = {}; bf16x8 qr[6];
  const bf16_t* Qw = Qb + (long)(wid * QBLK + r32) * QLD + hi * 8;
#pragma unroll
  for (int d0 = 0; d0 < 6; ++d0) qr[d0] = *reinterpret_cast<const bf16x8*>(Qw + d0 * 16);
  const bool kld = wid < 6;
  const int ksr = tid / 12, ksc = (tid - ksr * 12) * 8;
  const int vsr = tid >> 3, vsc = (tid & 7) * 8, vst0 = v_st(vsr, vsc);
  const int vb0 = (int)(uintptr_t)V_lds + v_rd_base(lane);
  struct { bf16x8 vs0, ks0, ks1; } sr_[2];
#define SLOAD(i, k0) do { sr_[i].vs0 = *reinterpret_cast<const bf16x8*>(&Vh[(long)((k0) + vsr) * QLD + vsc]); \
    if (kld) { sr_[i].ks0 = *reinterpret_cast<const bf16x8*>(&Kh[(long)((k0) + ksr) * QLD + ksc]); sr_[i].ks1 = *reinterpret_cast<const bf16x8*>(&Kh[(long)((k0) + 32 + ksr) * QLD + ksc]); } } while (0)
#define SWRITE(b, i) do { *(bf16x8*)(V_lds + (b) * SHM_V + vst0) = sr_[i].vs0; \
    if (kld) { int kc = ksc * 2; *(bf16x8*)(K_lds + (b) * SHM_K + KSWZ(ksr, kc)) = sr_[i].ks0; *(bf16x8*)(K_lds + (b) * SHM_K + KSWZ(32 + ksr, kc)) = sr_[i].ks1; } } while (0)
#define SWAIT() asm volatile("s_waitcnt vmcnt(3)" ::: "memory")
#define RESC(a) do { if (__any((a) < 1.f)) { if (hi == 0) al_l[r32] = (a); asm volatile("s_waitcnt lgkmcnt(0)" ::: "memory"); \
    _Pragma("unroll") for (int d = 0; d < 2; ++d) _Pragma("unroll") for (int r = 0; r < 16; ++r) o[d][r] *= al_l[crow(r, hi)]; } } while (0)
  f32x16 pA0, pA1, pB0, pB1; float mnA, mnB, alA, alB; bf16x8 pa0, pa1, pa2, pa3; const int NT = seq / KVBLK;
  constexpr int SE = 0, SO = 1;
  SLOAD(SE, 0); asm volatile("s_waitcnt vmcnt(0)" ::: "memory"); SWRITE(0, SE); __syncthreads();
  qkt(pA0, pA1, K_lds, qr, r32, hi); partialSM(pA0, pA1, m_reg, mnA, alA);
  SLOAD(SO, KVBLK); if (2 < NT) SLOAD(SE, 2 * KVBLK);
  SWAIT(); SWRITE(1, SO); __syncthreads();
  for (int j = 1; j + 1 < NT; j += 2) {
    SBAR(); qkt(pB0, pB1, K_lds + SHM_K, qr, r32, hi);
    finishSM(pA0, pA1, alA, l_reg, pa0, pa1, pa2, pa3); SBAR();
    SLOAD(SO, (j + 2) * KVBLK); SBAR();
    pv_d0(o, vb0, pa0, pa1, pa2, pa3); partialSM(pB0, pB1, m_reg, mnB, alB);
    __syncthreads(); SWAIT(); SWRITE(0, SE);
    RESC(alB); __syncthreads();
    SBAR(); qkt(pA0, pA1, K_lds, qr, r32, hi);
    finishSM(pB0, pB1, alB, l_reg, pa0, pa1, pa2, pa3); SBAR();
    if (j + 3 < NT) SLOAD(SE, (j + 3) * KVBLK); SBAR();
    pv_d0(o, vb0 + (int)SHM_V, pa0, pa1, pa2, pa3); partialSM(pA0, pA1, m_reg, mnA, alA);
    __syncthreads(); SWAIT(); SWRITE(1, SO);
    RESC(alA); __syncthreads();
  }
  SBAR(); qkt(pB0, pB1, K_lds + SHM_K, qr, r32, hi);
  finishSM(pA0, pA1, alA, l_reg, pa0, pa1, pa2, pa3); SBAR();
  pv_d0(o, vb0, pa0, pa1, pa2, pa3); partialSM(pB0, pB1, m_reg, mnB, alB);
  __syncthreads(); RESC(alB);
  finishSM(pB0, pB1, alB, l_reg, pa0, pa1, pa2, pa3); SBAR();
  pv_d0(o, vb0 + (int)SHM_V, pa0, pa1, pa2, pa3);
  if (hi == 0) li_l[r32] = l_reg; asm volatile("s_waitcnt lgkmcnt(0)" ::: "memory");
  bf16_t* Ow = Ob + (long)(wid * QBLK) * 1024;
#pragma unroll
  for (int r = 0; r < 16; ++r) { const int orow = crow(r, hi); const float rl = __builtin_amdgcn_rcpf(li_l[orow]);
#pragma unroll
    for (int d0 = 0; d0 < 2; ++d0) Ow[(long)orow * 1024 + d0 * 32 + r32] = (bf16_t)(cvt_pk_bf16(o[d0][r] * rl, 0.f) & 0xffffu); }
#undef SLOAD
#undef SWRITE
#undef SWAIT
#undef RESC
}
}


#define XB_TMO      128
#define XB_XCNT(j)  (256  + 64 * (j))
#define XB_XSUB(j)  (1280 + 64 * (j))
#define XB_XGEN(j)  (2304 + 64 * (j))
#define XB_TOP      3328
#define XB_TOPGEN   3392
#define XCD_BAR_WORDS 3456
#define XB_SPIN_CAP (1u << 20)
__device__ __forceinline__ unsigned xb_ld(unsigned* p)              { return __hip_atomic_load(p, __ATOMIC_RELAXED, __HIP_MEMORY_SCOPE_AGENT); }
__device__ __forceinline__ unsigned xb_add(unsigned* p, unsigned v) { return __hip_atomic_fetch_add(p, v, __ATOMIC_RELAXED, __HIP_MEMORY_SCOPE_AGENT); }
__device__ __forceinline__ unsigned xb_xcc_id() { return (unsigned)__builtin_amdgcn_s_getreg((3 << 11) | 20) & 0xFu; }
#define XB_SPIN(cond, bar) do { unsigned _sp = 0; while (cond) { __builtin_amdgcn_s_sleep(1); \
    if ((++_sp & 255u) == 0u) { if (xb_ld(&(bar)[XB_TMO])) break; if (_sp > XB_SPIN_CAP) { atomicAdd(&(bar)[XB_TMO], 1u); break; } } } } while (0)
struct XcdBarrier { unsigned* bar; unsigned x; volatile LAS unsigned* st; };
__device__ __forceinline__ XcdBarrier xcd_barrier_post(unsigned* bar, volatile LAS unsigned* st) {
    XcdBarrier b; b.bar = bar; b.x = xb_xcc_id(); b.st = st;
    if (threadIdx.x == 0) (void)xb_add(&bar[XB_XCNT(b.x)], 1u);
    return b;
}
__device__ __forceinline__ void xcd_barrier_complete(unsigned* bar, unsigned x, unsigned& nloc, unsigned& nx) {
    const unsigned G = gridDim.x * gridDim.y * gridDim.z;
    unsigned sum, cnt, mine, sp = 0u;
    for (;;) {
        sum = 0u; cnt = 0u; mine = 0u;
#pragma unroll
        for (unsigned j = 0; j < 16; ++j) { const unsigned c = xb_ld(&bar[XB_XCNT(j)]); sum += c; cnt += (c > 0u) ? 1u : 0u; mine = (j == x) ? c : mine; }
        if (sum == G) break;
        __builtin_amdgcn_s_sleep(1);
        if ((++sp & 255u) == 0u) { if (xb_ld(&bar[XB_TMO])) break; if (sp > XB_SPIN_CAP) { atomicAdd(&bar[XB_TMO], 1u); break; } }
    }
    nloc = mine > 0u ? mine : 1u; nx = cnt > 0u ? cnt : 1u;
}
__device__ __forceinline__ void xcd_barrier(const XcdBarrier& b) {
    asm volatile("s_waitcnt vmcnt(0)" ::: "memory");
    __syncthreads();
    if (threadIdx.x == 0) {
        unsigned* bar = b.bar;
        __builtin_amdgcn_s_waitcnt(0);
        unsigned nloc = b.st[0], nx = b.st[1];
        if (nloc == 0u) { xcd_barrier_complete(bar, b.x, nloc, nx); b.st[0] = nloc; b.st[1] = nx; }
        const unsigned old = xb_add(&bar[XB_XSUB(b.x)], 1u);
        const unsigned gen = old / nloc;
        if (old + 1u == (gen + 1u) * nloc) {
            __builtin_amdgcn_fence(__ATOMIC_RELEASE, "agent");
            asm volatile("s_waitcnt vmcnt(0)" ::: "memory");
            const unsigned og = xb_add(&bar[XB_TOP], 1u);
            const unsigned tg = og / nx;
            if (og + 1u == (tg + 1u) * nx) xb_add(&bar[XB_TOPGEN], 1u);
            else XB_SPIN(xb_ld(&bar[XB_TOPGEN]) == tg, bar);
            __builtin_amdgcn_fence(__ATOMIC_ACQUIRE, "agent");
            xb_add(&bar[XB_XGEN(b.x)], 1u);
            asm volatile("s_waitcnt vmcnt(0)" ::: "memory");
        } else {
            XB_SPIN(xb_ld(&bar[XB_XGEN(b.x)]) == gen, bar);
            __builtin_amdgcn_fence(__ATOMIC_ACQUIRE, "agent");
            asm volatile("s_waitcnt vmcnt(0)" ::: "memory");
        }
    }
    __syncthreads();
}

constexpr int LDS_BYTES = 139264;
struct Args { const float* in[25]; float* out; unsigned char* ws; int ph_lo, ph_hi; };

__device__ __forceinline__ void tr_item(const float* W, int ldw, bf16_t* dst, int ldd, LAS float* scr, int lane) {
    float tv[32];
#pragma unroll
    for (int i = 0; i < 32; ++i) tv[i] = W[(size_t)(2 * i + (lane >> 5)) * ldw + (lane & 31)];
#pragma unroll
    for (int i = 0; i < 32; ++i) scr[(2 * i + (lane >> 5)) * 33 + (lane & 31)] = tv[i];
    asm volatile("s_waitcnt lgkmcnt(0)" ::: "memory");
    const int c = lane & 7;
#pragma unroll
    for (int j = 0; j < 4; ++j) { const int n = (lane >> 3) + 8 * j; const LAS float* s = scr + (8 * c) * 33 + n;
        u32x4 o; o.x = cvt_pk_bf16(s[0 * 33], s[1 * 33]); o.y = cvt_pk_bf16(s[2 * 33], s[3 * 33]); o.z = cvt_pk_bf16(s[4 * 33], s[5 * 33]); o.w = cvt_pk_bf16(s[6 * 33], s[7 * 33]);
        *(u32x4*)(dst + (size_t)n * ldd + 8 * c) = o; }
    asm volatile("s_waitcnt lgkmcnt(0)" ::: "memory");
}


struct P2Row { f32x4 q[3], k[3]; u32x2 v[2]; int kind, t, e; };
__device__ __forceinline__ f32x4 ld_bf4(const bf16_t* p) { const u32x2 w = *(const u32x2*)p; return (f32x4){bflo(w.x), bfhi(w.x), bflo(w.y), bfhi(w.y)}; }
__device__ __forceinline__ void p2_load(P2Row& r, int e, int j, int hh, int s, const bf16_t* QKV, const float* KROPE, const float* cache_kr) {
    const float* krp; r.e = e; r.t = 0;
    if (e < NCTX) { r.kind = 0; krp = KROPE + (size_t)e * 32; }
    else { const int b = (e - NCTX) / KVB, tt = (e - NCTX) - b * KVB;
        if (tt < LLAT) { r.kind = 1; r.t = tt; krp = KROPE + (size_t)(NCTX + b * LLAT + tt) * 32; }
        else { r.kind = 2; krp = cache_kr + (((size_t)b * 2 + j) * 512 + (tt - LLAT)) * 32; } }
    const bf16_t* raw = QKV + (size_t)e * QLD;
#pragma unroll
    for (int jj = 0; jj < 3; ++jj) r.q[jj] = ld_bf4(raw + hh * 96 + 4 * (s + 8 * jj));
#pragma unroll
    for (int jj = 0; jj < 2; ++jj) { r.k[jj] = ld_bf4(raw + 768 + hh * 128 + 4 * (s + 8 * jj)); r.v[jj] = *(const u32x2*)(raw + 768 + hh * 128 + 64 + 4 * (s + 8 * jj)); }
    r.k[2] = *(const f32x4*)(krp + 4 * s);
}
__device__ __forceinline__ void p2_compute(P2Row& r, int s, const float* qn, const float* kn, const float* ROPE) {
    float sq = 0.f, sk = 0.f;
#pragma unroll
    for (int jj = 0; jj < 3; ++jj) { sq += (r.q[jj][0] * r.q[jj][0] + r.q[jj][1] * r.q[jj][1]) + (r.q[jj][2] * r.q[jj][2] + r.q[jj][3] * r.q[jj][3]);
                                     sk += (r.k[jj][0] * r.k[jj][0] + r.k[jj][1] * r.k[jj][1]) + (r.k[jj][2] * r.k[jj][2] + r.k[jj][3] * r.k[jj][3]); }
    sq += __shfl_xor(sq, 1); sq += __shfl_xor(sq, 2); sq += __shfl_xor(sq, 4);
    sk += __shfl_xor(sk, 1); sk += __shfl_xor(sk, 2); sk += __shfl_xor(sk, 4);
    const float rq = 1.0f / sqrtf(sq * (1.0f / 96.0f) + EPS), rk = 1.0f / sqrtf(sk * (1.0f / 96.0f) + EPS);
#pragma unroll
    for (int jj = 0; jj < 3; ++jj) { r.q[jj] = r.q[jj] * rq * *(const f32x4*)(qn + 4 * (s + 8 * jj)); r.k[jj] = r.k[jj] * rk * *(const f32x4*)(kn + 4 * (s + 8 * jj)); }
    f32x4 qp, kp;
#pragma unroll
    for (int c = 0; c < 4; ++c) { qp[c] = __shfl_xor(r.q[2][c], 2); kp[c] = __shfl_xor(r.k[2][c], 2); }
    if (r.kind == 1) {
        const int a = s >> 2, fi0 = (s & 1) * 4; const bool second = (s & 2) != 0;
        const f32x4 cs = *(const f32x4*)(ROPE + (size_t)r.t * 16 + a * 8 + fi0), sn = *(const f32x4*)(ROPE + 65536 + (size_t)r.t * 16 + a * 8 + fi0);
        if (!second) { r.q[2] = r.q[2] * cs - qp * sn; r.k[2] = r.k[2] * cs - kp * sn; }
        else { r.q[2] = qp * sn + r.q[2] * cs; r.k[2] = kp * sn + r.k[2] * cs; }
    }
}
__device__ __forceinline__ void p2_store(const P2Row& r, int hh, int s, bf16_t* QKV) {
    bf16_t* orow = QKV + (size_t)r.e * QLD;
#pragma unroll
    for (int jj = 0; jj < 3; ++jj) {
        if (r.kind != 2) { u32x2 w; w.x = cvt_pk_bf16(r.q[jj][0], r.q[jj][1]); w.y = cvt_pk_bf16(r.q[jj][2], r.q[jj][3]); *(u32x2*)(orow + hh * 96 + 4 * (s + 8 * jj)) = w; }
        u32x2 w2; w2.x = cvt_pk_bf16(r.k[jj][0], r.k[jj][1]); w2.y = cvt_pk_bf16(r.k[jj][2], r.k[jj][3]); *(u32x2*)(orow + 768 + hh * 96 + 4 * (s + 8 * jj)) = w2; }
#pragma unroll
    for (int jj = 0; jj < 2; ++jj) *(u32x2*)(orow + 1536 + hh * 64 + 4 * (s + 8 * jj)) = r.v[jj];
}
struct P1Row { f32x4 q4, k4, r4; };
__device__ __forceinline__ void p1_load(P1Row& p, const float* pr, int lane) {
    p.q4 = *(const f32x4*)(pr + 4 * lane);
    p.k4 = (f32x4){0.f, 0.f, 0.f, 0.f}; if (lane < 32) p.k4 = *(const f32x4*)(pr + 256 + 4 * lane);
    p.r4 = (f32x4){0.f, 0.f, 0.f, 0.f}; if (lane < 8) p.r4 = *(const f32x4*)(pr + 384 + 4 * lane);
}
__device__ __forceinline__ void p1_finish(const P1Row& p, int r, int j, int lane, const float* qan, const float* kvan, bf16_t* QKVLAT, float* KROPE, float* OUT_CKV, float* OUT_KR) {
    const int e = r < NCTX ? r : NCTX + ((r - NCTX) >> 12) * KVB + ((r - NCTX) & 4095);
    const float ssq = wave_sum((p.q4[0] * p.q4[0] + p.q4[1] * p.q4[1]) + (p.q4[2] * p.q4[2] + p.q4[3] * p.q4[3]));
    const float ssk = wave_sum((p.k4[0] * p.k4[0] + p.k4[1] * p.k4[1]) + (p.k4[2] * p.k4[2] + p.k4[3] * p.k4[3]));
    const float rq = 1.0f / sqrtf(ssq * (1.0f / 256.0f) + EPS), rk = 1.0f / sqrtf(ssk * (1.0f / 128.0f) + EPS);
    const f32x4 qo = p.q4 * rq * *(const f32x4*)(qan + 4 * lane);
    u32x2 w; w.x = cvt_pk_bf16(qo[0], qo[1]); w.y = cvt_pk_bf16(qo[2], qo[3]); *(u32x2*)(QKVLAT + (size_t)e * 384 + 4 * lane) = w;
    if (lane < 32) { const f32x4 ko = p.k4 * rk * *(const f32x4*)(kvan + 4 * lane); u32x2 w2; w2.x = cvt_pk_bf16(ko[0], ko[1]); w2.y = cvt_pk_bf16(ko[2], ko[3]);
        *(u32x2*)(QKVLAT + (size_t)e * 384 + 256 + 4 * lane) = w2;
        if (r < NCTX) *(f32x4*)(OUT_CKV + (((size_t)(r >> 8) * 2 + j) * 256 + (r & 255)) * 128 + 4 * lane) = ko; }
    if (lane < 8) { *(f32x4*)(KROPE + (size_t)r * 32 + 4 * lane) = p.r4;
        if (r < NCTX) *(f32x4*)(OUT_KR + (((size_t)(r >> 8) * 2 + j) * 256 + (r & 255)) * 32 + 4 * lane) = p.r4; }
}

#define DERIVE_PTRS \
    unsigned char* ws = args.ws; \
    float* X = args.out; \
    float* OUT_CKV = args.out + (size_t)MTOK * 1024; float* OUT_KR = OUT_CKV + (size_t)32 * 2 * 256 * 128; \
    bf16_t* W13 = (bf16_t*)(ws + OFF_W13); bf16_t* W2 = (bf16_t*)(ws + OFF_W2); bf16_t* WIN = (bf16_t*)(ws + OFF_WIN); bf16_t* WQKV = (bf16_t*)(ws + OFF_WQKV); \
    bf16_t* WOUT = (bf16_t*)(ws + OFF_WOUT); bf16_t* POOLT = (bf16_t*)(ws + OFF_POOLT); bf16_t* WSB = (bf16_t*)(ws + OFF_WS); \
    float* MOD = (float*)(ws + OFF_MOD); float* ROPE = (float*)(ws + OFF_ROPE); \
    bf16_t* H = (bf16_t*)(ws + OFF_H); bf16_t* MIX = H; \
    unsigned char* R = ws + OFF_R; \
    bf16_t* U = (bf16_t*)(R + R_U); bf16_t* PB = (bf16_t*)R; bf16_t* H2 = (bf16_t*)R; \
    float* RSS = (float*)(ws + OFF_RSS); float* B13 = (float*)(ws + OFF_B13); float* BIN = (float*)(ws + OFF_BIN); \
    bf16_t* QKVLAT = (bf16_t*)(R + R_QKVLAT); float* KROPE = (float*)(R + R_KROPE); float* PROJ = (float*)(R + R_PROJ); \
    bf16_t* GM = (bf16_t*)(R + R_GM); float* QKVRAW = (float*)(R + R_QKVRAW); bf16_t* QKV = (bf16_t*)(R + R_QKVRAW);

__global__ void __launch_bounds__(512, 2) fwd_mega(Args args) {
    extern __shared__ __attribute__((aligned(16))) unsigned char lds[];
    cg::grid_group grid = cg::this_grid();
    int tid = threadIdx.x, lane = tid & 63, wave = __builtin_amdgcn_readfirstlane(tid >> 6);
    const int G = gridDim.x, bid = blockIdx.x;
    int gw = bid * 8 + wave; const int NGW = G * 8;
    long gt = (long)bid * 512 + tid; const long NGT = (long)G * 512;
    const int lo = args.ph_lo, hi = args.ph_hi;
    int pid = 0;
    unsigned* BARW = (unsigned*)(args.ws + OFF_CTL);
    volatile LAS unsigned* MISC = (volatile LAS unsigned*)((LAS unsigned char*)lds + 131072);
    if (tid < 16) MISC[tid] = 0u;
    if (bid == 0) for (int i = tid; i < XCD_BAR_WORDS; i += 512) BARW[i] = 0u;
    __syncthreads();
    XcdBarrier xbar; xbar.bar = BARW; xbar.x = 0; xbar.st = MISC;

    for (int rep0 = 0; rep0 < ((DUPMASK & 1) ? 2 : 1); ++rep0)
    if (EN_PRO && pid >= lo && pid < hi) {
        DERIVE_PTRS
        if (bid < 288) {
            LAS float* S = (LAS float*)lds; LAS float* P = (LAS float*)(lds + 36864);
            for (int idx = tid; idx < 9216; idx += 512) { const int cv = idx >> 10, k = idx & 1023; const float x = cv == 0 ? args.in[5][k] : args.in[4][(cv - 1) * 1024 + k]; S[idx] = x / (1.0f + expf(-x)); }
            __syncthreads();
            for (int item = bid; item < 288; item += G) {
                const int l = item / 72, cb = item % 72, j = tid & 127, s = tid >> 7;
                float acc[9];
#pragma unroll
                for (int cv = 0; cv < 9; ++cv) acc[cv] = 0.f;
                const float* wp = args.in[6] + ((size_t)l * 1024 + s * 256) * NMOD + cb * 128 + j;
                for (int k = 0; k < 256; k += 16) {
                    float wv[16];
#pragma unroll
                    for (int i = 0; i < 16; ++i) wv[i] = wp[(size_t)(k + i) * NMOD];
#pragma unroll
                    for (int cv = 0; cv < 9; ++cv) { const LAS float* sp = S + cv * 1024 + s * 256 + k;
#pragma unroll
                        for (int i = 0; i < 16; ++i) acc[cv] += sp[i] * wv[i]; }
                }
#pragma unroll
                for (int cv = 0; cv < 9; ++cv) P[(s * 9 + cv) * 128 + j] = acc[cv];
                __syncthreads();
                for (int idx = tid; idx < 1152; idx += 512) { const int cv = idx >> 7, jj = idx & 127;
                    const float v = P[(0 * 9 + cv) * 128 + jj] + P[(1 * 9 + cv) * 128 + jj] + P[(2 * 9 + cv) * 128 + jj] + P[(3 * 9 + cv) * 128 + jj] + args.in[7][l * NMOD + cb * 128 + jj];
                    MOD[((size_t)l * 9 + cv) * NMOD + cb * 128 + jj] = v; }
                __syncthreads();
            }
        }
        __syncthreads();
        {
            LAS float* scr = (LAS float*)(lds + 57344 + wave * 8448);
            for (int it0 = gw; it0 < 36832; it0 += NGW) {
                int it = it0; const float* src; int ldw, ldd; bf16_t* dst;
                if (it < 33792) { const int ls = it / 4224, r = it % 4224, which = r / 1408, q = r % 1408;
                    if (which < 2) { const int kb = q / 88, nb = q % 88, k0 = kb * 64, n0 = nb * 32; src = args.in[which ? 10 : 9] + (size_t)ls * 1024 * FF + (size_t)k0 * FF + n0; ldw = FF;
                        const int drow = (n0 >> 7) * 256 + (n0 & 127) + which * 128; dst = W13 + (size_t)ls * 5632 * 1024 + (size_t)drow * 1024 + k0; ldd = 1024; }
                    else { const int kb = q / 32, nb = q % 32, k0 = kb * 64, n0 = nb * 32; src = args.in[11] + (size_t)ls * FF * 1024 + (size_t)k0 * 1024 + n0; ldw = 1024;
                        dst = W2 + (size_t)ls * 1024 * FF + (size_t)n0 * FF + k0; ldd = FF; } }
                else { it -= 33792;
                if (it < 1440) { const int j = it / 720, q = it % 720, kb = q / 45, nb = q % 45, k0 = kb * 64, n0 = nb * 32; src = args.in[12] + (size_t)j * 1024 * 1440 + (size_t)k0 * 1440 + n0; ldw = 1440;
                    const int drow = n0 < 416 ? n0 : n0 + 96; dst = WIN + (size_t)j * 1536 * 1024 + (size_t)drow * 1024 + k0; ldd = 1024; }
                else { it -= 1440;
                if (it < 192) { const int j = it / 96, q = it % 96, kb = q / 24, nb = q % 24, k0 = kb * 64, n0 = nb * 32; src = args.in[15] + (size_t)j * 256 * 768 + (size_t)k0 * 768 + n0; ldw = 768;
                    dst = WQKV + (size_t)j * 1792 * 384 + (size_t)n0 * 384 + k0; ldd = 384; }
                else { it -= 192;
                if (it < 128) { const int j = it / 64, q = it % 64, kb = q / 32, nb = q % 32, k0 = kb * 64, n0 = nb * 32; src = args.in[16] + (size_t)j * 128 * 1024 + (size_t)k0 * 1024 + n0; ldw = 1024;
                    dst = WQKV + (size_t)j * 1792 * 384 + (size_t)(768 + n0) * 384 + 256 + k0; ldd = 384; }
                else { it -= 128;
                if (it < 1024) { const int j = it / 512, q = it % 512, kb = q / 32, nb = q % 32, k0 = kb * 64, n0 = nb * 32; src = args.in[22] + (size_t)j * 1024 * 1024 + (size_t)k0 * 1024 + n0; ldw = 1024;
                    dst = WOUT + (size_t)j * 1024 * 1024 + (size_t)n0 * 1024 + k0; ldd = 1024; }
                else { it -= 1024;
                    const int jg = it / 32, q = it % 32, kb = q / 8, nb = q % 8, k0 = kb * 64, n0 = nb * 32; src = args.in[23] + (size_t)jg * 65536 + (size_t)k0 * 256 + n0; ldw = 256;
                    dst = POOLT + (size_t)jg * 65536 + (size_t)n0 * 256 + k0; ldd = 256; } } } } }
                tr_item(src, ldw, dst, ldd, scr, lane);
            }
        }
        {
            const u32x4 z = {0u, 0u, 0u, 0u};
            for (long i = gt; i < 2 * 12288; i += NGT) { const int j = (int)(i / 12288); const long q = i % 12288; *(u32x4*)(WIN + (size_t)j * 1536 * 1024 + (size_t)416 * 1024 + q * 8) = z; }
            for (long i = gt; i < 2 * 45056; i += NGT) { const int j = (int)(i / 45056); const long q = i % 45056; bf16_t* base = WQKV + (size_t)j * 1792 * 384;
                if (q < 12288) { const int row = (int)(q >> 4), c = (int)(q & 15); *(u32x4*)(base + (size_t)row * 384 + 256 + c * 8) = z; }
                else { const long q2 = q - 12288; const int row = 768 + (int)(q2 >> 5), c = (int)(q2 & 31); *(u32x4*)(base + (size_t)row * 384 + c * 8) = z; } }
        }
        for (long i = gt; i < 131072 / 4; i += NGT) { const f32x4 v = *(const f32x4*)(args.in[20] + i * 4); u32x2 w; w.x = cvt_pk_bf16(v[0], v[1]); w.y = cvt_pk_bf16(v[2], v[3]); *(u32x2*)(WSB + i * 4) = w; }
        for (long i = gt; i < 65536; i += NGT) { const int t = (int)(i >> 4), ai = (int)(i & 15), a = ai >> 3, fi = ai & 7;
            const float inv = powf(10000.0f, -(float)(2 * fi) / 16.0f); const float pos = (float)(a == 0 ? (t >> 6) : (t & 63)); const float ang = pos * inv;
            ROPE[i] = cosf(ang); ROPE[65536 + i] = sinf(ang); }
        { const f32x4 z4 = {0.f, 0.f, 0.f, 0.f}; for (long i = gt; i < (long)12 * MTOK / 4; i += NGT) *(f32x4*)(RSS + i * 4) = z4; }
    }
    grid.sync();
    xbar = xcd_barrier_post(BARW, MISC);
    ++pid;
    for (int rep1 = 0; rep1 < ((DUPMASK & 2) ? 2 : 1); ++rep1)
    if (pid >= lo && pid < hi) {
        DERIVE_PTRS
        for (int it = gw; it < 8 * 5632 + 2 * 1536; it += NGW) {
            const bf16_t* wrow; const float* shp; float* outp; int cvs;
            if (it < 8 * 5632) { const int ls = it / 5632, n = it - ls * 5632, l = ls >> 1, sub = ls & 1; wrow = W13 + ((size_t)ls * 5632 + n) * 1024;
                shp = MOD + (size_t)l * 9 * NMOD + (sub ? 6 : 0) * 1024; outp = B13 + (size_t)ls * 9 * 5632 + n; cvs = 5632; }
            else { const int q = it - 8 * 5632, jj = q / 1536, n = q - jj * 1536; wrow = WIN + ((size_t)jj * 1536 + n) * 1024;
                shp = MOD + (size_t)(2 * jj) * 9 * NMOD + 3 * 1024; outp = BIN + (size_t)jj * 9 * 1536 + n; cvs = 1536; }
            const u32x4 w0 = *(const u32x4*)(wrow + lane * 8), w1 = *(const u32x4*)(wrow + 512 + lane * 8);
            float wv[16];
#pragma unroll
            for (int e = 0; e < 4; ++e) { wv[2 * e] = bflo(w0[e]); wv[2 * e + 1] = bfhi(w0[e]); wv[8 + 2 * e] = bflo(w1[e]); wv[8 + 2 * e + 1] = bfhi(w1[e]); }
            float res = 0.f;
#pragma unroll
            for (int cv = 0; cv < 9; ++cv) { const float* sp = shp + (size_t)cv * NMOD; float a = 0.f;
#pragma unroll
                for (int hf = 0; hf < 2; ++hf) { const f32x4 s0 = *(const f32x4*)(sp + hf * 512 + lane * 8), s1 = *(const f32x4*)(sp + hf * 512 + lane * 8 + 4);
                    a += (s0[0] * wv[hf * 8 + 0] + s0[1] * wv[hf * 8 + 1]) + (s0[2] * wv[hf * 8 + 2] + s0[3] * wv[hf * 8 + 3]) + (s1[0] * wv[hf * 8 + 4] + s1[1] * wv[hf * 8 + 5]) + (s1[2] * wv[hf * 8 + 6] + s1[3] * wv[hf * 8 + 7]); }
                a = wave_sum(a); if (lane == cv) res = a; }
            if (lane < 9) outp[(size_t)lane * cvs] = res;
        }
        for (int rb = gw; rb < MTOK; rb += 2 * NGW) {
            f32x4 v[2][4]; float ss[2]; int rr[2];
#pragma unroll
            for (int u2 = 0; u2 < 2; ++u2) { const int r = (rb + u2 * NGW < MTOK) ? rb + u2 * NGW : rb; rr[u2] = r;
                const float* xr = r < NCTX ? args.in[0] + (size_t)r * 1024 : args.in[1] + (size_t)(r - NCTX) * 1024; ss[u2] = 0.f;
#pragma unroll
                for (int q = 0; q < 4; ++q) { v[u2][q] = *(const f32x4*)(xr + 4 * lane + 256 * q); ss[u2] += (v[u2][q][0] * v[u2][q][0] + v[u2][q][1] * v[u2][q][1]) + (v[u2][q][2] * v[u2][q][2] + v[u2][q][3] * v[u2][q][3]); } }
#pragma unroll
            for (int u2 = 0; u2 < 2; ++u2) { if (u2 == 1 && rb + NGW >= MTOK) break; const int r = rr[u2]; const int cv = cv_of_row(r);
                const float* scp = MOD + (size_t)cv * NMOD + 1024; const float* gptr = args.in[8];
                const float st = wave_sum(ss[u2]); if (lane == 0) RSS[r] = st;
#pragma unroll
                for (int q = 0; q < 4; ++q) { const int c = 4 * lane + 256 * q; const f32x4 g4 = *(const f32x4*)(gptr + c), sc = *(const f32x4*)(scp + c);
                    *(f32x4*)(X + (size_t)r * 1024 + c) = v[u2][q];
                    const f32x4 hh = v[u2][q] * g4 * (sc + 1.0f); u32x2 w; w.x = cvt_pk_bf16(hh[0], hh[1]); w.y = cvt_pk_bf16(hh[2], hh[3]);
                    *(u32x2*)(H + (size_t)r * 1024 + c) = w; } }
        }
        if (pid + 1 < hi) xcd_barrier(xbar);
    }
    ++pid;

    for (int layer = 0; layer < 4; ++layer) {
        const int j = layer >> 1;
        const unsigned long long prog = (layer & 1) ? 0xDCFE32ull : 0xDCA9876532ull;
        const int nsteps = (layer & 1) ? 6 : 10;
        for (int step = 0; step < nsteps; ++step, ++pid) {
            if (!(pid >= lo && pid < hi)) continue;
            const int op = (int)((prog >> (4 * step)) & 15ull);
            const int reps = ((DUPMASK >> op) & 1) ? 2 : 1;
            for (int rep = 0; rep < reps; ++rep) {
            DERIVE_PTRS
            int bid = blockIdx.x; asm volatile("" : "+s"(bid)); int G = gridDim.x; asm volatile("" : "+s"(G));
            const int NGW = G * 8; const long NGT = (long)G * 512;
            const float* MODL = MOD + (size_t)layer * 9 * NMOD;
            tid = threadIdx.x; asm volatile("" : "+v"(tid)); lane = tid & 63; wave = __builtin_amdgcn_readfirstlane(tid >> 6); gw = bid * 8 + wave; gt = (long)bid * 512 + tid;
            if (EN_G1 && (op == 2 || op == 12)) {
                const int sub = op == 2 ? 0 : 1;
                const bf16_t* Ain = (sub == 1 && !(layer & 1)) ? H2 : H;
                pg8::Gemm g{Ain, W13 + (size_t)(layer * 2 + sub) * 5632 * 1024, MTOK, 5632, 1024, 1024, 1024, 0};
                pg8::StaticOrder S; S.init(MTOK, 5632, G, bid);
                pg8::EpiSwiglu E{U, RSS + (size_t)(layer * 3 + (sub ? 2 : 0)) * MTOK, B13 + (size_t)(layer * 2 + sub) * 9 * 5632};
                pg8::gemm_phase<pg8::EpiSwiglu>((LAS unsigned char*)lds, g, S, E);
            } else if (EN_GRES && (op == 3 || op == 13 || op == 10 || op == 15)) {
                const bf16_t* gA; const bf16_t* gB; int gK, glda, gldb, gapn; const float* egate; const float* escale; float ecoef;
                if (op == 3 || op == 13) { const int sub = op == 3 ? 0 : 1; gA = U; gB = W2 + (size_t)(layer * 2 + sub) * 1024 * FF; gK = FF; glda = FF; gldb = FF; gapn = 0;
                    egate = MODL + (sub ? 8 : 2) * 1024; escale = nullptr; ecoef = 0.5f; }
                else if (op == 10) { gA = MIX; gB = WOUT + (size_t)j * 1024 * 1024; gK = 1024; glda = 1024; gldb = 1024; gapn = 0; egate = MODL + 5 * 1024; escale = nullptr; ecoef = 1.0f; }
                else { gA = PB; gB = POOLT + (size_t)j * 1024 * 256; gK = 256; glda = 1024; gldb = 256; gapn = 512; egate = MODL + 5 * 1024; escale = args.in[24] + (size_t)j * 1024; ecoef = 1.0f; }
                int ln = layer, kn; bf16_t* an = H;
                if (op == 3) kn = 1; else if (op == 13) { ln = layer + 1; kn = 0; } else { kn = 2; if (op == 10) an = H2; }
                if (ln >= 4) { an = nullptr; ln = 0; }
                const pg8::Gemm g{gA, gB, MTOK, 1024, gK, glda, gldb, gapn};
                const pg8::EpiResid E{X, egate, escale, an, args.in[8] + ((size_t)ln * 3 + kn) * 1024, MOD + (size_t)ln * 9 * NMOD + (3 * kn + 1) * 1024, RSS + (size_t)(ln * 3 + kn) * MTOK, ecoef, 0};
                pg8::StaticOrder S; S.init(MTOK, 1024, G, bid, 1);
                pg8::gemm_phase<pg8::EpiResid, true>((LAS unsigned char*)lds, g, S, E);
            } else if (EN_GRAW && (op == 5 || op == 7)) {
                const bool gin = op == 5;
                const pg8::Gemm g{gin ? (const bf16_t*)H : (const bf16_t*)QKVLAT, gin ? WIN + (size_t)j * 1536 * 1024 : WQKV + (size_t)j * 1792 * 384, gin ? MTOK : MEXT, gin ? 1536 : 1792, gin ? 1024 : 384, gin ? 1024 : 384, gin ? 1024 : 384, 0};
                const pg8::EpiRaw E{PROJ, gin ? GM : QKV, gin ? RSS + (size_t)(layer * 3 + 1) * MTOK : (const float*)nullptr, BIN + (size_t)j * 9 * 1536, 512, gin ? 2 : 0, gin ? 1024 : QLD, gin ? 1 : 0};
                pg8::StaticOrder S; S.init(gin ? MTOK : MEXT, gin ? 1536 : 1792, G, bid);
                pg8::gemm_phase<pg8::EpiRaw>((LAS unsigned char*)lds, g, S, E);
            } else if (EN_POST1 && op == 6) {
                {
                    LAS float* rs = (LAS float*)lds; LAS bf16_t* tT = (LAS bf16_t*)(lds + 1024);
                    const float* vn = args.in[19] + (size_t)j * 512; const float* gb = args.in[21] + (size_t)j * 512;
                    for (int item = bid; item < 1280; item += G) {
                        const int chunk = item >> 2, gq = item & 3; const size_t tok0 = (size_t)chunk * 128;
                        { u32x4 wv[16];
#pragma unroll
                          for (int tt = 0; tt < 16; ++tt) wv[tt] = *(const u32x4*)(GM + (tok0 + wave * 16 + tt) * 1024 + 512 + lane * 8);
#pragma unroll
                          for (int tt = 0; tt < 16; ++tt) { float ss = 0.f;
#pragma unroll
                            for (int e = 0; e < 4; ++e) { const float a = bflo(wv[tt][e]), b = bfhi(wv[tt][e]); ss += a * a + b * b; }
                            ss = wave_sum(ss); if (lane == 0) rs[wave * 16 + tt] = 1.0f / sqrtf(ss * (1.0f / 512.0f) + EPS); } }
                        __syncthreads();
                        { const int q = tid >> 2, cp = tid & 3; const float rq = rs[q];
#pragma unroll
                          for (int cc = 0; cc < 4; ++cc) { const int c0 = cp * 32 + cc * 8; const u32x4 w = *(const u32x4*)(GM + (tok0 + q) * 1024 + 512 + gq * 128 + c0);
                              const f32x4 n0 = *(const f32x4*)(vn + gq * 128 + c0), n1 = *(const f32x4*)(vn + gq * 128 + c0 + 4);
                              float v[8] = {bflo(w[0]) * n0[0], bfhi(w[0]) * n0[1], bflo(w[1]) * n0[2], bfhi(w[1]) * n0[3], bflo(w[2]) * n1[0], bfhi(w[2]) * n1[1], bflo(w[3]) * n1[2], bfhi(w[3]) * n1[3]};
#pragma unroll
                              for (int e = 0; e < 8; ++e) tT[(c0 + e) * 136 + q] = (bf16_t)(cvt_pk_bf16(v[e] * rq, 0.f) & 0xffffu); } }
                        __syncthreads();
                        f32x4 acc[8];
#pragma unroll
                        for (int n = 0; n < 8; ++n) acc[n] = (f32x4){0.f, 0.f, 0.f, 0.f};
                        const bf16_t* wsp = WSB + ((size_t)(j * 4 + gq) * 128 + wave * 16 + (lane & 15)) * 128 + 8 * (lane >> 4);
#pragma unroll
                        for (int ks = 0; ks < 4; ++ks) { const bf16x8 a = *(const bf16x8*)(wsp + 32 * ks);
#pragma unroll
                            for (int n = 0; n < 8; ++n) { const bf16x8 b = *(const LAS bf16x8*)(tT + (16 * n + (lane & 15)) * 136 + 32 * ks + 8 * (lane >> 4));
                                acc[n] = __builtin_amdgcn_mfma_f32_16x16x32_bf16(b, a, acc[n], 0, 0, 0); } }
                        { const int p = wave * 16 + (lane & 15); const size_t tok = tok0 + p; const float bsp = gb[gq * 128 + p];
                          u32x2 uu[8];
#pragma unroll
                          for (int n = 0; n < 8; ++n) uu[n] = *(const u32x2*)(GM + tok * 1024 + gq * 128 + 16 * n + 4 * (lane >> 4));
#pragma unroll
                          for (int n = 0; n < 8; ++n) { u32x2 w; w.x = cvt_pk_bf16(bflo(uu[n].x) * (acc[n][0] + bsp), bfhi(uu[n].x) * (acc[n][1] + bsp)); w.y = cvt_pk_bf16(bflo(uu[n].y) * (acc[n][2] + bsp), bfhi(uu[n].y) * (acc[n][3] + bsp));
                              *(u32x2*)(MIX + tok * 1024 + 512 + gq * 128 + 16 * n + 4 * (lane >> 4)) = w; } }
                        __syncthreads();
                    }
                }
                const float* qan = args.in[13] + (size_t)j * 256; const float* kvan = args.in[14] + (size_t)j * 128;
                for (int r = gw; r < MTOK; r += 2 * NGW) {
                    const int r1 = r + NGW; const bool has1 = r1 < MTOK;
                    P1Row p0, p1; p1_load(p0, PROJ + (size_t)r * 512, lane); p1_load(p1, PROJ + (size_t)(has1 ? r1 : r) * 512, lane);
                    p1_finish(p0, r, j, lane, qan, kvan, QKVLAT, KROPE, OUT_CKV, OUT_KR); if (has1) p1_finish(p1, r1, j, lane, qan, kvan, QKVLAT, KROPE, OUT_CKV, OUT_KR);
                }
                for (int cidx = gw; cidx < 4096; cidx += NGW) {
                    const int b = cidx >> 9, p = cidx & 511; const int e = NCTX + b * KVB + LLAT + p;
                    const u32x2 z = {0u, 0u}; *(u32x2*)(QKVLAT + (size_t)e * 384 + 4 * lane) = z;
                    if (lane < 32) { const f32x4 kv = *(const f32x4*)(args.in[2] + (((size_t)b * 2 + j) * 512 + p) * 128 + 4 * lane); u32x2 w2; w2.x = cvt_pk_bf16(kv[0], kv[1]); w2.y = cvt_pk_bf16(kv[2], kv[3]);
                        *(u32x2*)(QKVLAT + (size_t)e * 384 + 256 + 4 * lane) = w2; }
                }
            } else if (EN_POST2 && op == 8) {
                const float* qn = args.in[17] + (size_t)j * 96; const float* kn = args.in[18] + (size_t)j * 96;
                const int hh = lane >> 3, s = lane & 7;
                for (int e = gw; e < MEXT; e += 2 * NGW) {
                    const int e1 = e + NGW; const bool has1 = e1 < MEXT;
                    P2Row r0, r1;
                    p2_load(r0, e, j, hh, s, QKV, KROPE, args.in[3]); p2_load(r1, has1 ? e1 : e, j, hh, s, QKV, KROPE, args.in[3]);
                    p2_compute(r0, s, qn, kn, ROPE); p2_compute(r1, s, qn, kn, ROPE);
                    asm volatile("s_waitcnt vmcnt(0)" ::: "memory");
                    p2_store(r0, hh, s, QKV); if (has1) p2_store(r1, hh, s, QKV);
                    asm volatile("" ::: "memory");
                }
            } else if (EN_ATT && op == 9) {
                const int vcu = (G % 8 == 0) ? (bid % 8) * (G / 8) + bid / 8 : bid;
                for (int u = vcu; u < 1280; u += G) {
                    const bf16_t *Qb, *Kh, *Vh; bf16_t* Ob; int seq;
                    if (u < 1024) { const int bh = u >> 4, qt = u & 15, b = bh >> 3, h = bh & 7; const size_t e0 = NCTX + (size_t)b * KVB;
                        Qb = QKV + (e0 + qt * 256) * QLD + h * 96; Kh = QKV + e0 * QLD + 768 + h * 96; Vh = QKV + e0 * QLD + 1536 + h * 64;
                        Ob = MIX + ((size_t)NCTX + (size_t)b * LLAT + qt * 256) * 1024 + h * 64; seq = KVB; }
                    else { const int vv = u - 1024, b = vv >> 3, h = vv & 7; const size_t e0 = (size_t)b * 256;
                        Qb = QKV + e0 * QLD + h * 96; Kh = QKV + e0 * QLD + 768 + h * 96; Vh = QKV + e0 * QLD + 1536 + h * 64; Ob = MIX + e0 * 1024 + h * 64; seq = 256; }
                    __syncthreads();
                    att::attn_unit(Qb, Kh, Vh, Ob, seq, (char*)lds);
                }
            } else if (EN_POOL && op == 14) {
                const float* rs = RSS + (size_t)(layer * 3 + 1) * MTOK;
                for (long i = gt; i < (long)(MTOK / 32) * 128; i += NGT) {
                    const int seg = (int)(i >> 7), ch = (int)(i & 127), hw = 1 << (ch >> 5);
                    const int r0 = seg * 32; int t0, L; if (r0 < NCTX) { t0 = r0 & 255; L = 256; } else { t0 = (r0 - NCTX) & 4095; L = 4096; }
                    const int base = r0 - t0; const bf16_t* __restrict__ hp = H + (size_t)base * 1024 + ch * 8; const float* __restrict__ rsp = rs + base; bf16_t* __restrict__ pbp = PB + (size_t)base * 1024 + ch * 8;
                    float sum[8];
#pragma unroll
                    for (int e2 = 0; e2 < 8; ++e2) sum[e2] = 0.f;
#define POOL_LD(tt, wgt) do { const u32x4 w_ = *(const u32x4*)(hp + (size_t)(tt) * 1024); const float q_ = (wgt) * __builtin_amdgcn_rsqf(rsp[tt] * (1.0f / 1024.0f) + EPS); \
                        _Pragma("unroll") for (int e2 = 0; e2 < 4; ++e2) { sum[2 * e2] += bflo(w_[e2]) * q_; sum[2 * e2 + 1] += bfhi(w_[e2]) * q_; } } while (0)
#pragma unroll
                    for (int i2 = 0; i2 < 16; ++i2) { const int tt = t0 - hw + i2; const bool ok = (i2 < 2 * hw) && tt >= 0; const int tc = tt < 0 ? 0 : (tt > L - 1 ? L - 1 : tt); POOL_LD(tc, ok ? 1.0f : 0.0f); }
#pragma unroll 4
                    for (int t = t0; t < t0 + 32; ++t) {
                        const int lo2 = t - hw < 0 ? 0 : t - hw, hi2 = t + hw > L ? L : t + hw; const float inv = 1.0f / (float)(hi2 - lo2);
                        const u32x4 w0 = *(const u32x4*)(hp + (size_t)t * 1024); const float q0 = __builtin_amdgcn_rsqf(rsp[t] * (1.0f / 1024.0f) + EPS); u32x4 o;
#pragma unroll
                        for (int e2 = 0; e2 < 4; ++e2) o[e2] = cvt_pk_bf16(sum[2 * e2] * inv - bflo(w0[e2]) * q0, sum[2 * e2 + 1] * inv - bfhi(w0[e2]) * q0);
                        *(u32x4*)(pbp + (size_t)t * 1024) = o;
                        { const int tp = t + hw, tm = t - hw; const int tpc = tp > L - 1 ? L - 1 : tp, tmc = tm < 0 ? 0 : tm;
                          POOL_LD(tpc, tp < L ? 1.0f : 0.0f); POOL_LD(tmc, tm >= 0 ? -1.0f : 0.0f); }
                    }
#undef POOL_LD
                }
            }
            if (rep + 1 < reps || pid + 1 < hi) xcd_barrier(xbar);
            }
        }
    }
}

extern "C" void kernel_launch(void* const* d_in, const int* in_sizes, int n_in, void* d_out, int out_size, void* d_ws, size_t ws_size, hipStream_t stream) {
    static int grid = 0;
    if (grid == 0) {
        if (n_in != 25 || ws_size < WS_NEED) { fprintf(stderr, "kernel_launch: n_in %d ws %zu (need %zu)\n", n_in, ws_size, (size_t)WS_NEED); grid = -1; return; }
        int dev = 0, cus = 0, per_cu = 0;
        hipGetDevice(&dev); hipDeviceGetAttribute(&cus, hipDeviceAttributeMultiprocessorCount, dev);
        if (hipFuncSetAttribute((const void*)fwd_mega, hipFuncAttributeMaxDynamicSharedMemorySize, LDS_BYTES) != hipSuccess) { fprintf(stderr, "kernel_launch: hipFuncSetAttribute failed\n"); grid = -1; return; }
        if (hipOccupancyMaxActiveBlocksPerMultiprocessor(&per_cu, (const void*)fwd_mega, 512, LDS_BYTES) != hipSuccess || per_cu < 1) { fprintf(stderr, "kernel_launch: occupancy query gave %d\n", per_cu); per_cu = 1; }
        (void)hipGetLastError();
        grid = cus * per_cu;
    }
    if (grid < 0) return;
    Args a{};
    for (int i = 0; i < 25; ++i) a.in[i] = (const float*)d_in[i];
    a.out = (float*)d_out; a.ws = (unsigned char*)d_ws; a.ph_lo = 0; a.ph_hi = 34;
    void* kargs[] = {&a};
    hipError_t e = hipLaunchCooperativeKernel((const void*)fwd_mega, dim3(grid), dim3(512), kargs, LDS_BYTES, stream);
    if (e != hipSuccess) fprintf(stderr, "kernel_launch: cooperative launch failed: %s (grid %d)\n", hipGetErrorString(e), grid);
}
```

```cpp
#include <hip/hip_runtime.h>
#include <hip/hip_cooperative_groups.h>
#include <cstdio>
#include <cstdint>
namespace cg = cooperative_groups;
#ifndef EN_NORM
#define EN_NORM 1
#endif
#ifndef EN_G1
#define EN_G1 1
#endif
#ifndef EN_GRES
#define EN_GRES 1
#endif
#ifndef EN_GRAW
#define EN_GRAW 1
#endif
#ifndef EN_POST1
#define EN_POST1 1
#endif
#ifndef EN_POST2
#define EN_POST2 1
#endif
#ifndef EN_ATT
#define EN_ATT 1
#endif
#ifndef EN_POOL
#define EN_POOL 1
#endif
#ifndef EN_PRO
#define EN_PRO 1
#endif
#ifndef DUPMASK
#define DUPMASK 0
#endif

#define LAS __attribute__((address_space(3)))
typedef unsigned short bf16_t;
typedef short bf16x8 __attribute__((ext_vector_type(8)));
typedef short s16x4 __attribute__((ext_vector_type(4)));
typedef float f32x4 __attribute__((ext_vector_type(4)));
typedef float f32x16 __attribute__((ext_vector_type(16)));
typedef unsigned u32x4 __attribute__((ext_vector_type(4)));
typedef unsigned u32x2 __attribute__((ext_vector_type(2)));

constexpr int DM = 1024, FF = 2816, MTOK = 40960, MEXT = 45056, NCTX = 8192, LLAT = 4096, PAST = 512, KVB = 4608;
constexpr int NMOD = 9216;
constexpr int QLD = 2048;
constexpr float EPS = 1e-6f;
constexpr size_t SZ_W13 = (size_t)8 * 5632 * 1024 * 2, SZ_W2 = (size_t)8 * 1024 * 2816 * 2, SZ_WIN = (size_t)2 * 1536 * 1024 * 2,
                 SZ_WQKV = (size_t)2 * 1792 * 384 * 2, SZ_WOUT = (size_t)2 * 1024 * 1024 * 2, SZ_POOLT = (size_t)2 * 1024 * 256 * 2,
                 SZ_WS = (size_t)2 * 4 * 128 * 128 * 2, SZ_MOD = (size_t)4 * 9 * NMOD * 4, SZ_ROPE = (size_t)2 * 4096 * 16 * 4,
                 SZ_H = (size_t)MTOK * 1024 * 2;
constexpr size_t OFF_W13 = 0, OFF_W2 = OFF_W13 + SZ_W13, OFF_WIN = OFF_W2 + SZ_W2, OFF_WQKV = OFF_WIN + SZ_WIN, OFF_WOUT = OFF_WQKV + SZ_WQKV,
                 OFF_POOLT = OFF_WOUT + SZ_WOUT, OFF_WS = OFF_POOLT + SZ_POOLT, OFF_MOD = OFF_WS + SZ_WS, OFF_ROPE = OFF_MOD + SZ_MOD,
                 OFF_H = OFF_ROPE + SZ_ROPE, OFF_R = OFF_H + SZ_H;
constexpr size_t R_QKVLAT = 0, R_KROPE = (size_t)MEXT * 384 * 2, R_PROJ = 41943040, R_GM = R_PROJ + (size_t)MTOK * 512 * 4,
                 R_QKVRAW = R_PROJ, SZ_R = SZ_H + (size_t)MTOK * 2816 * 2;
static_assert(R_KROPE + (size_t)MTOK * 32 * 4 <= R_PROJ, "ws map");
static_assert(R_QKVRAW + (size_t)MEXT * QLD * 2 <= SZ_R, "ws map");
constexpr size_t OFF_CTL = OFF_R + SZ_R, SZ_CTL = 16384;
constexpr size_t OFF_RSS = OFF_CTL + SZ_CTL, SZ_RSS = (size_t)12 * MTOK * 4;
constexpr size_t OFF_B13 = OFF_RSS + SZ_RSS, SZ_B13 = (size_t)8 * 9 * 5632 * 4;
constexpr size_t OFF_BIN = OFF_B13 + SZ_B13, SZ_BIN = (size_t)2 * 9 * 1536 * 4;
constexpr size_t R_U = SZ_H;
static_assert(R_U + (size_t)MTOK * 2816 * 2 <= SZ_R, "ws map");
constexpr size_t WS_NEED = OFF_BIN + SZ_BIN;

__device__ __forceinline__ unsigned cvt_pk_bf16(float lo, float hi) { unsigned r; asm volatile("v_cvt_pk_bf16_f32 %0, %1, %2" : "=v"(r) : "v"(lo), "v"(hi)); return r; }
__device__ __forceinline__ float bf2f(unsigned short b) { return __uint_as_float(((unsigned)b) << 16); }
__device__ __forceinline__ float bflo(unsigned w) { return __uint_as_float(w << 16); }
__device__ __forceinline__ float bfhi(unsigned w) { return __uint_as_float(w & 0xffff0000u); }
__device__ __forceinline__ float wave_sum(float v) {
#pragma unroll
    for (int o = 1; o < 64; o <<= 1) v += __shfl_xor(v, o);
    return v;
}
__device__ __forceinline__ float fast_sigmoid(float x) { return __builtin_amdgcn_rcpf(1.0f + __builtin_amdgcn_exp2f(-1.4426950408889634f * x)); }
__device__ __forceinline__ float silu_f(float x) { return x * fast_sigmoid(x); }
__device__ __forceinline__ float gelu_tanh_f(float x) { const float y = 0.7978845608028654f * (x + 0.044715f * x * x * x); return x * fast_sigmoid(2.0f * y); }
__device__ __forceinline__ f32x4 sigmoid4(f32x4 x) {
    const f32x4 t = x * -1.4426950408889634f; f32x4 e;
#pragma unroll
    for (int i = 0; i < 4; ++i) e[i] = __builtin_amdgcn_exp2f(t[i]);
    const f32x4 d = e + 1.0f; f32x4 r;
#pragma unroll
    for (int i = 0; i < 4; ++i) r[i] = __builtin_amdgcn_rcpf(d[i]);
    return r;
}
__device__ __forceinline__ f32x4 silu4(f32x4 x) { return x * sigmoid4(x); }
__device__ __forceinline__ f32x4 gelu_tanh4(f32x4 x) { const f32x4 y = (x + x * x * x * 0.044715f) * (2.0f * 0.7978845608028654f); return x * sigmoid4(y); }
__device__ __forceinline__ int cv_of_row(int r) { return r < NCTX ? 0 : 1 + ((r - NCTX) >> 12); }

#ifndef PROBE_KREP
#define PROBE_KREP 1
#endif
namespace pg8 {
constexpr int BM = 256, BK = 64, HALF = 128, HTB = HALF * BK * 2, STAGE_BYTES = 8 * HTB, NXCD = 8, WGM = 8;
__host__ __device__ __forceinline__ int lds_byte(int r, int c) { const int st = (r >> 4) * 2 + (c >> 5), rr = r & 15, cc = c & 31, ob = rr * 64 + cc * 2; return st * 1024 + (ob ^ (((ob >> 9) & 1) << 5)); }
__host__ __device__ __forceinline__ void stage_rc(int b, int& R, int& C) { const int st = b / 1024, sb = b % 1024, swz = sb ^ (((sb >> 9) & 1) << 5); R = (st >> 1) * 16 + swz / 64; C = (st & 1) * 32 + (swz % 64) / 2; }
__host__ __device__ __forceinline__ int perm32(int rho) { const int n = rho >> 4, i = rho & 15; return 8 * (i >> 2) + 4 * n + (i & 3); }

struct Unit { int pm, pn, half; };
struct Gemm { const bf16_t* A; const bf16_t* Bt; int M, N, K, lda, ldb, apn; };

struct StaticOrder {
    int nM, nN, nwg, G, c, ht;
    __device__ void init(int M, int N, int G_, int c_, int ht_ = 0) { nM = M / BM; nN = N / BM; nwg = nM * nN; G = G_; c = c_; ht = ht_; }
    __device__ bool next(int i, Unit& u) const {
        long L = (long)i * G + c; u.half = -1;
        if (ht) { const int nfull = nwg / G, rem = nwg - nfull * G;
            if (rem > 0 && 2 * rem <= G && i >= nfull) { if (i > nfull || (c >> 1) >= rem) return false; L = (long)nfull * G + (c >> 1); u.half = c & 1; } }
        if (L >= nwg) return false;
        int wgid = (int)L; { const int q = nwg / NXCD, r = nwg % NXCD, xcd = wgid % NXCD, off = wgid / NXCD; wgid = (xcd < r ? xcd * (q + 1) : r * (q + 1) + (xcd - r) * q) + off; }
        const int nig = WGM * nN, gid = wgid / nig, fm = gid * WGM, gsz = (nM - fm) < WGM ? (nM - fm) : WGM;
        u.pm = fm + ((wgid % nig) % gsz); u.pn = (wgid % nig) / gsz; return true;
    }
};

struct EpiSwiglu {
    static constexpr bool PERM = true; static constexpr int KREP = PROBE_KREP;
    bf16_t* U; const float* rss; const float* bias;
    static constexpr bool PREF = true;
    __device__ __forceinline__ bool pref_on() const { return true; }
    __device__ __forceinline__ const float* pref_ptr(const Unit& u, int tid) const { const int cv = u.pm < 32 ? 0 : 1 + ((u.pm - 32) >> 4);
        return tid < 256 ? rss + u.pm * BM + tid : bias + (size_t)cv * 5632 + u.pn * BM + (tid - 256); }
    __device__ __forceinline__ void run(f32x4 (&acc)[2][2][4][2], const Unit& u, int wr, int wc, int fr, int fq, const LAS float* sc) const {
        const int row0 = u.pm * BM + wr * 64 + fr, col0 = u.pn * HALF + wc * 32 + 8 * fq;
        const LAS float* bp = sc + 256 + wc * 32 + 8 * fq;
        const f32x4 ba0 = *(const LAS f32x4*)(bp), ba1 = *(const LAS f32x4*)(bp + 4), bb0 = *(const LAS f32x4*)(bp + HALF), bb1 = *(const LAS f32x4*)(bp + HALF + 4);
#pragma unroll
        for (int ai = 0; ai < 2; ++ai)
#pragma unroll
            for (int m = 0; m < 4; ++m) {
                const int row = row0 + ai * HALF + m * 16;
                bf16_t* rowp = U + (size_t)row * FF + col0;
                const float rstd = (1.0f / (float)KREP) * __builtin_amdgcn_rsqf(sc[ai * HALF + wr * 64 + m * 16 + fr] * (1.0f / 1024.0f) + EPS);
                const f32x4 a0 = acc[ai][0][m][0] * rstd + ba0, a1 = acc[ai][0][m][1] * rstd + ba1, b0 = acc[ai][1][m][0] * rstd + bb0, b1 = acc[ai][1][m][1] * rstd + bb1;
                const f32x4 v0 = silu4(a0) * b0, v1 = silu4(a1) * b1;
                u32x4 w; w.x = cvt_pk_bf16(v0[0], v0[1]); w.y = cvt_pk_bf16(v0[2], v0[3]); w.z = cvt_pk_bf16(v1[0], v1[1]); w.w = cvt_pk_bf16(v1[2], v1[3]);
                *(u32x4*)rowp = w;
            }
    }
};
struct EpiResid {
    static constexpr bool PERM = true; static constexpr int KREP = 1;
    float* X; const float* gate; const float* scale;
    bf16_t* An; const float* gn; const float* scn; float* rssn;
    float coef; int pad_;
    static constexpr bool PREF = false;
    __device__ __forceinline__ bool pref_on() const { return false; }
    __device__ __forceinline__ const float* pref_ptr(const Unit&, int) const { return nullptr; }
    __device__ __forceinline__ void run(f32x4 (&acc)[2][2][4][2], const Unit& u, int wr, int wc, int fr, int fq, const LAS float*) const {
        const int row0 = u.pm * BM + wr * 64 + fr; int col0 = u.pn * BM + wc * 32 + 8 * fq;
        const int cv = u.pm < 32 ? 0 : 1 + ((u.pm - 32) >> 4);
        const bool nx = An != nullptr;
        const int hb = u.half > 0 ? HALF : 0, nbj = u.half < 0 ? 2 : 1;
        col0 += hb;
        f32x4 gv[2][2], gm[2][2];
#pragma unroll
        for (int bj = 0; bj < 2; ++bj)
#pragma unroll
            for (int n = 0; n < 2; ++n) { const int c = col0 + (bj < nbj ? bj : 0) * HALF + 4 * n; f32x4 g = *(const f32x4*)(gate + (size_t)cv * NMOD + c) * coef;
                if (scale) g = g * *(const f32x4*)(scale + c); gv[bj][n] = g;
                gm[bj][n] = nx ? *(const f32x4*)(gn + c) * (*(const f32x4*)(scn + (size_t)cv * NMOD + c) + 1.0f) : (f32x4){0.f, 0.f, 0.f, 0.f}; }
#pragma unroll
        for (int ai = 0; ai < 2; ++ai)
#pragma unroll
            for (int m = 0; m < 4; ++m) { const int row = row0 + ai * HALF + m * 16; float* rowp = X + (size_t)row * DM + col0;
                float ss = 0.f;
#pragma unroll
                for (int bj = 0; bj < 2; ++bj) if (bj < nbj) { f32x4* p = (f32x4*)(rowp + bj * HALF);
                    const f32x4 x0 = __builtin_nontemporal_load(p) + acc[ai][bj][m][0] * gv[bj][0], x1 = __builtin_nontemporal_load(p + 1) + acc[ai][bj][m][1] * gv[bj][1];
                    __builtin_nontemporal_store(x0, p); __builtin_nontemporal_store(x1, p + 1);
                    if (nx) { ss += ((x0[0] * x0[0] + x0[1] * x0[1]) + (x0[2] * x0[2] + x0[3] * x0[3])) + ((x1[0] * x1[0] + x1[1] * x1[1]) + (x1[2] * x1[2] + x1[3] * x1[3]));
                        const f32x4 a0 = x0 * gm[bj][0], a1 = x1 * gm[bj][1]; u32x4 w; w.x = cvt_pk_bf16(a0[0], a0[1]); w.y = cvt_pk_bf16(a0[2], a0[3]); w.z = cvt_pk_bf16(a1[0], a1[1]); w.w = cvt_pk_bf16(a1[2], a1[3]);
                        *(u32x4*)(An + (size_t)row * DM + col0 + bj * HALF) = w; } }
                if (nx) { ss += __shfl_xor(ss, 16); ss += __shfl_xor(ss, 32);
                    if (fq == 0) (void)__hip_atomic_fetch_add(rssn + row, ss, __ATOMIC_RELAXED, __HIP_MEMORY_SCOPE_AGENT); } }
    }
};
struct EpiRaw {
    static constexpr bool PERM = true; static constexpr int KREP = 1;
    float* R; bf16_t* G; const float* rss; const float* bias; int ldr, nraw, ldg, act;
    static constexpr bool PREF = true;
    __device__ __forceinline__ bool pref_on() const { return rss != nullptr; }
    __device__ __forceinline__ const float* pref_ptr(const Unit& u, int tid) const { const int cv = u.pm < 32 ? 0 : 1 + ((u.pm - 32) >> 4);
        return tid < 256 ? rss + u.pm * BM + tid : bias + (size_t)cv * 1536 + u.pn * BM + (tid - 256); }
    __device__ __forceinline__ void run(f32x4 (&acc)[2][2][4][2], const Unit& u, int wr, int wc, int fr, int fq, const LAS float* sc) const {
        const int row0 = u.pm * BM + wr * 64 + fr, cw = wc * 32 + 8 * fq;
        if (rss) {
            f32x4 bv[2][2];
#pragma unroll
            for (int bj = 0; bj < 2; ++bj)
#pragma unroll
                for (int n = 0; n < 2; ++n) bv[bj][n] = *(const LAS f32x4*)(sc + 256 + cw + bj * HALF + 4 * n);
#pragma unroll
            for (int ai = 0; ai < 2; ++ai)
#pragma unroll
                for (int m = 0; m < 4; ++m) { const float rstd = __builtin_amdgcn_rsqf(sc[ai * HALF + wr * 64 + m * 16 + fr] * (1.0f / 1024.0f) + EPS);
#pragma unroll
                    for (int bj = 0; bj < 2; ++bj)
#pragma unroll
                        for (int n = 0; n < 2; ++n) acc[ai][bj][m][n] = acc[ai][bj][m][n] * rstd + bv[bj][n]; }
        }
        if (u.pn < nraw) {
#pragma unroll
            for (int ai = 0; ai < 2; ++ai)
#pragma unroll
                for (int m = 0; m < 4; ++m) { float* rowp = R + (size_t)(row0 + ai * HALF + m * 16) * ldr + u.pn * BM + cw;
#pragma unroll
                    for (int bj = 0; bj < 2; ++bj) { *(f32x4*)(rowp + bj * HALF) = acc[ai][bj][m][0]; *(f32x4*)(rowp + bj * HALF + 4) = acc[ai][bj][m][1]; } }
        } else {
#pragma unroll
            for (int ai = 0; ai < 2; ++ai)
#pragma unroll
                for (int m = 0; m < 4; ++m) { bf16_t* rowp = G + (size_t)(row0 + ai * HALF + m * 16) * ldg + (u.pn - nraw) * BM + cw;
#pragma unroll
                    for (int bj = 0; bj < 2; ++bj) { f32x4 v0 = acc[ai][bj][m][0], v1 = acc[ai][bj][m][1];
                        if (act) { v0 = gelu_tanh4(v0); v1 = gelu_tanh4(v1); }
                        u32x4 w; w.x = cvt_pk_bf16(v0[0], v0[1]); w.y = cvt_pk_bf16(v0[2], v0[3]); w.z = cvt_pk_bf16(v1[0], v1[1]); w.w = cvt_pk_bf16(v1[2], v1[3]);
                        *(u32x4*)(rowp + bj * HALF) = w; } }
        }
    }
};

template <class Epi, bool HT = false>
__device__ __forceinline__ void gemm_phase(LAS unsigned char* lds, const Gemm g, const StaticOrder S, const Epi E) {
    int tid = threadIdx.x; asm volatile("" : "+v"(tid));
    const int wid = __builtin_amdgcn_readfirstlane(tid >> 6), lane = tid & 63, wr = wid >> 2, wc = wid & 3, fr = lane & 15, fq = lane >> 4;
    const int nt = g.K / BK;
    unsigned voffA[2], voffB[2];
#pragma unroll
    for (int i = 0; i < 2; ++i) { int R, C; stage_rc(tid * 16 + i * 8192, R, C); const int Rb = Epi::PERM ? ((R & ~31) + perm32(R & 31)) : R;
        voffA[i] = (unsigned)(R * g.lda + C) * 2u; voffB[i] = (unsigned)(Rb * g.ldb + C) * 2u; }
    const size_t kstep = (size_t)(BK * 2);
    const size_t hstepA = (size_t)HALF * g.lda * 2, hstepB = (size_t)HALF * g.ldb * 2;
    const size_t tstepA = 2 * hstepA, tstepB = 2 * hstepB;
    const unsigned ldsw = (unsigned)wid * 1024u;
    const int aoff = lds_byte(wr * 64 + fr, fq * 8), boff = lds_byte(wc * 32 + fr, fq * 8);
#define PG8_SA(b, h) (((b) * 2 + (h)) * HTB)
#define PG8_SB(b, h) ((4 + (b) * 2 + (h)) * HTB)
#define PG8_STAGE(bufoff, gbase, voff) do { _Pragma("unroll") for (int _i = 0; _i < 2; ++_i) \
        __builtin_amdgcn_global_load_lds((const unsigned*)((const char*)(gbase) + (voff)[_i]), (LAS unsigned*)(lds + (bufoff) + ldsw + _i * 8192), 16, 0, 0); } while (0)
#define PG8_LDA(dst, b, h) do { _Pragma("unroll") for (int m = 0; m < 4; ++m) _Pragma("unroll") for (int k = 0; k < 2; ++k) dst[m][k] = *(const LAS bf16x8*)(lds + PG8_SA(b, h) + aoff + m * 2048 + k * 1024); } while (0)
#define PG8_LDB(dst, b, h) do { _Pragma("unroll") for (int n = 0; n < 2; ++n) _Pragma("unroll") for (int k = 0; k < 2; ++k) dst[n][k] = *(const LAS bf16x8*)(lds + PG8_SB(b, h) + boff + n * 2048 + k * 1024); } while (0)
#define PG8_MMA(ai, bj, At, Bt) do { __builtin_amdgcn_s_setprio(1); _Pragma("unroll") for (int m = 0; m < 4; ++m) _Pragma("unroll") for (int n = 0; n < 2; ++n) _Pragma("unroll") for (int k = 0; k < 2; ++k) \
        acc[ai][bj][m][n] = __builtin_amdgcn_mfma_f32_16x16x32_bf16(Bt[n][k], At[m][k], acc[ai][bj][m][n], 0, 0, 0); __builtin_amdgcn_s_setprio(0); } while (0)
#define PG8_WAIT_V(n) asm volatile("s_waitcnt vmcnt(" #n ")" ::: "memory")
#define PG8_WAIT_L(n) asm volatile("s_waitcnt lgkmcnt(" #n ")" ::: "memory")
#define PG8_BAR __builtin_amdgcn_s_barrier()
#define PG8_SCHED __builtin_amdgcn_sched_barrier(0)
    Unit cur, nxt; int ui = 0;
    if (!S.next(0, cur)) return;
    constexpr int EPI_LDS = 131328;
#define PG8_PREF(u) do { if (Epi::PREF && E.pref_on()) __builtin_amdgcn_global_load_lds((const unsigned*)E.pref_ptr(u, tid), (LAS unsigned*)(lds + EPI_LDS + (ui & 1) * 2048 + wid * 256), 4, 0, 0); } while (0)
    PG8_PREF(cur);
    f32x4 acc[2][2][4][2];
#pragma unroll
    for (int a = 0; a < 2; ++a)
#pragma unroll
        for (int b = 0; b < 2; ++b)
#pragma unroll
            for (int m = 0; m < 4; ++m)
#pragma unroll
                for (int n = 0; n < 2; ++n) acc[a][b][m][n] = (f32x4){0.f, 0.f, 0.f, 0.f};
    bf16x8 At[4][2], B0[2][2], B1[2][2];
    const char* cA = (const char*)g.A + (size_t)cur.pm * tstepA + (size_t)cur.pn * g.apn; const char* cB = (const char*)g.Bt + (size_t)cur.pn * tstepB + ((HT && cur.half > 0) ? hstepB : 0);
    size_t hBc = (HT && cur.half >= 0) ? 0 : hstepB;
    PG8_STAGE(PG8_SB(0, 0), cB, voffB); PG8_STAGE(PG8_SB(0, 1), cB + hBc, voffB); PG8_STAGE(PG8_SA(0, 0), cA, voffA); PG8_STAGE(PG8_SA(0, 1), cA + hstepA, voffA);
    if (wr == 1) PG8_BAR;
    PG8_WAIT_V(2); PG8_BAR;
    PG8_STAGE(PG8_SB(1, 0), cB + kstep, voffB); PG8_STAGE(PG8_SA(1, 0), cA + kstep, voffA); PG8_STAGE(PG8_SB(1, 1), cB + hBc + kstep, voffB);
    PG8_WAIT_V(6); PG8_BAR;
#define PG8_KBODY(B1ON) \
        for (int t = 0, tk = 0; t < nt * Epi::KREP; t += 2) { \
            const bool last = (t == nt * Epi::KREP - 2); \
            const int tk2 = (tk + 2 >= nt) ? tk + 2 - nt : tk + 2; \
            const char* a1 = cA + (size_t)(tk + 1) * kstep; \
            const char* a2 = last ? nA : cA + (size_t)tk2 * kstep; const char* b2 = last ? nB : cB + (size_t)tk2 * kstep; const size_t hb2 = last ? nhB : hBc; tk = tk2; \
            const char* a3 = a2 + kstep; const char* b3 = b2 + kstep; \
            PG8_LDB(B0, 0, 0); if (B1ON) PG8_LDB(B1, 0, 1); PG8_SCHED; PG8_LDA(At, 0, 0); PG8_STAGE(PG8_SA(1, 1), a1 + hstepA, voffA); \
            PG8_WAIT_V(8); PG8_WAIT_L(0); PG8_BAR; PG8_MMA(0, 0, At, B0); if (B1ON) PG8_MMA(0, 1, At, B1); PG8_BAR; PG8_SCHED; \
            PG8_LDA(At, 0, 1); PG8_STAGE(PG8_SB(0, 0), b2, voffB); PG8_STAGE(PG8_SB(0, 1), b2 + hb2, voffB); PG8_STAGE(PG8_SA(0, 0), a2, voffA); \
            PG8_WAIT_V(8); PG8_WAIT_L(0); PG8_BAR; PG8_MMA(1, 0, At, B0); if (B1ON) PG8_MMA(1, 1, At, B1); PG8_BAR; PG8_SCHED; \
            PG8_LDB(B0, 1, 0); if (B1ON) PG8_LDB(B1, 1, 1); PG8_SCHED; PG8_LDA(At, 1, 0); PG8_STAGE(PG8_SA(0, 1), a2 + hstepA, voffA); \
            PG8_WAIT_V(8); PG8_WAIT_L(0); PG8_BAR; PG8_MMA(0, 0, At, B0); if (B1ON) PG8_MMA(0, 1, At, B1); PG8_BAR; PG8_SCHED; \
            PG8_LDA(At, 1, 1); PG8_STAGE(PG8_SB(1, 0), b3, voffB); PG8_STAGE(PG8_SB(1, 1), b3 + hb2, voffB); PG8_STAGE(PG8_SA(1, 0), a3, voffA); \
            PG8_WAIT_V(8); PG8_WAIT_L(0); PG8_BAR; PG8_MMA(1, 0, At, B0); if (B1ON) PG8_MMA(1, 1, At, B1); PG8_BAR; PG8_SCHED; \
        }
    for (;;) {
        const bool has_next = S.next(ui + 1, nxt);
        const char* nA = has_next ? (const char*)g.A + (size_t)nxt.pm * tstepA + (size_t)nxt.pn * g.apn : cA;
        const char* nB = has_next ? (const char*)g.Bt + (size_t)nxt.pn * tstepB + ((HT && nxt.half > 0) ? hstepB : 0) : cB;
        const size_t nhB = has_next ? ((HT && nxt.half >= 0) ? 0 : hstepB) : hBc;
        if (HT && cur.half >= 0) { PG8_KBODY(false) } else { PG8_KBODY(true) }
        if (wr == 0) PG8_BAR;
        E.run(acc, cur, wr, wc, fr, fq, (const LAS float*)(lds + EPI_LDS + (ui & 1) * 2048));
        if (!has_next) break;
#pragma unroll
        for (int a = 0; a < 2; ++a)
#pragma unroll
            for (int b = 0; b < 2; ++b)
#pragma unroll
                for (int m = 0; m < 4; ++m)
#pragma unroll
                    for (int n = 0; n < 2; ++n) acc[a][b][m][n] = (f32x4){0.f, 0.f, 0.f, 0.f};
        cur = nxt; cA = nA; cB = nB; hBc = nhB; ++ui;
        PG8_PREF(cur);
        if (wr == 1) PG8_BAR;
    }
    PG8_WAIT_V(0);
    PG8_BAR;
#undef PG8_KBODY
#undef PG8_PREF
#undef PG8_SA
#undef PG8_SB
#undef PG8_STAGE
#undef PG8_LDA
#undef PG8_LDB
#undef PG8_MMA
#undef PG8_WAIT_V
#undef PG8_WAIT_L
#undef PG8_BAR
#undef PG8_SCHED
}
}

namespace att {
constexpr int NW = 8, QBLK = 32, KVBLK = 64;
constexpr float SCALE = 0.10206207261596575f;
constexpr float THR = 8.f;
constexpr size_t SHM_V = 16384, SHM_K = 16384, SHM_ATTN = 2 * SHM_V + 2 * SHM_K + NW * 64 * 4;
#define KSWZ(row, colB) ((row) * 256 + ((colB) ^ (((row) & 7) << 4)))
#define SBAR() __builtin_amdgcn_sched_barrier(0)
__device__ __forceinline__ int crow(int r, int hi) { return (r & 3) + 8 * (r >> 2) + 4 * hi; }
__device__ __forceinline__ void partialSM(f32x16& p0, f32x16& p1, float& m_reg, float& mn, float& alpha) {
  constexpr float C = SCALE * 1.4426950408889634f;
  float pmax = p0[0];
#pragma unroll
  for (int r = 1; r < 16; ++r) pmax = fmaxf(pmax, p0[r]);
#pragma unroll
  for (int r = 0; r < 16; ++r) pmax = fmaxf(pmax, p1[r]);
  { auto rr = __builtin_amdgcn_permlane32_swap(__float_as_uint(pmax), __float_as_uint(pmax), false, false);
    pmax = fmaxf(__uint_as_float(rr[0]), __uint_as_float(rr[1])); }
  if (__builtin_expect(__all(pmax - m_reg <= THR / SCALE), 1)) { mn = m_reg; alpha = 1.f; }
  else { mn = fmaxf(m_reg, pmax); alpha = __builtin_amdgcn_exp2f((m_reg - mn) * C); m_reg = mn; }
  float mnC = -mn * C;
#pragma unroll
  for (int r = 0; r < 16; ++r) p0[r] = fmaf(p0[r], C, mnC);
#pragma unroll
  for (int r = 0; r < 16; ++r) p1[r] = fmaf(p1[r], C, mnC);
#pragma unroll
  for (int r = 0; r < 16; ++r) p0[r] = __builtin_amdgcn_exp2f(p0[r]);
}
__device__ __forceinline__ void finishSM(f32x16& p0, f32x16& p1, float alpha, float& l_reg, bf16x8& pa0, bf16x8& pa1, bf16x8& pa2, bf16x8& pa3) {
#pragma unroll
  for (int r = 0; r < 16; ++r) p1[r] = __builtin_amdgcn_exp2f(p1[r]);
  float ps = 0;
#pragma unroll
  for (int r = 0; r < 16; ++r) ps += p0[r];
#pragma unroll
  for (int r = 0; r < 16; ++r) ps += p1[r];
  { auto rr = __builtin_amdgcn_permlane32_swap(__float_as_uint(ps), __float_as_uint(ps), false, false);
    ps = __uint_as_float(rr[0]) + __uint_as_float(rr[1]); }
  l_reg = l_reg * alpha + ps;
#define PK4(P, BASE, OUT) do { unsigned a0 = cvt_pk_bf16(P[BASE + 0], P[BASE + 1]), a1 = cvt_pk_bf16(P[BASE + 2], P[BASE + 3]);   \
    unsigned b0 = cvt_pk_bf16(P[BASE + 4], P[BASE + 5]), b1 = cvt_pk_bf16(P[BASE + 6], P[BASE + 7]);                              \
    auto r0 = __builtin_amdgcn_permlane32_swap(a0, b0, false, false); auto r1 = __builtin_amdgcn_permlane32_swap(a1, b1, false, false); \
    u32x4 w = {r0[0], r1[0], r0[1], r1[1]}; OUT = *reinterpret_cast<bf16x8*>(&w); } while (0)
  PK4(p0, 0, pa0); PK4(p0, 8, pa1); PK4(p1, 0, pa2); PK4(p1, 8, pa3);
#undef PK4
}
__device__ __forceinline__ void qkt(f32x16& p0, f32x16& p1, const char* Ks, const bf16x8* qr, int r32, int hi) {
  p0 = f32x16{}; p1 = f32x16{};
#pragma unroll
  for (int d0 = 0; d0 < 6; ++d0) { int cb = (d0 * 16 + hi * 8) * 2;
    bf16x8 b0 = *reinterpret_cast<const bf16x8*>(Ks + KSWZ(r32, cb));
    bf16x8 b1 = *reinterpret_cast<const bf16x8*>(Ks + KSWZ(32 + r32, cb));
    p0 = __builtin_amdgcn_mfma_f32_32x32x16_bf16(b0, qr[d0], p0, 0, 0, 0);
    p1 = __builtin_amdgcn_mfma_f32_32x32x16_bf16(b1, qr[d0], p1, 0, 0, 0); }
}
__device__ __forceinline__ int v_st(int k, int c) { const int kk = (k & ~0xC) | ((k & 4) << 1) | ((k & 8) >> 1); return ((kk >> 3) * 4 + (c >> 5)) * 512 + ((kk & 7) * 32 + (c & 31)) * 2; }
__device__ __forceinline__ int v_rd_base(int lane) { return ((lane & 3) << 3) | (((lane >> 2) & 3) << 6) | (((lane >> 4) & 1) << 5) | (((lane >> 5) & 1) << 8); }
constexpr int v_rd_off(int d0, int ks, int half) { return d0 * 512 + ks * 4096 + half * 2048; }
template <int OFF> __device__ __forceinline__ s16x4 tr_read(int vb) {
  s16x4 r; asm volatile("ds_read_b64_tr_b16 %0, %1 offset:%2" : "=&v"(r) : "v"(vb), "i"(OFF) : "memory"); return r;
}
template <int D0> __device__ __forceinline__ void pv_one(f32x16& od, int vb, bf16x8 pa0, bf16x8 pa1, bf16x8 pa2, bf16x8 pa3) {
  const s16x4 l0 = tr_read<v_rd_off(D0, 0, 0)>(vb), h0 = tr_read<v_rd_off(D0, 0, 1)>(vb), l1 = tr_read<v_rd_off(D0, 1, 0)>(vb), h1 = tr_read<v_rd_off(D0, 1, 1)>(vb);
  const s16x4 l2 = tr_read<v_rd_off(D0, 2, 0)>(vb), h2 = tr_read<v_rd_off(D0, 2, 1)>(vb), l3 = tr_read<v_rd_off(D0, 3, 0)>(vb), h3 = tr_read<v_rd_off(D0, 3, 1)>(vb);
  asm volatile("s_waitcnt lgkmcnt(0)" ::: "memory"); SBAR();
#define PK(L, H) (bf16x8){L[0], L[1], L[2], L[3], H[0], H[1], H[2], H[3]}
  od = __builtin_amdgcn_mfma_f32_32x32x16_bf16(pa0, PK(l0, h0), od, 0, 0, 0);
  od = __builtin_amdgcn_mfma_f32_32x32x16_bf16(pa1, PK(l1, h1), od, 0, 0, 0);
  od = __builtin_amdgcn_mfma_f32_32x32x16_bf16(pa2, PK(l2, h2), od, 0, 0, 0);
  od = __builtin_amdgcn_mfma_f32_32x32x16_bf16(pa3, PK(l3, h3), od, 0, 0, 0);
#undef PK
}
__device__ __forceinline__ void pv_d0(f32x16* o, int vb, bf16x8 pa0, bf16x8 pa1, bf16x8 pa2, bf16x8 pa3) {
  pv_one<0>(o[0], vb, pa0, pa1, pa2, pa3); pv_one<1>(o[1], vb, pa0, pa1, pa2, pa3);
}
__device__ __forceinline__ void attn_unit(const bf16_t* __restrict__ Qb, const bf16_t* __restrict__ Kh, const bf16_t* __restrict__ Vh,
                                          bf16_t* __restrict__ Ob, int seq, char* lds) {
  int tid = threadIdx.x; asm volatile("" : "+v"(tid));
  const int wid = tid >> 6, lane = tid & 63, r32 = lane & 31, hi = lane >> 5;
  char* V_lds = lds; char* K_lds = lds + 2 * SHM_V;
  float* ws = (float*)(lds + 2 * SHM_V + 2 * SHM_K) + wid * 64; float* li_l = ws; float* al_l = ws + 32;
  float m_reg = -1e30f, l_reg = 0; f32x16 o[2] = {}; bf16x8 qr[6];
  const bf16_t* Qw = Qb + (long)(wid * QBLK + r32) * QLD + hi * 8;
#pragma unroll
  for (int d0 = 0; d0 < 6; ++d0) qr[d0] = *reinterpret_cast<const bf16x8*>(Qw + d0 * 16);
  const bool kld = wid < 6;
  const int ksr = tid / 12, ksc = (tid - ksr * 12) * 8;
  const int vsr = tid >> 3, vsc = (tid & 7) * 8, vst0 = v_st(vsr, vsc);
  const int vb0 = (int)(uintptr_t)V_lds + v_rd_base(lane);
  struct { bf16x8 vs0, ks0, ks1; } sr_[2];
#define SLOAD(i, k0) do { sr_[i].vs0 = *reinterpret_cast<const bf16x8*>(&Vh[(long)((k0) + vsr) * QLD + vsc]); \
    if (kld) { sr_[i].ks0 = *reinterpret_cast<const bf16x8*>(&Kh[(long)((k0) + ksr) * QLD + ksc]); sr_[i].ks1 = *reinterpret_cast<const bf16x8*>(&Kh[(long)((k0) + 32 + ksr) * QLD + ksc]); } } while (0)
#define SWRITE(b, i) do { *(bf16x8*)(V_lds + (b) * SHM_V + vst0) = sr_[i].vs0; \
    if (kld) { int kc = ksc * 2; *(bf16x8*)(K_lds + (b) * SHM_K + KSWZ(ksr, kc)) = sr_[i].ks0; *(bf16x8*)(K_lds + (b) * SHM_K + KSWZ(32 + ksr, kc)) = sr_[i].ks1; } } while (0)
#define SWAIT() asm volatile("s_waitcnt vmcnt(3)" ::: "memory")
#define RESC(a) do { if (__any((a) < 1.f)) { if (hi == 0) al_l[r32] = (a); asm volatile("s_waitcnt lgkmcnt(0)" ::: "memory"); \
    _Pragma("unroll") for (int d = 0; d < 2; ++d) _Pragma("unroll") for (int r = 0; r < 16; ++r) o[d][r] *= al_l[crow(r, hi)]; } } while (0)
  f32x16 pA0, pA1, pB0, pB1; float mnA, mnB, alA, alB; bf16x8 pa0, pa1, pa2, pa3; const int NT = seq / KVBLK;
  constexpr int SE = 0, SO = 1;
  SLOAD(SE, 0); asm volatile("s_waitcnt vmcnt(0)" ::: "memory"); SWRITE(0, SE); __syncthreads();
  qkt(pA0, pA1, K_lds, qr, r32, hi); partialSM(pA0, pA1, m_reg, mnA, alA);
  SLOAD(SO, KVBLK); if (2 < NT) SLOAD(SE, 2 * KVBLK);
  SWAIT(); SWRITE(1, SO); __syncthreads();
  for (int j = 1; j + 1 < NT; j += 2) {
    SBAR(); qkt(pB0, pB1, K_lds + SHM_K, qr, r32, hi);
    finishSM(pA0, pA1, alA, l_reg, pa0, pa1, pa2, pa3); SBAR();
    SLOAD(SO, (j + 2) * KVBLK); SBAR();
    pv_d0(o, vb0, pa0, pa1, pa2, pa3); partialSM(pB0, pB1, m_reg, mnB, alB);
    __syncthreads(); SWAIT(); SWRITE(0, SE);
    RESC(alB); __syncthreads();
    SBAR(); qkt(pA0, pA1, K_lds, qr, r32, hi);
    finishSM(pB0, pB1, alB, l_reg, pa0, pa1, pa2, pa3); SBAR();
    if (j + 3 < NT) SLOAD(SE, (j + 3) * KVBLK); SBAR();
    pv_d0(o, vb0 + (int)SHM_V, pa0, pa1, pa2, pa3); partialSM(pA0, pA1, m_reg, mnA, alA);
    __syncthreads(); SWAIT(); SWRITE(1, SO);
    RESC(alA); __syncthreads();
  }
  SBAR(); qkt(pB0, pB1, K_lds + SHM_K, qr, r32, hi);
  finishSM(pA0, pA1, alA, l_reg, pa0, pa1, pa2, pa3); SBAR();
  pv_d0(o, vb0, pa0, pa1, pa2, pa3); partialSM(pB0, pB1, m_reg, mnB, alB);
  __syncthreads(); RESC(alB);
  finishSM(pB0, pB1, alB, l_reg, pa0, pa1, pa2, pa3); SBAR();
  pv_d0(o, vb0 + (int)SHM_V, pa0, pa1, pa2, pa3);
  if (hi == 0) li_l[r32] = l_reg; asm volatile("s_waitcnt lgkmcnt(0)" ::: "memory");
  bf16_t* Ow = Ob + (long)(wid * QBLK) * 1024;
#pragma unroll
  for (int r = 0; r < 16; ++r) { const int orow = crow(r, hi); const float rl = __builtin_amdgcn_rcpf(li_l[orow]);
#pragma unroll
    for (int d0 = 0; d0 < 2; ++d0) Ow[(long)orow * 1024 + d0 * 32 + r32] = (bf16_t)(cvt_pk_bf16(o[d0][r] * rl, 0.f) & 0xffffu); }
#undef SLOAD
#undef SWRITE
#undef SWAIT
#undef RESC
}
}


#define XB_TMO      128
#define XB_XCNT(j)  (256  + 64 * (j))
#define XB_XSUB(j)  (1280 + 64 * (j))
#define XB_XGEN(j)  (2304 + 64 * (j))
#define XB_TOP      3328
#define XB_TOPGEN   3392
#define XCD_BAR_WORDS 3456
#define XB_SPIN_CAP (1u << 20)
__device__ __forceinline__ unsigned xb_ld(unsigned* p)              { return __hip_atomic_load(p, __ATOMIC_RELAXED, __HIP_MEMORY_SCOPE_AGENT); }
__device__ __forceinline__ unsigned xb_add(unsigned* p, unsigned v) { return __hip_atomic_fetch_add(p, v, __ATOMIC_RELAXED, __HIP_MEMORY_SCOPE_AGENT); }
__device__ __forceinline__ unsigned xb_xcc_id() { return (unsigned)__builtin_amdgcn_s_getreg((3 << 11) | 20) & 0xFu; }
#define XB_SPIN(cond, bar) do { unsigned _sp = 0; while (cond) { __builtin_amdgcn_s_sleep(1); \
    if ((++_sp & 255u) == 0u) { if (xb_ld(&(bar)[XB_TMO])) break; if (_sp > XB_SPIN_CAP) { atomicAdd(&(bar)[XB_TMO], 1u); break; } } } } while (0)
struct XcdBarrier { unsigned* bar; unsigned x; volatile LAS unsigned* st; };
__device__ __forceinline__ XcdBarrier xcd_barrier_post(unsigned* bar, volatile LAS unsigned* st) {
    XcdBarrier b; b.bar = bar; b.x = xb_xcc_id(); b.st = st;
    if (threadIdx.x == 0) (void)xb_add(&bar[XB_XCNT(b.x)], 1u);
    return b;
}
__device__ __forceinline__ void xcd_barrier_complete(unsigned* bar, unsigned x, unsigned& nloc, unsigned& nx) {
    const unsigned G = gridDim.x * gridDim.y * gridDim.z;
    unsigned sum, cnt, mine, sp = 0u;
    for (;;) {
        sum = 0u; cnt = 0u; mine = 0u;
#pragma unroll
        for (unsigned j = 0; j < 16; ++j) { const unsigned c = xb_ld(&bar[XB_XCNT(j)]); sum += c; cnt += (c > 0u) ? 1u : 0u; mine = (j == x) ? c : mine; }
        if (sum == G) break;
        __builtin_amdgcn_s_sleep(1);
        if ((++sp & 255u) == 0u) { if (xb_ld(&bar[XB_TMO])) break; if (sp > XB_SPIN_CAP) { atomicAdd(&bar[XB_TMO], 1u); break; } }
    }
    nloc = mine > 0u ? mine : 1u; nx = cnt > 0u ? cnt : 1u;
}
__device__ __forceinline__ void xcd_barrier(const XcdBarrier& b) {
    asm volatile("s_waitcnt vmcnt(0)" ::: "memory");
    __syncthreads();
    if (threadIdx.x == 0) {
        unsigned* bar = b.bar;
        __builtin_amdgcn_s_waitcnt(0);
        unsigned nloc = b.st[0], nx = b.st[1];
        if (nloc == 0u) { xcd_barrier_complete(bar, b.x, nloc, nx); b.st[0] = nloc; b.st[1] = nx; }
        const unsigned old = xb_add(&bar[XB_XSUB(b.x)], 1u);
        const unsigned gen = old / nloc;
        if (old + 1u == (gen + 1u) * nloc) {
            __builtin_amdgcn_fence(__ATOMIC_RELEASE, "agent");
            asm volatile("s_waitcnt vmcnt(0)" ::: "memory");
            const unsigned og = xb_add(&bar[XB_TOP], 1u);
            const unsigned tg = og / nx;
            if (og + 1u == (tg + 1u) * nx) xb_add(&bar[XB_TOPGEN], 1u);
            else XB_SPIN(xb_ld(&bar[XB_TOPGEN]) == tg, bar);
            __builtin_amdgcn_fence(__ATOMIC_ACQUIRE, "agent");
            xb_add(&bar[XB_XGEN(b.x)], 1u);
            asm volatile("s_waitcnt vmcnt(0)" ::: "memory");
        } else {
            XB_SPIN(xb_ld(&bar[XB_XGEN(b.x)]) == gen, bar);
            __builtin_amdgcn_fence(__ATOMIC_ACQUIRE, "agent");
            asm volatile("s_waitcnt vmcnt(0)" ::: "memory");
        }
    }
    __syncthreads();
}

constexpr int LDS_BYTES = 139264;
struct Args { const float* in[25]; float* out; unsigned char* ws; int ph_lo, ph_hi; };

__device__ __forceinline__ void tr_item(const float* W, int ldw, bf16_t* dst, int ldd, LAS float* scr, int lane) {
    float tv[32];
#pragma unroll
    for (int i = 0; i < 32; ++i) tv[i] = W[(size_t)(2 * i + (lane >> 5)) * ldw + (lane & 31)];
#pragma unroll
    for (int i = 0; i < 32; ++i) scr[(2 * i + (lane >> 5)) * 33 + (lane & 31)] = tv[i];
    asm volatile("s_waitcnt lgkmcnt(0)" ::: "memory");
    const int c = lane & 7;
#pragma unroll
    for (int j = 0; j < 4; ++j) { const int n = (lane >> 3) + 8 * j; const LAS float* s = scr + (8 * c) * 33 + n;
        u32x4 o; o.x = cvt_pk_bf16(s[0 * 33], s[1 * 33]); o.y = cvt_pk_bf16(s[2 * 33], s[3 * 33]); o.z = cvt_pk_bf16(s[4 * 33], s[5 * 33]); o.w = cvt_pk_bf16(s[6 * 33], s[7 * 33]);
        *(u32x4*)(dst + (size_t)n * ldd + 8 * c) = o; }
    asm volatile("s_waitcnt lgkmcnt(0)" ::: "memory");
}


struct P2Row { f32x4 q[3], k[3]; u32x2 v[2]; int kind, t, e; };
__device__ __forceinline__ f32x4 ld_bf4(const bf16_t* p) { const u32x2 w = *(const u32x2*)p; return (f32x4){bflo(w.x), bfhi(w.x), bflo(w.y), bfhi(w.y)}; }
__device__ __forceinline__ void p2_load(P2Row& r, int e, int j, int hh, int s, const bf16_t* QKV, const float* KROPE, const float* cache_kr) {
    const float* krp; r.e = e; r.t = 0;
    if (e < NCTX) { r.kind = 0; krp = KROPE + (size_t)e * 32; }
    else { const int b = (e - NCTX) / KVB, tt = (e - NCTX) - b * KVB;
        if (tt < LLAT) { r.kind = 1; r.t = tt; krp = KROPE + (size_t)(NCTX + b * LLAT + tt) * 32; }
        else { r.kind = 2; krp = cache_kr + (((size_t)b * 2 + j) * 512 + (tt - LLAT)) * 32; } }
    const bf16_t* raw = QKV + (size_t)e * QLD;
#pragma unroll
    for (int jj = 0; jj < 3; ++jj) r.q[jj] = ld_bf4(raw + hh * 96 + 4 * (s + 8 * jj));
#pragma unroll
    for (int jj = 0; jj < 2; ++jj) { r.k[jj] = ld_bf4(raw + 768 + hh * 128 + 4 * (s + 8 * jj)); r.v[jj] = *(const u32x2*)(raw + 768 + hh * 128 + 64 + 4 * (s + 8 * jj)); }
    r.k[2] = *(const f32x4*)(krp + 4 * s);
}
__device__ __forceinline__ void p2_compute(P2Row& r, int s, const float* qn, const float* kn, const float* ROPE) {
    float sq = 0.f, sk = 0.f;
#pragma unroll
    for (int jj = 0; jj < 3; ++jj) { sq += (r.q[jj][0] * r.q[jj][0] + r.q[jj][1] * r.q[jj][1]) + (r.q[jj][2] * r.q[jj][2] + r.q[jj][3] * r.q[jj][3]);
                                     sk += (r.k[jj][0] * r.k[jj][0] + r.k[jj][1] * r.k[jj][1]) + (r.k[jj][2] * r.k[jj][2] + r.k[jj][3] * r.k[jj][3]); }
    sq += __shfl_xor(sq, 1); sq += __shfl_xor(sq, 2); sq += __shfl_xor(sq, 4);
    sk += __shfl_xor(sk, 1); sk += __shfl_xor(sk, 2); sk += __shfl_xor(sk, 4);
    const float rq = 1.0f / sqrtf(sq * (1.0f / 96.0f) + EPS), rk = 1.0f / sqrtf(sk * (1.0f / 96.0f) + EPS);
#pragma unroll
    for (int jj = 0; jj < 3; ++jj) { r.q[jj] = r.q[jj] * rq * *(const f32x4*)(qn + 4 * (s + 8 * jj)); r.k[jj] = r.k[jj] * rk * *(const f32x4*)(kn + 4 * (s + 8 * jj)); }
    f32x4 qp, kp;
#pragma unroll
    for (int c = 0; c < 4; ++c) { qp[c] = __shfl_xor(r.q[2][c], 2); kp[c] = __shfl_xor(r.k[2][c], 2); }
    if (r.kind == 1) {
        const int a = s >> 2, fi0 = (s & 1) * 4; const bool second = (s & 2) != 0;
        const f32x4 cs = *(const f32x4*)(ROPE + (size_t)r.t * 16 + a * 8 + fi0), sn = *(const f32x4*)(ROPE + 65536 + (size_t)r.t * 16 + a * 8 + fi0);
        if (!second) { r.q[2] = r.q[2] * cs - qp * sn; r.k[2] = r.k[2] * cs - kp * sn; }
        else { r.q[2] = qp * sn + r.q[2] * cs; r.k[2] = kp * sn + r.k[2] * cs; }
    }
}
__device__ __forceinline__ void p2_store(const P2Row& r, int hh, int s, bf16_t* QKV) {
    bf16_t* orow = QKV + (size_t)r.e * QLD;
#pragma unroll
    for (int jj = 0; jj < 3; ++jj) {
        if (r.kind != 2) { u32x2 w; w.x = cvt_pk_bf16(r.q[jj][0], r.q[jj][1]); w.y = cvt_pk_bf16(r.q[jj][2], r.q[jj][3]); *(u32x2*)(orow + hh * 96 + 4 * (s + 8 * jj)) = w; }
        u32x2 w2; w2.x = cvt_pk_bf16(r.k[jj][0], r.k[jj][1]); w2.y = cvt_pk_bf16(r.k[jj][2], r.k[jj][3]); *(u32x2*)(orow + 768 + hh * 96 + 4 * (s + 8 * jj)) = w2; }
#pragma unroll
    for (int jj = 0; jj < 2; ++jj) *(u32x2*)(orow + 1536 + hh * 64 + 4 * (s + 8 * jj)) = r.v[jj];
}
struct P1Row { f32x4 q4, k4, r4; };
__device__ __forceinline__ void p1_load(P1Row& p, const float* pr, int lane) {
    p.q4 = *(const f32x4*)(pr + 4 * lane);
    p.k4 = (f32x4){0.f, 0.f, 0.f, 0.f}; if (lane < 32) p.k4 = *(const f32x4*)(pr + 256 + 4 * lane);
    p.r4 = (f32x4){0.f, 0.f, 0.f, 0.f}; if (lane < 8) p.r4 = *(const f32x4*)(pr + 384 + 4 * lane);
}
__device__ __forceinline__ void p1_finish(const P1Row& p, int r, int j, int lane, const float* qan, const float* kvan, bf16_t* QKVLAT, float* KROPE, float* OUT_CKV, float* OUT_KR) {
    const int e = r < NCTX ? r : NCTX + ((r - NCTX) >> 12) * KVB + ((r - NCTX) & 4095);
    const float ssq = wave_sum((p.q4[0] * p.q4[0] + p.q4[1] * p.q4[1]) + (p.q4[2] * p.q4[2] + p.q4[3] * p.q4[3]));
    const float ssk = wave_sum((p.k4[0] * p.k4[0] + p.k4[1] * p.k4[1]) + (p.k4[2] * p.k4[2] + p.k4[3] * p.k4[3]));
    const float rq = 1.0f / sqrtf(ssq * (1.0f / 256.0f) + EPS), rk = 1.0f / sqrtf(ssk * (1.0f / 128.0f) + EPS);
    const f32x4 qo = p.q4 * rq * *(const f32x4*)(qan + 4 * lane);
    u32x2 w; w.x = cvt_pk_bf16(qo[0], qo[1]); w.y = cvt_pk_bf16(qo[2], qo[3]); *(u32x2*)(QKVLAT + (size_t)e * 384 + 4 * lane) = w;
    if (lane < 32) { const f32x4 ko = p.k4 * rk * *(const f32x4*)(kvan + 4 * lane); u32x2 w2; w2.x = cvt_pk_bf16(ko[0], ko[1]); w2.y = cvt_pk_bf16(ko[2], ko[3]);
        *(u32x2*)(QKVLAT + (size_t)e * 384 + 256 + 4 * lane) = w2;
        if (r < NCTX) *(f32x4*)(OUT_CKV + (((size_t)(r >> 8) * 2 + j) * 256 + (r & 255)) * 128 + 4 * lane) = ko; }
    if (lane < 8) { *(f32x4*)(KROPE + (size_t)r * 32 + 4 * lane) = p.r4;
        if (r < NCTX) *(f32x4*)(OUT_KR + (((size_t)(r >> 8) * 2 + j) * 256 + (r & 255)) * 32 + 4 * lane) = p.r4; }
}

#define DERIVE_PTRS \
    unsigned char* ws = args.ws; \
    float* X = args.out; \
    float* OUT_CKV = args.out + (size_t)MTOK * 1024; float* OUT_KR = OUT_CKV + (size_t)32 * 2 * 256 * 128; \
    bf16_t* W13 = (bf16_t*)(ws + OFF_W13); bf16_t* W2 = (bf16_t*)(ws + OFF_W2); bf16_t* WIN = (bf16_t*)(ws + OFF_WIN); bf16_t* WQKV = (bf16_t*)(ws + OFF_WQKV); \
    bf16_t* WOUT = (bf16_t*)(ws + OFF_WOUT); bf16_t* POOLT = (bf16_t*)(ws + OFF_POOLT); bf16_t* WSB = (bf16_t*)(ws + OFF_WS); \
    float* MOD = (float*)(ws + OFF_MOD); float* ROPE = (float*)(ws + OFF_ROPE); \
    bf16_t* H = (bf16_t*)(ws + OFF_H); bf16_t* MIX = H; \
    unsigned char* R = ws + OFF_R; \
    bf16_t* U = (bf16_t*)(R + R_U); bf16_t* PB = (bf16_t*)R; bf16_t* H2 = (bf16_t*)R; \
    float* RSS = (float*)(ws + OFF_RSS); float* B13 = (float*)(ws + OFF_B13); float* BIN = (float*)(ws + OFF_BIN); \
    bf16_t* QKVLAT = (bf16_t*)(R + R_QKVLAT); float* KROPE = (float*)(R + R_KROPE); float* PROJ = (float*)(R + R_PROJ); \
    bf16_t* GM = (bf16_t*)(R + R_GM); float* QKVRAW = (float*)(R + R_QKVRAW); bf16_t* QKV = (bf16_t*)(R + R_QKVRAW);

__global__ void __launch_bounds__(512, 2) fwd_mega(Args args) {
    extern __shared__ __attribute__((aligned(16))) unsigned char lds[];
    cg::grid_group grid = cg::this_grid();
    int tid = threadIdx.x, lane = tid & 63, wave = __builtin_amdgcn_readfirstlane(tid >> 6);
    const int G = gridDim.x, bid = blockIdx.x;
    int gw = bid * 8 + wave; const int NGW = G * 8;
    long gt = (long)bid * 512 + tid; const long NGT = (long)G * 512;
    const int lo = args.ph_lo, hi = args.ph_hi;
    int pid = 0;
    unsigned* BARW = (unsigned*)(args.ws + OFF_CTL);
    volatile LAS unsigned* MISC = (volatile LAS unsigned*)((LAS unsigned char*)lds + 131072);
    if (tid < 16) MISC[tid] = 0u;
    if (bid == 0) for (int i = tid; i < XCD_BAR_WORDS; i += 512) BARW[i] = 0u;
    __syncthreads();
    XcdBarrier xbar; xbar.bar = BARW; xbar.x = 0; xbar.st = MISC;

    for (int rep0 = 0; rep0 < ((DUPMASK & 1) ? 2 : 1); ++rep0)
    if (EN_PRO && pid >= lo && pid < hi) {
        DERIVE_PTRS
        if (bid < 288) {
            LAS float* S = (LAS float*)lds; LAS float* P = (LAS float*)(lds + 36864);
            for (int idx = tid; idx < 9216; idx += 512) { const int cv = idx >> 10, k = idx & 1023; const float x = cv == 0 ? args.in[5][k] : args.in[4][(cv - 1) * 1024 + k]; S[idx] = x / (1.0f + expf(-x)); }
            __syncthreads();
            for (int item = bid; item < 288; item += G) {
                const int l = item / 72, cb = item % 72, j = tid & 127, s = tid >> 7;
                float acc[9];
#pragma unroll
                for (int cv = 0; cv < 9; ++cv) acc[cv] = 0.f;
                const float* wp = args.in[6] + ((size_t)l * 1024 + s * 256) * NMOD + cb * 128 + j;
                for (int k = 0; k < 256; k += 16) {
                    float wv[16];
#pragma unroll
                    for (int i = 0; i < 16; ++i) wv[i] = wp[(size_t)(k + i) * NMOD];
#pragma unroll
                    for (int cv = 0; cv < 9; ++cv) { const LAS float* sp = S + cv * 1024 + s * 256 + k;
#pragma unroll
                        for (int i = 0; i < 16; ++i) acc[cv] += sp[i] * wv[i]; }
                }
#pragma unroll
                for (int cv = 0; cv < 9; ++cv) P[(s * 9 + cv) * 128 + j] = acc[cv];
                __syncthreads();
                for (int idx = tid; idx < 1152; idx += 512) { const int cv = idx >> 7, jj = idx & 127;
                    const float v = P[(0 * 9 + cv) * 128 + jj] + P[(1 * 9 + cv) * 128 + jj] + P[(2 * 9 + cv) * 128 + jj] + P[(3 * 9 + cv) * 128 + jj] + args.in[7][l * NMOD + cb * 128 + jj];
                    MOD[((size_t)l * 9 + cv) * NMOD + cb * 128 + jj] = v; }
                __syncthreads();
            }
        }
        __syncthreads();
        {
            LAS float* scr = (LAS float*)(lds + 57344 + wave * 8448);
            for (int it0 = gw; it0 < 36832; it0 += NGW) {
                int it = it0; const float* src; int ldw, ldd; bf16_t* dst;
                if (it < 33792) { const int ls = it / 4224, r = it % 4224, which = r / 1408, q = r % 1408;
                    if (which < 2) { const int kb = q / 88, nb = q % 88, k0 = kb * 64, n0 = nb * 32; src = args.in[which ? 10 : 9] + (size_t)ls * 1024 * FF + (size_t)k0 * FF + n0; ldw = FF;
                        const int drow = (n0 >> 7) * 256 + (n0 & 127) + which * 128; dst = W13 + (size_t)ls * 5632 * 1024 + (size_t)drow * 1024 + k0; ldd = 1024; }
                    else { const int kb = q / 32, nb = q % 32, k0 = kb * 64, n0 = nb * 32; src = args.in[11] + (size_t)ls * FF * 1024 + (size_t)k0 * 1024 + n0; ldw = 1024;
                        dst = W2 + (size_t)ls * 1024 * FF + (size_t)n0 * FF + k0; ldd = FF; } }
                else { it -= 33792;
                if (it < 1440) { const int j = it / 720, q = it % 720, kb = q / 45, nb = q % 45, k0 = kb * 64, n0 = nb * 32; src = args.in[12] + (size_t)j * 1024 * 1440 + (size_t)k0 * 1440 + n0; ldw = 1440;
                    const int drow = n0 < 416 ? n0 : n0 + 96; dst = WIN + (size_t)j * 1536 * 1024 + (size_t)drow * 1024 + k0; ldd = 1024; }
                else { it -= 1440;
                if (it < 192) { const int j = it / 96, q = it % 96, kb = q / 24, nb = q % 24, k0 = kb * 64, n0 = nb * 32; src = args.in[15] + (size_t)j * 256 * 768 + (size_t)k0 * 768 + n0; ldw = 768;
                    dst = WQKV + (size_t)j * 1792 * 384 + (size_t)n0 * 384 + k0; ldd = 384; }
                else { it -= 192;
                if (it < 128) { const int j = it / 64, q = it % 64, kb = q / 32, nb = q % 32, k0 = kb * 64, n0 = nb * 32; src = args.in[16] + (size_t)j * 128 * 1024 + (size_t)k0 * 1024 + n0; ldw = 1024;
                    dst = WQKV + (size_t)j * 1792 * 384 + (size_t)(768 + n0) * 384 + 256 + k0; ldd = 384; }
                else { it -= 128;
                if (it < 1024) { const int j = it / 512, q = it % 512, kb = q / 32, nb = q % 32, k0 = kb * 64, n0 = nb * 32; src = args.in[22] + (size_t)j * 1024 * 1024 + (size_t)k0 * 1024 + n0; ldw = 1024;
                    dst = WOUT + (size_t)j * 1024 * 1024 + (size_t)n0 * 1024 + k0; ldd = 1024; }
                else { it -= 1024;
                    const int jg = it / 32, q = it % 32, kb = q / 8, nb = q % 8, k0 = kb * 64, n0 = nb * 32; src = args.in[23] + (size_t)jg * 65536 + (size_t)k0 * 256 + n0; ldw = 256;
                    dst = POOLT + (size_t)jg * 65536 + (size_t)n0 * 256 + k0; ldd = 256; } } } } }
                tr_item(src, ldw, dst, ldd, scr, lane);
            }
        }
        {
            const u32x4 z = {0u, 0u, 0u, 0u};
            for (long i = gt; i < 2 * 12288; i += NGT) { const int j = (int)(i / 12288); const long q = i % 12288; *(u32x4*)(WIN + (size_t)j * 1536 * 1024 + (size_t)416 * 1024 + q * 8) = z; }
            for (long i = gt; i < 2 * 45056; i += NGT) { const int j = (int)(i / 45056); const long q = i % 45056; bf16_t* base = WQKV + (size_t)j * 1792 * 384;
                if (q < 12288) { const int row = (int)(q >> 4), c = (int)(q & 15); *(u32x4*)(base + (size_t)row * 384 + 256 + c * 8) = z; }
                else { const long q2 = q - 12288; const int row = 768 + (int)(q2 >> 5), c = (int)(q2 & 31); *(u32x4*)(base + (size_t)row * 384 + c * 8) = z; } }
        }
        for (long i = gt; i < 131072 / 4; i += NGT) { const f32x4 v = *(const f32x4*)(args.in[20] + i * 4); u32x2 w; w.x = cvt_pk_bf16(v[0], v[1]); w.y = cvt_pk_bf16(v[2], v[3]); *(u32x2*)(WSB + i * 4) = w; }
        for (long i = gt; i < 65536; i += NGT) { const int t = (int)(i >> 4), ai = (int)(i & 15), a = ai >> 3, fi = ai & 7;
            const float inv = powf(10000.0f, -(float)(2 * fi) / 16.0f); const float pos = (float)(a == 0 ? (t >> 6) : (t & 63)); const float ang = pos * inv;
            ROPE[i] = cosf(ang); ROPE[65536 + i] = sinf(ang); }
        { const f32x4 z4 = {0.f, 0.f, 0.f, 0.f}; for (long i = gt; i < (long)12 * MTOK / 4; i += NGT) *(f32x4*)(RSS + i * 4) = z4; }
    }
    grid.sync();
    xbar = xcd_barrier_post(BARW, MISC);
    ++pid;
    for (int rep1 = 0; rep1 < ((DUPMASK & 2) ? 2 : 1); ++rep1)
    if (pid >= lo && pid < hi) {
        DERIVE_PTRS
        for (int ck = gw; ck < 8 * 176 + 2 * 48; ck += NGW) {
            const bf16_t* __restrict__ wbase; const float* shp; float* __restrict__ outp; int cvs;
            if (ck < 8 * 176) { const int ls = ck / 176, n0 = (ck - ls * 176) * 32, l = ls >> 1, sub = ls & 1; wbase = W13 + ((size_t)ls * 5632 + n0) * 1024;
                shp = MOD + (size_t)l * 9 * NMOD + (sub ? 6 : 0) * 1024; outp = B13 + (size_t)ls * 9 * 5632 + n0; cvs = 5632; }
            else { const int q = ck - 8 * 176, jj = q / 48, n0 = (q - jj * 48) * 32; wbase = WIN + ((size_t)jj * 1536 + n0) * 1024;
                shp = MOD + (size_t)(2 * jj) * 9 * NMOD + 3 * 1024; outp = BIN + (size_t)jj * 9 * 1536 + n0; cvs = 1536; }
            f32x4 sh[9][4];
#pragma unroll
            for (int cv = 0; cv < 9; ++cv) { const float* sp = shp + (size_t)cv * NMOD;
                sh[cv][0] = *(const f32x4*)(sp + lane * 8); sh[cv][1] = *(const f32x4*)(sp + lane * 8 + 4); sh[cv][2] = *(const f32x4*)(sp + 512 + lane * 8); sh[cv][3] = *(const f32x4*)(sp + 512 + lane * 8 + 4); }
#pragma unroll 2
            for (int r = 0; r < 32; ++r) {
                const u32x4 w0 = *(const u32x4*)(wbase + (size_t)r * 1024 + lane * 8), w1 = *(const u32x4*)(wbase + (size_t)r * 1024 + 512 + lane * 8);
                const f32x4 wa = {bflo(w0[0]), bfhi(w0[0]), bflo(w0[1]), bfhi(w0[1])}, wb = {bflo(w0[2]), bfhi(w0[2]), bflo(w0[3]), bfhi(w0[3])};
                const f32x4 wc2 = {bflo(w1[0]), bfhi(w1[0]), bflo(w1[1]), bfhi(w1[1])}, wd = {bflo(w1[2]), bfhi(w1[2]), bflo(w1[3]), bfhi(w1[3])};
                float res = 0.f;
#pragma unroll
                for (int cv = 0; cv < 9; ++cv) { const f32x4 p = sh[cv][0] * wa + sh[cv][1] * wb + sh[cv][2] * wc2 + sh[cv][3] * wd;
                    float a2 = (p[0] + p[1]) + (p[2] + p[3]); a2 = wave_sum(a2); if (lane == cv) res = a2; }
                if (lane < 9) outp[(size_t)lane * cvs + r] = res;
            }
        }
        for (int rb = gw; rb < MTOK; rb += 2 * NGW) {
            f32x4 v[2][4]; float ss[2]; int rr[2];
#pragma unroll
            for (int u2 = 0; u2 < 2; ++u2) { const int r = (rb + u2 * NGW < MTOK) ? rb + u2 * NGW : rb; rr[u2] = r;
                const float* xr = r < NCTX ? args.in[0] + (size_t)r * 1024 : args.in[1] + (size_t)(r - NCTX) * 1024; ss[u2] = 0.f;
#pragma unroll
                for (int q = 0; q < 4; ++q) { v[u2][q] = *(const f32x4*)(xr + 4 * lane + 256 * q); ss[u2] += (v[u2][q][0] * v[u2][q][0] + v[u2][q][1] * v[u2][q][1]) + (v[u2][q][2] * v[u2][q][2] + v[u2][q][3] * v[u2][q][3]); } }
#pragma unroll
            for (int u2 = 0; u2 < 2; ++u2) { if (u2 == 1 && rb + NGW >= MTOK) break; const int r = rr[u2]; const int cv = cv_of_row(r);
                const float* scp = MOD + (size_t)cv * NMOD + 1024; const float* gptr = args.in[8];
                const float st = wave_sum(ss[u2]); if (lane == 0) RSS[r] = st;
#pragma unroll
                for (int q = 0; q < 4; ++q) { const int c = 4 * lane + 256 * q; const f32x4 g4 = *(const f32x4*)(gptr + c), sc = *(const f32x4*)(scp + c);
                    *(f32x4*)(X + (size_t)r * 1024 + c) = v[u2][q];
                    const f32x4 hh = v[u2][q] * g4 * (sc + 1.0f); u32x2 w; w.x = cvt_pk_bf16(hh[0], hh[1]); w.y = cvt_pk_bf16(hh[2], hh[3]);
                    *(u32x2*)(H + (size_t)r * 1024 + c) = w; } }
        }
        if (pid + 1 < hi) xcd_barrier(xbar);
    }
    ++pid;

    for (int layer = 0; layer < 4; ++layer) {
        const int j = layer >> 1;
        const unsigned long long prog = (layer & 1) ? 0xDCFE32ull : 0xDCA9876532ull;
        const int nsteps = (layer & 1) ? 6 : 10;
        for (int step = 0; step < nsteps; ++step, ++pid) {
            if (!(pid >= lo && pid < hi)) continue;
            const int op = (int)((prog >> (4 * step)) & 15ull);
            const int reps = ((DUPMASK >> op) & 1) ? 2 : 1;
            for (int rep = 0; rep < reps; ++rep) {
            DERIVE_PTRS
            int bid = blockIdx.x; asm volatile("" : "+s"(bid)); int G = gridDim.x; asm volatile("" : "+s"(G));
            const int NGW = G * 8; const long NGT = (long)G * 512;
            const float* MODL = MOD + (size_t)layer * 9 * NMOD;
            tid = threadIdx.x; asm volatile("" : "+v"(tid)); lane = tid & 63; wave = __builtin_amdgcn_readfirstlane(tid >> 6); gw = bid * 8 + wave; gt = (long)bid * 512 + tid;
            if (EN_G1 && (op == 2 || op == 12)) {
                const int sub = op == 2 ? 0 : 1;
                const bf16_t* Ain = (sub == 1 && !(layer & 1)) ? H2 : H;
                pg8::Gemm g{Ain, W13 + (size_t)(layer * 2 + sub) * 5632 * 1024, MTOK, 5632, 1024, 1024, 1024, 0};
                pg8::StaticOrder S; S.init(MTOK, 5632, G, bid);
                pg8::EpiSwiglu E{U, RSS + (size_t)(layer * 3 + (sub ? 2 : 0)) * MTOK, B13 + (size_t)(layer * 2 + sub) * 9 * 5632};
                pg8::gemm_phase<pg8::EpiSwiglu>((LAS unsigned char*)lds, g, S, E);
            } else if (EN_GRES && (op == 3 || op == 13 || op == 10 || op == 15)) {
                const bf16_t* gA; const bf16_t* gB; int gK, glda, gldb, gapn; const float* egate; const float* escale; float ecoef;
                if (op == 3 || op == 13) { const int sub = op == 3 ? 0 : 1; gA = U; gB = W2 + (size_t)(layer * 2 + sub) * 1024 * FF; gK = FF; glda = FF; gldb = FF; gapn = 0;
                    egate = MODL + (sub ? 8 : 2) * 1024; escale = nullptr; ecoef = 0.5f; }
                else if (op == 10) { gA = MIX; gB = WOUT + (size_t)j * 1024 * 1024; gK = 1024; glda = 1024; gldb = 1024; gapn = 0; egate = MODL + 5 * 1024; escale = nullptr; ecoef = 1.0f; }
                else { gA = PB; gB = POOLT + (size_t)j * 1024 * 256; gK = 256; glda = 1024; gldb = 256; gapn = 512; egate = MODL + 5 * 1024; escale = args.in[24] + (size_t)j * 1024; ecoef = 1.0f; }
                int ln = layer, kn; bf16_t* an = H;
                if (op == 3) kn = 1; else if (op == 13) { ln = layer + 1; kn = 0; } else { kn = 2; if (op == 10) an = H2; }
                if (ln >= 4) { an = nullptr; ln = 0; }
                const pg8::Gemm g{gA, gB, MTOK, 1024, gK, glda, gldb, gapn};
                const pg8::EpiResid E{X, egate, escale, an, args.in[8] + ((size_t)ln * 3 + kn) * 1024, MOD + (size_t)ln * 9 * NMOD + (3 * kn + 1) * 1024, RSS + (size_t)(ln * 3 + kn) * MTOK, ecoef, 0};
                pg8::StaticOrder S; S.init(MTOK, 1024, G, bid, 1);
                pg8::gemm_phase<pg8::EpiResid, true>((LAS unsigned char*)lds, g, S, E);
            } else if (EN_GRAW && (op == 5 || op == 7)) {
                const bool gin = op == 5;
                const pg8::Gemm g{gin ? (const bf16_t*)H : (const bf16_t*)QKVLAT, gin ? WIN + (size_t)j * 1536 * 1024 : WQKV + (size_t)j * 1792 * 384, gin ? MTOK : MEXT, gin ? 1536 : 1792, gin ? 1024 : 384, gin ? 1024 : 384, gin ? 1024 : 384, 0};
                const pg8::EpiRaw E{PROJ, gin ? GM : QKV, gin ? RSS + (size_t)(layer * 3 + 1) * MTOK : (const float*)nullptr, BIN + (size_t)j * 9 * 1536, 512, gin ? 2 : 0, gin ? 1024 : QLD, gin ? 1 : 0};
                pg8::StaticOrder S; S.init(gin ? MTOK : MEXT, gin ? 1536 : 1792, G, bid);
                pg8::gemm_phase<pg8::EpiRaw>((LAS unsigned char*)lds, g, S, E);
            } else if (EN_POST1 && op == 6) {
                {
                    LAS float* rs = (LAS float*)lds; LAS bf16_t* tT = (LAS bf16_t*)(lds + 1024);
                    const float* vn = args.in[19] + (size_t)j * 512; const float* gb = args.in[21] + (size_t)j * 512;
                    for (int item = bid; item < 1280; item += G) {
                        const int chunk = item >> 2, gq = item & 3; const size_t tok0 = (size_t)chunk * 128;
                        { u32x4 wv[16];
#pragma unroll
                          for (int tt = 0; tt < 16; ++tt) wv[tt] = *(const u32x4*)(GM + (tok0 + wave * 16 + tt) * 1024 + 512 + lane * 8);
#pragma unroll
                          for (int tt = 0; tt < 16; ++tt) { float ss = 0.f;
#pragma unroll
                            for (int e = 0; e < 4; ++e) { const float a = bflo(wv[tt][e]), b = bfhi(wv[tt][e]); ss += a * a + b * b; }
                            ss = wave_sum(ss); if (lane == 0) rs[wave * 16 + tt] = 1.0f / sqrtf(ss * (1.0f / 512.0f) + EPS); } }
                        __syncthreads();
                        { const int q = tid >> 2, cp = tid & 3; const float rq = rs[q];
#pragma unroll
                          for (int cc = 0; cc < 4; ++cc) { const int c0 = cp * 32 + cc * 8; const u32x4 w = *(const u32x4*)(GM + (tok0 + q) * 1024 + 512 + gq * 128 + c0);
                              const f32x4 n0 = *(const f32x4*)(vn + gq * 128 + c0), n1 = *(const f32x4*)(vn + gq * 128 + c0 + 4);
                              float v[8] = {bflo(w[0]) * n0[0], bfhi(w[0]) * n0[1], bflo(w[1]) * n0[2], bfhi(w[1]) * n0[3], bflo(w[2]) * n1[0], bfhi(w[2]) * n1[1], bflo(w[3]) * n1[2], bfhi(w[3]) * n1[3]};
#pragma unroll
                              for (int e = 0; e < 8; ++e) tT[(c0 + e) * 136 + q] = (bf16_t)(cvt_pk_bf16(v[e] * rq, 0.f) & 0xffffu); } }
                        __syncthreads();
                        f32x4 acc[8];
#pragma unroll
                        for (int n = 0; n < 8; ++n) acc[n] = (f32x4){0.f, 0.f, 0.f, 0.f};
                        const bf16_t* wsp = WSB + ((size_t)(j * 4 + gq) * 128 + wave * 16 + (lane & 15)) * 128 + 8 * (lane >> 4);
#pragma unroll
                        for (int ks = 0; ks < 4; ++ks) { const bf16x8 a = *(const bf16x8*)(wsp + 32 * ks);
#pragma unroll
                            for (int n = 0; n < 8; ++n) { const bf16x8 b = *(const LAS bf16x8*)(tT + (16 * n + (lane & 15)) * 136 + 32 * ks + 8 * (lane >> 4));
                                acc[n] = __builtin_amdgcn_mfma_f32_16x16x32_bf16(b, a, acc[n], 0, 0, 0); } }
                        { const int p = wave * 16 + (lane & 15); const size_t tok = tok0 + p; const float bsp = gb[gq * 128 + p];
                          u32x2 uu[8];
#pragma unroll
                          for (int n = 0; n < 8; ++n) uu[n] = *(const u32x2*)(GM + tok * 1024 + gq * 128 + 16 * n + 4 * (lane >> 4));
#pragma unroll
                          for (int n = 0; n < 8; ++n) { u32x2 w; w.x = cvt_pk_bf16(bflo(uu[n].x) * (acc[n][0] + bsp), bfhi(uu[n].x) * (acc[n][1] + bsp)); w.y = cvt_pk_bf16(bflo(uu[n].y) * (acc[n][2] + bsp), bfhi(uu[n].y) * (acc[n][3] + bsp));
                              *(u32x2*)(MIX + tok * 1024 + 512 + gq * 128 + 16 * n + 4 * (lane >> 4)) = w; } }
                        __syncthreads();
                    }
                }
                const float* qan = args.in[13] + (size_t)j * 256; const float* kvan = args.in[14] + (size_t)j * 128;
                for (int r = gw; r < MTOK; r += 2 * NGW) {
                    const int r1 = r + NGW; const bool has1 = r1 < MTOK;
                    P1Row p0, p1; p1_load(p0, PROJ + (size_t)r * 512, lane); p1_load(p1, PROJ + (size_t)(has1 ? r1 : r) * 512, lane);
                    p1_finish(p0, r, j, lane, qan, kvan, QKVLAT, KROPE, OUT_CKV, OUT_KR); if (has1) p1_finish(p1, r1, j, lane, qan, kvan, QKVLAT, KROPE, OUT_CKV, OUT_KR);
                }
                for (int cidx = gw; cidx < 4096; cidx += NGW) {
                    const int b = cidx >> 9, p = cidx & 511; const int e = NCTX + b * KVB + LLAT + p;
                    const u32x2 z = {0u, 0u}; *(u32x2*)(QKVLAT + (size_t)e * 384 + 4 * lane) = z;
                    if (lane < 32) { const f32x4 kv = *(const f32x4*)(args.in[2] + (((size_t)b * 2 + j) * 512 + p) * 128 + 4 * lane); u32x2 w2; w2.x = cvt_pk_bf16(kv[0], kv[1]); w2.y = cvt_pk_bf16(kv[2], kv[3]);
                        *(u32x2*)(QKVLAT + (size_t)e * 384 + 256 + 4 * lane) = w2; }
                }
            } else if (EN_POST2 && op == 8) {
                const float* qn = args.in[17] + (size_t)j * 96; const float* kn = args.in[18] + (size_t)j * 96;
                const int hh = lane >> 3, s = lane & 7;
                for (int e = gw; e < MEXT; e += 2 * NGW) {
                    const int e1 = e + NGW; const bool has1 = e1 < MEXT;
                    P2Row r0, r1;
                    p2_load(r0, e, j, hh, s, QKV, KROPE, args.in[3]); p2_load(r1, has1 ? e1 : e, j, hh, s, QKV, KROPE, args.in[3]);
                    p2_compute(r0, s, qn, kn, ROPE); p2_compute(r1, s, qn, kn, ROPE);
                    asm volatile("s_waitcnt vmcnt(0)" ::: "memory");
                    p2_store(r0, hh, s, QKV); if (has1) p2_store(r1, hh, s, QKV);
                    asm volatile("" ::: "memory");
                }
            } else if (EN_ATT && op == 9) {
                const int vcu = (G % 8 == 0) ? (bid % 8) * (G / 8) + bid / 8 : bid;
                for (int u = vcu; u < 1280; u += G) {
                    const bf16_t *Qb, *Kh, *Vh; bf16_t* Ob; int seq;
                    if (u < 1024) { const int bh = u >> 4, qt = u & 15, b = bh >> 3, h = bh & 7; const size_t e0 = NCTX + (size_t)b * KVB;
                        Qb = QKV + (e0 + qt * 256) * QLD + h * 96; Kh = QKV + e0 * QLD + 768 + h * 96; Vh = QKV + e0 * QLD + 1536 + h * 64;
                        Ob = MIX + ((size_t)NCTX + (size_t)b * LLAT + qt * 256) * 1024 + h * 64; seq = KVB; }
                    else { const int vv = u - 1024, b = vv >> 3, h = vv & 7; const size_t e0 = (size_t)b * 256;
                        Qb = QKV + e0 * QLD + h * 96; Kh = QKV + e0 * QLD + 768 + h * 96; Vh = QKV + e0 * QLD + 1536 + h * 64; Ob = MIX + e0 * 1024 + h * 64; seq = 256; }
                    __syncthreads();
                    att::attn_unit(Qb, Kh, Vh, Ob, seq, (char*)lds);
                }
            } else if (EN_POOL && op == 14) {
                const float* rs = RSS + (size_t)(layer * 3 + 1) * MTOK;
                for (long i = gt; i < (long)(MTOK / 32) * 128; i += NGT) {
                    const int seg = (int)(i >> 7), ch = (int)(i & 127), hw = 1 << (ch >> 5);
                    const int r0 = seg * 32; int t0, L; if (r0 < NCTX) { t0 = r0 & 255; L = 256; } else { t0 = (r0 - NCTX) & 4095; L = 4096; }
                    const int base = r0 - t0; const bf16_t* __restrict__ hp = H + (size_t)base * 1024 + ch * 8; const float* __restrict__ rsp = rs + base; bf16_t* __restrict__ pbp = PB + (size_t)base * 1024 + ch * 8;
                    float sum[8];
#pragma unroll
                    for (int e2 = 0; e2 < 8; ++e2) sum[e2] = 0.f;
#define POOL_LD(tt, wgt) do { const u32x4 w_ = *(const u32x4*)(hp + (size_t)(tt) * 1024); const float q_ = (wgt) * __builtin_amdgcn_rsqf(rsp[tt] * (1.0f / 1024.0f) + EPS); \
                        _Pragma("unroll") for (int e2 = 0; e2 < 4; ++e2) { sum[2 * e2] += bflo(w_[e2]) * q_; sum[2 * e2 + 1] += bfhi(w_[e2]) * q_; } } while (0)
#pragma unroll
                    for (int i2 = 0; i2 < 16; ++i2) { const int tt = t0 - hw + i2; const bool ok = (i2 < 2 * hw) && tt >= 0; const int tc = tt < 0 ? 0 : (tt > L - 1 ? L - 1 : tt); POOL_LD(tc, ok ? 1.0f : 0.0f); }
#pragma unroll 4
                    for (int t = t0; t < t0 + 32; ++t) {
                        const int lo2 = t - hw < 0 ? 0 : t - hw, hi2 = t + hw > L ? L : t + hw; const float inv = 1.0f / (float)(hi2 - lo2);
                        const u32x4 w0 = *(const u32x4*)(hp + (size_t)t * 1024); const float q0 = __builtin_amdgcn_rsqf(rsp[t] * (1.0f / 1024.0f) + EPS); u32x4 o;
#pragma unroll
                        for (int e2 = 0; e2 < 4; ++e2) o[e2] = cvt_pk_bf16(sum[2 * e2] * inv - bflo(w0[e2]) * q0, sum[2 * e2 + 1] * inv - bfhi(w0[e2]) * q0);
                        *(u32x4*)(pbp + (size_t)t * 1024) = o;
                        { const int tp = t + hw, tm = t - hw; const int tpc = tp > L - 1 ? L - 1 : tp, tmc = tm < 0 ? 0 : tm;
                          POOL_LD(tpc, tp < L ? 1.0f : 0.0f); POOL_LD(tmc, tm >= 0 ? -1.0f : 0.0f); }
                    }
#undef POOL_LD
                }
            }
            if (rep + 1 < reps || pid + 1 < hi) xcd_barrier(xbar);
            }
        }
    }
}

extern "C" void kernel_launch(void* const* d_in, const int* in_sizes, int n_in, void* d_out, int out_size, void* d_ws, size_t ws_size, hipStream_t stream) {
    static int grid = 0;
    if (grid == 0) {
        if (n_in != 25 || ws_size < WS_NEED) { fprintf(stderr, "kernel_launch: n_in %d ws %zu (need %zu)\n", n_in, ws_size, (size_t)WS_NEED); grid = -1; return; }
        int dev = 0, cus = 0, per_cu = 0;
        hipGetDevice(&dev); hipDeviceGetAttribute(&cus, hipDeviceAttributeMultiprocessorCount, dev);
        if (hipFuncSetAttribute((const void*)fwd_mega, hipFuncAttributeMaxDynamicSharedMemorySize, LDS_BYTES) != hipSuccess) { fprintf(stderr, "kernel_launch: hipFuncSetAttribute failed\n"); grid = -1; return; }
        if (hipOccupancyMaxActiveBlocksPerMultiprocessor(&per_cu, (const void*)fwd_mega, 512, LDS_BYTES) != hipSuccess || per_cu < 1) { fprintf(stderr, "kernel_launch: occupancy query gave %d\n", per_cu); per_cu = 1; }
        (void)hipGetLastError();
        grid = cus * per_cu;
    }
    if (grid < 0) return;
    Args a{};
    for (int i = 0; i < 25; ++i) a.in[i] = (const float*)d_in[i];
    a.out = (float*)d_out; a.ws = (unsigned char*)d_ws; a.ph_lo = 0; a.ph_hi = 34;
    void* kargs[] = {&a};
    hipError_t e = hipLaunchCooperativeKernel((const void*)fwd_mega, dim3(grid), dim3(512), kargs, LDS_BYTES, stream);
    if (e != hipSuccess) fprintf(stderr, "kernel_launch: cooperative launch failed: %s (grid %d)\n", hipGetErrorString(e), grid);
}
```

```cpp
#include <hip/hip_runtime.h>
#include <hip/hip_cooperative_groups.h>
#include <cstdio>
#include <cstdint>
namespace cg = cooperative_groups;
#ifndef EN_NORM
#define EN_NORM 1
#endif
#ifndef EN_G1
#define EN_G1 1
#endif
#ifndef EN_GRES
#define EN_GRES 1
#endif
#ifndef EN_GRAW
#define EN_GRAW 1
#endif
#ifndef EN_POST1
#define EN_POST1 1
#endif
#ifndef EN_POST2
#define EN_POST2 1
#endif
#ifndef EN_ATT
#define EN_ATT 1
#endif
#ifndef EN_POOL
#define EN_POOL 1
#endif
#ifndef EN_PRO
#define EN_PRO 1
#endif
#ifndef DUPMASK
#define DUPMASK 0
#endif

#define LAS __attribute__((address_space(3)))
typedef unsigned short bf16_t;
typedef short bf16x8 __attribute__((ext_vector_type(8)));
typedef short s16x4 __attribute__((ext_vector_type(4)));
typedef float f32x4 __attribute__((ext_vector_type(4)));
typedef float f32x16 __attribute__((ext_vector_type(16)));
typedef unsigned u32x4 __attribute__((ext_vector_type(4)));
typedef unsigned u32x2 __attribute__((ext_vector_type(2)));

constexpr int DM = 1024, FF = 2816, MTOK = 40960, MEXT = 45056, NCTX = 8192, LLAT = 4096, PAST = 512, KVB = 4608;
constexpr int NMOD = 9216;
constexpr int QLD = 2048;
constexpr float EPS = 1e-6f;
constexpr size_t SZ_W13 = (size_t)8 * 5632 * 1024 * 2, SZ_W2 = (size_t)8 * 1024 * 2816 * 2, SZ_WIN = (size_t)2 * 1536 * 1024 * 2,
                 SZ_WQKV = (size_t)2 * 1792 * 384 * 2, SZ_WOUT = (size_t)2 * 1024 * 1024 * 2, SZ_POOLT = (size_t)2 * 1024 * 256 * 2,
                 SZ_WS = (size_t)2 * 4 * 128 * 128 * 2, SZ_MOD = (size_t)4 * 9 * NMOD * 4, SZ_ROPE = (size_t)2 * 4096 * 16 * 4,
                 SZ_H = (size_t)MTOK * 1024 * 2;
constexpr size_t OFF_W13 = 0, OFF_W2 = OFF_W13 + SZ_W13, OFF_WIN = OFF_W2 + SZ_W2, OFF_WQKV = OFF_WIN + SZ_WIN, OFF_WOUT = OFF_WQKV + SZ_WQKV,
                 OFF_POOLT = OFF_WOUT + SZ_WOUT, OFF_WS = OFF_POOLT + SZ_POOLT, OFF_MOD = OFF_WS + SZ_WS, OFF_ROPE = OFF_MOD + SZ_MOD,
                 OFF_H = OFF_ROPE + SZ_ROPE, OFF_R = OFF_H + SZ_H;
constexpr size_t R_QKVLAT = 0, R_KROPE = (size_t)MEXT * 384 * 2, R_PROJ = 41943040, R_GM = R_PROJ + (size_t)MTOK * 512 * 4,
                 R_QKVRAW = R_PROJ, SZ_R = SZ_H + (size_t)MTOK * 2816 * 2;
static_assert(R_KROPE + (size_t)MTOK * 32 * 4 <= R_PROJ, "ws map");
static_assert(R_QKVRAW + (size_t)MEXT * QLD * 2 <= SZ_R, "ws map");
constexpr size_t OFF_CTL = OFF_R + SZ_R, SZ_CTL = 16384;
constexpr size_t OFF_RSS = OFF_CTL + SZ_CTL, SZ_RSS = (size_t)12 * MTOK * 4;
constexpr size_t OFF_B13 = OFF_RSS + SZ_RSS, SZ_B13 = (size_t)8 * 9 * 5632 * 4;
constexpr size_t OFF_BIN = OFF_B13 + SZ_B13, SZ_BIN = (size_t)2 * 9 * 1536 * 4;
constexpr size_t R_U = SZ_H;
static_assert(R_U + (size_t)MTOK * 2816 * 2 <= SZ_R, "ws map");
constexpr size_t OFF_VSS = OFF_BIN + SZ_BIN, SZ_VSS = (size_t)2 * MTOK * 4;
constexpr size_t WS_NEED = OFF_VSS + SZ_VSS;

__device__ __forceinline__ unsigned cvt_pk_bf16(float lo, float hi) { unsigned r; asm volatile("v_cvt_pk_bf16_f32 %0, %1, %2" : "=v"(r) : "v"(lo), "v"(hi)); return r; }
__device__ __forceinline__ float bf2f(unsigned short b) { return __uint_as_float(((unsigned)b) << 16); }
__device__ __forceinline__ float bflo(unsigned w) { return __uint_as_float(w << 16); }
__device__ __forceinline__ float bfhi(unsigned w) { return __uint_as_float(w & 0xffff0000u); }
__device__ __forceinline__ float wave_sum(float v) {
#pragma unroll
    for (int o = 1; o < 64; o <<= 1) v += __shfl_xor(v, o);
    return v;
}
__device__ __forceinline__ float fast_sigmoid(float x) { return __builtin_amdgcn_rcpf(1.0f + __builtin_amdgcn_exp2f(-1.4426950408889634f * x)); }
__device__ __forceinline__ float silu_f(float x) { return x * fast_sigmoid(x); }
__device__ __forceinline__ float gelu_tanh_f(float x) { const float y = 0.7978845608028654f * (x + 0.044715f * x * x * x); return x * fast_sigmoid(2.0f * y); }
__device__ __forceinline__ f32x4 sigmoid4(f32x4 x) {
    const f32x4 t = x * -1.4426950408889634f; f32x4 e;
#pragma unroll
    for (int i = 0; i < 4; ++i) e[i] = __builtin_amdgcn_exp2f(t[i]);
    const f32x4 d = e + 1.0f; f32x4 r;
#pragma unroll
    for (int i = 0; i < 4; ++i) r[i] = __builtin_amdgcn_rcpf(d[i]);
    return r;
}
__device__ __forceinline__ f32x4 silu4(f32x4 x) { return x * sigmoid4(x); }
__device__ __forceinline__ f32x4 gelu_tanh4(f32x4 x) { const f32x4 y = (x + x * x * x * 0.044715f) * (2.0f * 0.7978845608028654f); return x * sigmoid4(y); }
__device__ __forceinline__ int cv_of_row(int r) { return r < NCTX ? 0 : 1 + ((r - NCTX) >> 12); }

#ifndef PROBE_KREP
#define PROBE_KREP 1
#endif
namespace pg8 {
constexpr int BM = 256, BK = 64, HALF = 128, HTB = HALF * BK * 2, STAGE_BYTES = 8 * HTB, NXCD = 8, WGM = 8;
__host__ __device__ __forceinline__ int lds_byte(int r, int c) { const int st = (r >> 4) * 2 + (c >> 5), rr = r & 15, cc = c & 31, ob = rr * 64 + cc * 2; return st * 1024 + (ob ^ (((ob >> 9) & 1) << 5)); }
__host__ __device__ __forceinline__ void stage_rc(int b, int& R, int& C) { const int st = b / 1024, sb = b % 1024, swz = sb ^ (((sb >> 9) & 1) << 5); R = (st >> 1) * 16 + swz / 64; C = (st & 1) * 32 + (swz % 64) / 2; }
__host__ __device__ __forceinline__ int perm32(int rho) { const int n = rho >> 4, i = rho & 15; return 8 * (i >> 2) + 4 * n + (i & 3); }

struct Unit { int pm, pn, half; };
struct Gemm { const bf16_t* A; const bf16_t* Bt; int M, N, K, lda, ldb, apn; };

struct StaticOrder {
    int nM, nN, nwg, G, c, ht;
    __device__ void init(int M, int N, int G_, int c_, int ht_ = 0) { nM = M / BM; nN = N / BM; nwg = nM * nN; G = G_; c = c_; ht = ht_; }
    __device__ bool next(int i, Unit& u) const {
        long L = (long)i * G + c; u.half = -1;
        if (ht) { const int nfull = nwg / G, rem = nwg - nfull * G;
            if (rem > 0 && 2 * rem <= G && i >= nfull) { if (i > nfull || (c >> 1) >= rem) return false; L = (long)nfull * G + (c >> 1); u.half = c & 1; } }
        if (L >= nwg) return false;
        int wgid = (int)L; { const int q = nwg / NXCD, r = nwg % NXCD, xcd = wgid % NXCD, off = wgid / NXCD; wgid = (xcd < r ? xcd * (q + 1) : r * (q + 1) + (xcd - r) * q) + off; }
        const int nig = WGM * nN, gid = wgid / nig, fm = gid * WGM, gsz = (nM - fm) < WGM ? (nM - fm) : WGM;
        u.pm = fm + ((wgid % nig) % gsz); u.pn = (wgid % nig) / gsz; return true;
    }
};

struct EpiSwiglu {
    static constexpr bool PERM = true; static constexpr int KREP = PROBE_KREP;
    bf16_t* U; const float* rss; const float* bias;
    static constexpr bool PREF = true;
    __device__ __forceinline__ bool pref_on() const { return true; }
    __device__ __forceinline__ const float* pref_ptr(const Unit& u, int tid) const { const int cv = u.pm < 32 ? 0 : 1 + ((u.pm - 32) >> 4);
        return tid < 256 ? rss + u.pm * BM + tid : bias + (size_t)cv * 5632 + u.pn * BM + (tid - 256); }
    __device__ __forceinline__ void run(f32x4 (&acc)[2][2][4][2], const Unit& u, int wr, int wc, int fr, int fq, const LAS float* sc) const {
        const int row0 = u.pm * BM + wr * 64 + fr, col0 = u.pn * HALF + wc * 32 + 8 * fq;
        const LAS float* bp = sc + 256 + wc * 32 + 8 * fq;
        const f32x4 ba0 = *(const LAS f32x4*)(bp), ba1 = *(const LAS f32x4*)(bp + 4), bb0 = *(const LAS f32x4*)(bp + HALF), bb1 = *(const LAS f32x4*)(bp + HALF + 4);
#pragma unroll
        for (int ai = 0; ai < 2; ++ai)
#pragma unroll
            for (int m = 0; m < 4; ++m) {
                const int row = row0 + ai * HALF + m * 16;
                bf16_t* rowp = U + (size_t)row * FF + col0;
                const float rstd = (1.0f / (float)KREP) * __builtin_amdgcn_rsqf(sc[ai * HALF + wr * 64 + m * 16 + fr] * (1.0f / 1024.0f) + EPS);
                const f32x4 a0 = acc[ai][0][m][0] * rstd + ba0, a1 = acc[ai][0][m][1] * rstd + ba1, b0 = acc[ai][1][m][0] * rstd + bb0, b1 = acc[ai][1][m][1] * rstd + bb1;
                const f32x4 v0 = silu4(a0) * b0, v1 = silu4(a1) * b1;
                u32x4 w; w.x = cvt_pk_bf16(v0[0], v0[1]); w.y = cvt_pk_bf16(v0[2], v0[3]); w.z = cvt_pk_bf16(v1[0], v1[1]); w.w = cvt_pk_bf16(v1[2], v1[3]);
                *(u32x4*)rowp = w;
            }
    }
};
struct EpiResid {
    static constexpr bool PERM = true; static constexpr int KREP = 1;
    float* X; const float* gate; const float* scale;
    bf16_t* An; const float* gn; const float* scn; float* rssn;
    float coef; int pad_;
    static constexpr bool PREF = false;
    __device__ __forceinline__ bool pref_on() const { return false; }
    __device__ __forceinline__ const float* pref_ptr(const Unit&, int) const { return nullptr; }
    __device__ __forceinline__ void run(f32x4 (&acc)[2][2][4][2], const Unit& u, int wr, int wc, int fr, int fq, const LAS float*) const {
        const int row0 = u.pm * BM + wr * 64 + fr; int col0 = u.pn * BM + wc * 32 + 8 * fq;
        const int cv = u.pm < 32 ? 0 : 1 + ((u.pm - 32) >> 4);
        const bool nx = An != nullptr;
        const int hb = u.half > 0 ? HALF : 0, nbj = u.half < 0 ? 2 : 1;
        col0 += hb;
        f32x4 gv[2][2], gm[2][2];
#pragma unroll
        for (int bj = 0; bj < 2; ++bj)
#pragma unroll
            for (int n = 0; n < 2; ++n) { const int c = col0 + (bj < nbj ? bj : 0) * HALF + 4 * n; f32x4 g = *(const f32x4*)(gate + (size_t)cv * NMOD + c) * coef;
                if (scale) g = g * *(const f32x4*)(scale + c); gv[bj][n] = g;
                gm[bj][n] = nx ? *(const f32x4*)(gn + c) * (*(const f32x4*)(scn + (size_t)cv * NMOD + c) + 1.0f) : (f32x4){0.f, 0.f, 0.f, 0.f}; }
#pragma unroll
        for (int ai = 0; ai < 2; ++ai)
#pragma unroll
            for (int m = 0; m < 4; ++m) { const int row = row0 + ai * HALF + m * 16; float* rowp = X + (size_t)row * DM + col0;
                float ss = 0.f;
#pragma unroll
                for (int bj = 0; bj < 2; ++bj) if (bj < nbj) { f32x4* p = (f32x4*)(rowp + bj * HALF);
                    const f32x4 x0 = __builtin_nontemporal_load(p) + acc[ai][bj][m][0] * gv[bj][0], x1 = __builtin_nontemporal_load(p + 1) + acc[ai][bj][m][1] * gv[bj][1];
                    __builtin_nontemporal_store(x0, p); __builtin_nontemporal_store(x1, p + 1);
                    if (nx) { ss += ((x0[0] * x0[0] + x0[1] * x0[1]) + (x0[2] * x0[2] + x0[3] * x0[3])) + ((x1[0] * x1[0] + x1[1] * x1[1]) + (x1[2] * x1[2] + x1[3] * x1[3]));
                        const f32x4 a0 = x0 * gm[bj][0], a1 = x1 * gm[bj][1]; u32x4 w; w.x = cvt_pk_bf16(a0[0], a0[1]); w.y = cvt_pk_bf16(a0[2], a0[3]); w.z = cvt_pk_bf16(a1[0], a1[1]); w.w = cvt_pk_bf16(a1[2], a1[3]);
                        *(u32x4*)(An + (size_t)row * DM + col0 + bj * HALF) = w; } }
                if (nx) { ss += __shfl_xor(ss, 16); ss += __shfl_xor(ss, 32);
                    if (fq == 0) (void)__hip_atomic_fetch_add(rssn + row, ss, __ATOMIC_RELAXED, __HIP_MEMORY_SCOPE_AGENT); } }
    }
};
struct EpiRaw {
    static constexpr bool PERM = true; static constexpr int KREP = 1;
    float* R; bf16_t* G; const float* rss; const float* bias; float* vss; int ldr, nraw, ldg, act;
    static constexpr bool PREF = true;
    __device__ __forceinline__ bool pref_on() const { return rss != nullptr; }
    __device__ __forceinline__ const float* pref_ptr(const Unit& u, int tid) const { const int cv = u.pm < 32 ? 0 : 1 + ((u.pm - 32) >> 4);
        return tid < 256 ? rss + u.pm * BM + tid : bias + (size_t)cv * 1536 + u.pn * BM + (tid - 256); }
    __device__ __forceinline__ void run(f32x4 (&acc)[2][2][4][2], const Unit& u, int wr, int wc, int fr, int fq, const LAS float* sc) const {
        const int row0 = u.pm * BM + wr * 64 + fr, cw = wc * 32 + 8 * fq;
        if (rss) {
            f32x4 bv[2][2];
#pragma unroll
            for (int bj = 0; bj < 2; ++bj)
#pragma unroll
                for (int n = 0; n < 2; ++n) bv[bj][n] = *(const LAS f32x4*)(sc + 256 + cw + bj * HALF + 4 * n);
#pragma unroll
            for (int ai = 0; ai < 2; ++ai)
#pragma unroll
                for (int m = 0; m < 4; ++m) { const float rstd = __builtin_amdgcn_rsqf(sc[ai * HALF + wr * 64 + m * 16 + fr] * (1.0f / 1024.0f) + EPS);
#pragma unroll
                    for (int bj = 0; bj < 2; ++bj)
#pragma unroll
                        for (int n = 0; n < 2; ++n) acc[ai][bj][m][n] = acc[ai][bj][m][n] * rstd + bv[bj][n]; }
        }
        if (u.pn < nraw) {
#pragma unroll
            for (int ai = 0; ai < 2; ++ai)
#pragma unroll
                for (int m = 0; m < 4; ++m) { float* rowp = R + (size_t)(row0 + ai * HALF + m * 16) * ldr + u.pn * BM + cw;
#pragma unroll
                    for (int bj = 0; bj < 2; ++bj) { *(f32x4*)(rowp + bj * HALF) = acc[ai][bj][m][0]; *(f32x4*)(rowp + bj * HALF + 4) = acc[ai][bj][m][1]; } }
        } else {
            const bool dovs = vss != nullptr && (u.pn - nraw) >= 2;
#pragma unroll
            for (int ai = 0; ai < 2; ++ai)
#pragma unroll
                for (int m = 0; m < 4; ++m) { bf16_t* rowp = G + (size_t)(row0 + ai * HALF + m * 16) * ldg + (u.pn - nraw) * BM + cw; float vs = 0.f;
#pragma unroll
                    for (int bj = 0; bj < 2; ++bj) { f32x4 v0 = acc[ai][bj][m][0], v1 = acc[ai][bj][m][1];
                        if (act) { v0 = gelu_tanh4(v0); v1 = gelu_tanh4(v1); }
                        vs += ((v0[0] * v0[0] + v0[1] * v0[1]) + (v0[2] * v0[2] + v0[3] * v0[3])) + ((v1[0] * v1[0] + v1[1] * v1[1]) + (v1[2] * v1[2] + v1[3] * v1[3]));
                        u32x4 w; w.x = cvt_pk_bf16(v0[0], v0[1]); w.y = cvt_pk_bf16(v0[2], v0[3]); w.z = cvt_pk_bf16(v1[0], v1[1]); w.w = cvt_pk_bf16(v1[2], v1[3]);
                        *(u32x4*)(rowp + bj * HALF) = w; }
                    if (dovs) { vs += __shfl_xor(vs, 16); vs += __shfl_xor(vs, 32);
                        if (fq == 0) (void)__hip_atomic_fetch_add(vss + row0 + ai * HALF + m * 16, vs, __ATOMIC_RELAXED, __HIP_MEMORY_SCOPE_AGENT); } }
        }
    }
};

template <class Epi, bool HT = false>
__device__ __forceinline__ void gemm_phase(LAS unsigned char* lds, const Gemm g, const StaticOrder S, const Epi E) {
    int tid = threadIdx.x; asm volatile("" : "+v"(tid));
    const int wid = __builtin_amdgcn_readfirstlane(tid >> 6), lane = tid & 63, wr = wid >> 2, wc = wid & 3, fr = lane & 15, fq = lane >> 4;
    const int nt = g.K / BK;
    unsigned voffA[2], voffB[2];
#pragma unroll
    for (int i = 0; i < 2; ++i) { int R, C; stage_rc(tid * 16 + i * 8192, R, C); const int Rb = Epi::PERM ? ((R & ~31) + perm32(R & 31)) : R;
        voffA[i] = (unsigned)(R * g.lda + C) * 2u; voffB[i] = (unsigned)(Rb * g.ldb + C) * 2u; }
    const size_t kstep = (size_t)(BK * 2);
    const size_t hstepA = (size_t)HALF * g.lda * 2, hstepB = (size_t)HALF * g.ldb * 2;
    const size_t tstepA = 2 * hstepA, tstepB = 2 * hstepB;
    const unsigned ldsw = (unsigned)wid * 1024u;
    const int aoff = lds_byte(wr * 64 + fr, fq * 8), boff = lds_byte(wc * 32 + fr, fq * 8);
#define PG8_SA(b, h) (((b) * 2 + (h)) * HTB)
#define PG8_SB(b, h) ((4 + (b) * 2 + (h)) * HTB)
#define PG8_STAGE(bufoff, gbase, voff) do { _Pragma("unroll") for (int _i = 0; _i < 2; ++_i) \
        __builtin_amdgcn_global_load_lds((const unsigned*)((const char*)(gbase) + (voff)[_i]), (LAS unsigned*)(lds + (bufoff) + ldsw + _i * 8192), 16, 0, 0); } while (0)
#define PG8_LDA(dst, b, h) do { _Pragma("unroll") for (int m = 0; m < 4; ++m) _Pragma("unroll") for (int k = 0; k < 2; ++k) dst[m][k] = *(const LAS bf16x8*)(lds + PG8_SA(b, h) + aoff + m * 2048 + k * 1024); } while (0)
#define PG8_LDB(dst, b, h) do { _Pragma("unroll") for (int n = 0; n < 2; ++n) _Pragma("unroll") for (int k = 0; k < 2; ++k) dst[n][k] = *(const LAS bf16x8*)(lds + PG8_SB(b, h) + boff + n * 2048 + k * 1024); } while (0)
#define PG8_MMA(ai, bj, At, Bt) do { __builtin_amdgcn_s_setprio(1); _Pragma("unroll") for (int m = 0; m < 4; ++m) _Pragma("unroll") for (int n = 0; n < 2; ++n) _Pragma("unroll") for (int k = 0; k < 2; ++k) \
        acc[ai][bj][m][n] = __builtin_amdgcn_mfma_f32_16x16x32_bf16(Bt[n][k], At[m][k], acc[ai][bj][m][n], 0, 0, 0); __builtin_amdgcn_s_setprio(0); } while (0)
#define PG8_WAIT_V(n) asm volatile("s_waitcnt vmcnt(" #n ")" ::: "memory")
#define PG8_WAIT_L(n) asm volatile("s_waitcnt lgkmcnt(" #n ")" ::: "memory")
#define PG8_BAR __builtin_amdgcn_s_barrier()
#define PG8_SCHED __builtin_amdgcn_sched_barrier(0)
    Unit cur, nxt; int ui = 0;
    if (!S.next(0, cur)) return;
    constexpr int EPI_LDS = 131328;
#define PG8_PREF(u) do { if (Epi::PREF && E.pref_on()) __builtin_amdgcn_global_load_lds((const unsigned*)E.pref_ptr(u, tid), (LAS unsigned*)(lds + EPI_LDS + (ui & 1) * 2048 + wid * 256), 4, 0, 0); } while (0)
    PG8_PREF(cur);
    f32x4 acc[2][2][4][2];
#pragma unroll
    for (int a = 0; a < 2; ++a)
#pragma unroll
        for (int b = 0; b < 2; ++b)
#pragma unroll
            for (int m = 0; m < 4; ++m)
#pragma unroll
                for (int n = 0; n < 2; ++n) acc[a][b][m][n] = (f32x4){0.f, 0.f, 0.f, 0.f};
    bf16x8 At[4][2], B0[2][2], B1[2][2];
    const char* cA = (const char*)g.A + (size_t)cur.pm * tstepA + (size_t)cur.pn * g.apn; const char* cB = (const char*)g.Bt + (size_t)cur.pn * tstepB + ((HT && cur.half > 0) ? hstepB : 0);
    size_t hBc = (HT && cur.half >= 0) ? 0 : hstepB;
    PG8_STAGE(PG8_SB(0, 0), cB, voffB); PG8_STAGE(PG8_SB(0, 1), cB + hBc, voffB); PG8_STAGE(PG8_SA(0, 0), cA, voffA); PG8_STAGE(PG8_SA(0, 1), cA + hstepA, voffA);
    if (wr == 1) PG8_BAR;
    PG8_WAIT_V(2); PG8_BAR;
    PG8_STAGE(PG8_SB(1, 0), cB + kstep, voffB); PG8_STAGE(PG8_SA(1, 0), cA + kstep, voffA); PG8_STAGE(PG8_SB(1, 1), cB + hBc + kstep, voffB);
    PG8_WAIT_V(6); PG8_BAR;
#define PG8_KBODY(B1ON) \
        for (int t = 0, tk = 0; t < nt * Epi::KREP; t += 2) { \
            const bool last = (t == nt * Epi::KREP - 2); \
            const int tk2 = (tk + 2 >= nt) ? tk + 2 - nt : tk + 2; \
            const char* a1 = cA + (size_t)(tk + 1) * kstep; \
            const char* a2 = last ? nA : cA + (size_t)tk2 * kstep; const char* b2 = last ? nB : cB + (size_t)tk2 * kstep; const size_t hb2 = last ? nhB : hBc; tk = tk2; \
            const char* a3 = a2 + kstep; const char* b3 = b2 + kstep; \
            PG8_LDB(B0, 0, 0); if (B1ON) PG8_LDB(B1, 0, 1); PG8_SCHED; PG8_LDA(At, 0, 0); PG8_STAGE(PG8_SA(1, 1), a1 + hstepA, voffA); \
            PG8_WAIT_V(8); PG8_WAIT_L(0); PG8_BAR; PG8_MMA(0, 0, At, B0); if (B1ON) PG8_MMA(0, 1, At, B1); PG8_BAR; PG8_SCHED; \
            PG8_LDA(At, 0, 1); PG8_STAGE(PG8_SB(0, 0), b2, voffB); PG8_STAGE(PG8_SB(0, 1), b2 + hb2, voffB); PG8_STAGE(PG8_SA(0, 0), a2, voffA); \
            PG8_WAIT_V(8); PG8_WAIT_L(0); PG8_BAR; PG8_MMA(1, 0, At, B0); if (B1ON) PG8_MMA(1, 1, At, B1); PG8_BAR; PG8_SCHED; \
            PG8_LDB(B0, 1, 0); if (B1ON) PG8_LDB(B1, 1, 1); PG8_SCHED; PG8_LDA(At, 1, 0); PG8_STAGE(PG8_SA(0, 1), a2 + hstepA, voffA); \
            PG8_WAIT_V(8); PG8_WAIT_L(0); PG8_BAR; PG8_MMA(0, 0, At, B0); if (B1ON) PG8_MMA(0, 1, At, B1); PG8_BAR; PG8_SCHED; \
            PG8_LDA(At, 1, 1); PG8_STAGE(PG8_SB(1, 0), b3, voffB); PG8_STAGE(PG8_SB(1, 1), b3 + hb2, voffB); PG8_STAGE(PG8_SA(1, 0), a3, voffA); \
            PG8_WAIT_V(8); PG8_WAIT_L(0); PG8_BAR; PG8_MMA(1, 0, At, B0); if (B1ON) PG8_MMA(1, 1, At, B1); PG8_BAR; PG8_SCHED; \
        }
    for (;;) {
        const bool has_next = S.next(ui + 1, nxt);
        const char* nA = has_next ? (const char*)g.A + (size_t)nxt.pm * tstepA + (size_t)nxt.pn * g.apn : cA;
        const char* nB = has_next ? (const char*)g.Bt + (size_t)nxt.pn * tstepB + ((HT && nxt.half > 0) ? hstepB : 0) : cB;
        const size_t nhB = has_next ? ((HT && nxt.half >= 0) ? 0 : hstepB) : hBc;
        if (HT && cur.half >= 0) { PG8_KBODY(false) } else { PG8_KBODY(true) }
        if (wr == 0) PG8_BAR;
        E.run(acc, cur, wr, wc, fr, fq, (const LAS float*)(lds + EPI_LDS + (ui & 1) * 2048));
        if (!has_next) break;
#pragma unroll
        for (int a = 0; a < 2; ++a)
#pragma unroll
            for (int b = 0; b < 2; ++b)
#pragma unroll
                for (int m = 0; m < 4; ++m)
#pragma unroll
                    for (int n = 0; n < 2; ++n) acc[a][b][m][n] = (f32x4){0.f, 0.f, 0.f, 0.f};
        cur = nxt; cA = nA; cB = nB; hBc = nhB; ++ui;
        PG8_PREF(cur);
        if (wr == 1) PG8_BAR;
    }
    PG8_WAIT_V(0);
    PG8_BAR;
#undef PG8_KBODY
#undef PG8_PREF
#undef PG8_SA
#undef PG8_SB
#undef PG8_STAGE
#undef PG8_LDA
#undef PG8_LDB
#undef PG8_MMA
#undef PG8_WAIT_V
#undef PG8_WAIT_L
#undef PG8_BAR
#undef PG8_SCHED
}
}

namespace att {
constexpr int NW = 8, QBLK = 32, KVBLK = 64;
constexpr float SCALE = 0.10206207261596575f;
constexpr float THR = 8.f;
constexpr size_t SHM_V = 16384, SHM_K = 16384, SHM_ATTN = 2 * SHM_V + 2 * SHM_K + NW * 64 * 4;
#define KSWZ(row, colB) ((row) * 256 + ((colB) ^ (((row) & 7) << 4)))
#define SBAR() __builtin_amdgcn_sched_barrier(0)
__device__ __forceinline__ int crow(int r, int hi) { return (r & 3) + 8 * (r >> 2) + 4 * hi; }
__device__ __forceinline__ void partialSM(f32x16& p0, f32x16& p1, float& m_reg, float& mn, float& alpha) {
  constexpr float C = SCALE * 1.4426950408889634f;
  float pmax = p0[0];
#pragma unroll
  for (int r = 1; r < 16; ++r) pmax = fmaxf(pmax, p0[r]);
#pragma unroll
  for (int r = 0; r < 16; ++r) pmax = fmaxf(pmax, p1[r]);
  { auto rr = __builtin_amdgcn_permlane32_swap(__float_as_uint(pmax), __float_as_uint(pmax), false, false);
    pmax = fmaxf(__uint_as_float(rr[0]), __uint_as_float(rr[1])); }
  if (__builtin_expect(__all(pmax - m_reg <= THR / SCALE), 1)) { mn = m_reg; alpha = 1.f; }
  else { mn = fmaxf(m_reg, pmax); alpha = __builtin_amdgcn_exp2f((m_reg - mn) * C); m_reg = mn; }
  float mnC = -mn * C;
#pragma unroll
  for (int r = 0; r < 16; ++r) p0[r] = fmaf(p0[r], C, mnC);
#pragma unroll
  for (int r = 0; r < 16; ++r) p1[r] = fmaf(p1[r], C, mnC);
#pragma unroll
  for (int r = 0; r < 16; ++r) p0[r] = __builtin_amdgcn_exp2f(p0[r]);
}
__device__ __forceinline__ void finishSM(f32x16& p0, f32x16& p1, float alpha, float& l_reg, bf16x8& pa0, bf16x8& pa1, bf16x8& pa2, bf16x8& pa3) {
#pragma unroll
  for (int r = 0; r < 16; ++r) p1[r] = __builtin_amdgcn_exp2f(p1[r]);
  float ps = 0;
#pragma unroll
  for (int r = 0; r < 16; ++r) ps += p0[r];
#pragma unroll
  for (int r = 0; r < 16; ++r) ps += p1[r];
  { auto rr = __builtin_amdgcn_permlane32_swap(__float_as_uint(ps), __float_as_uint(ps), false, false);
    ps = __uint_as_float(rr[0]) + __uint_as_float(rr[1]); }
  l_reg = l_reg * alpha + ps;
#define PK4(P, BASE, OUT) do { unsigned a0 = cvt_pk_bf16(P[BASE + 0], P[BASE + 1]), a1 = cvt_pk_bf16(P[BASE + 2], P[BASE + 3]);   \
    unsigned b0 = cvt_pk_bf16(P[BASE + 4], P[BASE + 5]), b1 = cvt_pk_bf16(P[BASE + 6], P[BASE + 7]);                              \
    auto r0 = __builtin_amdgcn_permlane32_swap(a0, b0, false, false); auto r1 = __builtin_amdgcn_permlane32_swap(a1, b1, false, false); \
    u32x4 w = {r0[0], r1[0], r0[1], r1[1]}; OUT = *reinterpret_cast<bf16x8*>(&w); } while (0)
  PK4(p0, 0, pa0); PK4(p0, 8, pa1); PK4(p1, 0, pa2); PK4(p1, 8, pa3);
#undef PK4
}
__device__ __forceinline__ void qkt(f32x16& p0, f32x16& p1, const char* Ks, const bf16x8* qr, int r32, int hi) {
  p0 = f32x16{}; p1 = f32x16{};
#pragma unroll
  for (int d0 = 0; d0 < 6; ++d0) { int cb = (d0 * 16 + hi * 8) * 2;
    bf16x8 b0 = *reinterpret_cast<const bf16x8*>(Ks + KSWZ(r32, cb));
    bf16x8 b1 = *reinterpret_cast<const bf16x8*>(Ks + KSWZ(32 + r32, cb));
    p0 = __builtin_amdgcn_mfma_f32_32x32x16_bf16(b0, qr[d0], p0, 0, 0, 0);
    p1 = __builtin_amdgcn_mfma_f32_32x32x16_bf16(b1, qr[d0], p1, 0, 0, 0); }
}
__device__ __forceinline__ int v_st(int k, int c) { const int kk = (k & ~0xC) | ((k & 4) << 1) | ((k & 8) >> 1); return ((kk >> 3) * 4 + (c >> 5)) * 512 + ((kk & 7) * 32 + (c & 31)) * 2; }
__device__ __forceinline__ int v_rd_base(int lane) { return ((lane & 3) << 3) | (((lane >> 2) & 3) << 6) | (((lane >> 4) & 1) << 5) | (((lane >> 5) & 1) << 8); }
constexpr int v_rd_off(int d0, int ks, int half) { return d0 * 512 + ks * 4096 + half * 2048; }
template <int OFF> __device__ __forceinline__ s16x4 tr_read(int vb) {
  s16x4 r; asm volatile("ds_read_b64_tr_b16 %0, %1 offset:%2" : "=&v"(r) : "v"(vb), "i"(OFF) : "memory"); return r;
}
template <int D0> __device__ __forceinline__ void pv_one(f32x16& od, int vb, bf16x8 pa0, bf16x8 pa1, bf16x8 pa2, bf16x8 pa3) {
  const s16x4 l0 = tr_read<v_rd_off(D0, 0, 0)>(vb), h0 = tr_read<v_rd_off(D0, 0, 1)>(vb), l1 = tr_read<v_rd_off(D0, 1, 0)>(vb), h1 = tr_read<v_rd_off(D0, 1, 1)>(vb);
  const s16x4 l2 = tr_read<v_rd_off(D0, 2, 0)>(vb), h2 = tr_read<v_rd_off(D0, 2, 1)>(vb), l3 = tr_read<v_rd_off(D0, 3, 0)>(vb), h3 = tr_read<v_rd_off(D0, 3, 1)>(vb);
  asm volatile("s_waitcnt lgkmcnt(0)" ::: "memory"); SBAR();
#define PK(L, H) (bf16x8){L[0], L[1], L[2], L[3], H[0], H[1], H[2], H[3]}
  od = __builtin_amdgcn_mfma_f32_32x32x16_bf16(pa0, PK(l0, h0), od, 0, 0, 0);
  od = __builtin_amdgcn_mfma_f32_32x32x16_bf16(pa1, PK(l1, h1), od, 0, 0, 0);
  od = __builtin_amdgcn_mfma_f32_32x32x16_bf16(pa2, PK(l2, h2), od, 0, 0, 0);
  od = __builtin_amdgcn_mfma_f32_32x32x16_bf16(pa3, PK(l3, h3), od, 0, 0, 0);
#undef PK
}
__device__ __forceinline__ void pv_d0(f32x16* o, int vb, bf16x8 pa0, bf16x8 pa1, bf16x8 pa2, bf16x8 pa3) {
  pv_one<0>(o[0], vb, pa0, pa1, pa2, pa3); pv_one<1>(o[1], vb, pa0, pa1, pa2, pa3);
}
__device__ __forceinline__ void attn_unit(const bf16_t* __restrict__ Qb, const bf16_t* __restrict__ Kh, const bf16_t* __restrict__ Vh,
                                          bf16_t* __restrict__ Ob, int seq, char* lds) {
  int tid = threadIdx.x; asm volatile("" : "+v"(tid));
  const int wid = tid >> 6, lane = tid & 63, r32 = lane & 31, hi = lane >> 5;
  char* V_lds = lds; char* K_lds = lds + 2 * SHM_V;
  float* ws = (float*)(lds + 2 * SHM_V + 2 * SHM_K) + wid * 64; float* li_l = ws; float* al_l = ws + 32;
  float m_reg = -1e30f, l_reg = 0; f32x16 o[2] = {}; bf16x8 qr[6];
  const bf16_t* Qw = Qb + (long)(wid * QBLK + r32) * QLD + hi * 8;
#pragma unroll
  for (int d0 = 0; d0 < 6; ++d0) qr[d0] = *reinterpret_cast<const bf16x8*>(Qw + d0 * 16);
  const bool kld = wid < 6;
  const int ksr = tid / 12, ksc = (tid - ksr * 12) * 8;
  const int vsr = tid >> 3, vsc = (tid & 7) * 8, vst0 = v_st(vsr, vsc);
  const int vb0 = (int)(uintptr_t)V_lds + v_rd_base(lane);
  struct { bf16x8 vs0, ks0, ks1; } sr_[2];
#define SLOAD(i, k0) do { sr_[i].vs0 = *reinterpret_cast<const bf16x8*>(&Vh[(long)((k0) + vsr) * QLD + vsc]); \
    if (kld) { sr_[i].ks0 = *reinterpret_cast<const bf16x8*>(&Kh[(long)((k0) + ksr) * QLD + ksc]); sr_[i].ks1 = *reinterpret_cast<const bf16x8*>(&Kh[(long)((k0) + 32 + ksr) * QLD + ksc]); } } while (0)
#define SWRITE(b, i) do { *(bf16x8*)(V_lds + (b) * SHM_V + vst0) = sr_[i].vs0; \
    if (kld) { int kc = ksc * 2; *(bf16x8*)(K_lds + (b) * SHM_K + KSWZ(ksr, kc)) = sr_[i].ks0; *(bf16x8*)(K_lds + (b) * SHM_K + KSWZ(32 + ksr, kc)) = sr_[i].ks1; } } while (0)
#define SWAIT() asm volatile("s_waitcnt vmcnt(3)" ::: "memory")
#define RESC(a) do { if (__any((a) < 1.f)) { if (hi == 0) al_l[r32] = (a); asm volatile("s_waitcnt lgkmcnt(0)" ::: "memory"); \
    _Pragma("unroll") for (int d = 0; d < 2; ++d) _Pragma("unroll") for (int r = 0; r < 16; ++r) o[d][r] *= al_l[crow(r, hi)]; } } while (0)
  f32x16 pA0, pA1, pB0, pB1; float mnA, mnB, alA, alB; bf16x8 pa0, pa1, pa2, pa3; const int NT = seq / KVBLK;
  constexpr int SE = 0, SO = 1;
  SLOAD(SE, 0); asm volatile("s_waitcnt vmcnt(0)" ::: "memory"); SWRITE(0, SE); __syncthreads();
  qkt(pA0, pA1, K_lds, qr, r32, hi); partialSM(pA0, pA1, m_reg, mnA, alA);
  SLOAD(SO, KVBLK); if (2 < NT) SLOAD(SE, 2 * KVBLK);
  SWAIT(); SWRITE(1, SO); __syncthreads();
  for (int j = 1; j + 1 < NT; j += 2) {
    SBAR(); qkt(pB0, pB1, K_lds + SHM_K, qr, r32, hi);
    finishSM(pA0, pA1, alA, l_reg, pa0, pa1, pa2, pa3); SBAR();
    SLOAD(SO, (j + 2) * KVBLK); SBAR();
    pv_d0(o, vb0, pa0, pa1, pa2, pa3); partialSM(pB0, pB1, m_reg, mnB, alB);
    __syncthreads(); SWAIT(); SWRITE(0, SE);
    RESC(alB); __syncthreads();
    SBAR(); qkt(pA0, pA1, K_lds, qr, r32, hi);
    finishSM(pB0, pB1, alB, l_reg, pa0, pa1, pa2, pa3); SBAR();
    if (j + 3 < NT) SLOAD(SE, (j + 3) * KVBLK); SBAR();
    pv_d0(o, vb0 + (int)SHM_V, pa0, pa1, pa2, pa3); partialSM(pA0, pA1, m_reg, mnA, alA);
    __syncthreads(); SWAIT(); SWRITE(1, SO);
    RESC(alA); __syncthreads();
  }
  SBAR(); qkt(pB0, pB1, K_lds + SHM_K, qr, r32, hi);
  finishSM(pA0, pA1, alA, l_reg, pa0, pa1, pa2, pa3); SBAR();
  pv_d0(o, vb0, pa0, pa1, pa2, pa3); partialSM(pB0, pB1, m_reg, mnB, alB);
  __syncthreads(); RESC(alB);
  finishSM(pB0, pB1, alB, l_reg, pa0, pa1, pa2, pa3); SBAR();
  pv_d0(o, vb0 + (int)SHM_V, pa0, pa1, pa2, pa3);
  if (hi == 0) li_l[r32] = l_reg; asm volatile("s_waitcnt lgkmcnt(0)" ::: "memory");
  bf16_t* Ow = Ob + (long)(wid * QBLK) * 1024;
#pragma unroll
  for (int r = 0; r < 16; ++r) { const int orow = crow(r, hi); const float rl = __builtin_amdgcn_rcpf(li_l[orow]);
#pragma unroll
    for (int d0 = 0; d0 < 2; ++d0) Ow[(long)orow * 1024 + d0 * 32 + r32] = (bf16_t)(cvt_pk_bf16(o[d0][r] * rl, 0.f) & 0xffffu); }
#undef SLOAD
#undef SWRITE
#undef SWAIT
#undef RESC
}
}


#define XB_TMO      128
#define XB_XCNT(j)  (256  + 64 * (j))
#define XB_XSUB(j)  (1280 + 64 * (j))
#define XB_XGEN(j)  (2304 + 64 * (j))
#define XB_TOP      3328
#define XB_TOPGEN   3392
#define XCD_BAR_WORDS 3456
#define XB_SPIN_CAP (1u << 20)
__device__ __forceinline__ unsigned xb_ld(unsigned* p)              { return __hip_atomic_load(p, __ATOMIC_RELAXED, __HIP_MEMORY_SCOPE_AGENT); }
__device__ __forceinline__ unsigned xb_add(unsigned* p, unsigned v) { return __hip_atomic_fetch_add(p, v, __ATOMIC_RELAXED, __HIP_MEMORY_SCOPE_AGENT); }
__device__ __forceinline__ unsigned xb_xcc_id() { return (unsigned)__builtin_amdgcn_s_getreg((3 << 11) | 20) & 0xFu; }
#define XB_SPIN(cond, bar) do { unsigned _sp = 0; while (cond) { __builtin_amdgcn_s_sleep(1); \
    if ((++_sp & 255u) == 0u) { if (xb_ld(&(bar)[XB_TMO])) break; if (_sp > XB_SPIN_CAP) { atomicAdd(&(bar)[XB_TMO], 1u); break; } } } } while (0)
struct XcdBarrier { unsigned* bar; unsigned x; volatile LAS unsigned* st; };
__device__ __forceinline__ XcdBarrier xcd_barrier_post(unsigned* bar, volatile LAS unsigned* st) {
    XcdBarrier b; b.bar = bar; b.x = xb_xcc_id(); b.st = st;
    if (threadIdx.x == 0) (void)xb_add(&bar[XB_XCNT(b.x)], 1u);
    return b;
}
__device__ __forceinline__ void xcd_barrier_complete(unsigned* bar, unsigned x, unsigned& nloc, unsigned& nx) {
    const unsigned G = gridDim.x * gridDim.y * gridDim.z;
    unsigned sum, cnt, mine, sp = 0u;
    for (;;) {
        sum = 0u; cnt = 0u; mine = 0u;
#pragma unroll
        for (unsigned j = 0; j < 16; ++j) { const unsigned c = xb_ld(&bar[XB_XCNT(j)]); sum += c; cnt += (c > 0u) ? 1u : 0u; mine = (j == x) ? c : mine; }
        if (sum == G) break;
        __builtin_amdgcn_s_sleep(1);
        if ((++sp & 255u) == 0u) { if (xb_ld(&bar[XB_TMO])) break; if (sp > XB_SPIN_CAP) { atomicAdd(&bar[XB_TMO], 1u); break; } }
    }
    nloc = mine > 0u ? mine : 1u; nx = cnt > 0u ? cnt : 1u;
}
__device__ __forceinline__ void xcd_barrier(const XcdBarrier& b) {
    asm volatile("s_waitcnt vmcnt(0)" ::: "memory");
    __syncthreads();
    if (threadIdx.x == 0) {
        unsigned* bar = b.bar;
        __builtin_amdgcn_s_waitcnt(0);
        unsigned nloc = b.st[0], nx = b.st[1];
        if (nloc == 0u) { xcd_barrier_complete(bar, b.x, nloc, nx); b.st[0] = nloc; b.st[1] = nx; }
        const unsigned old = xb_add(&bar[XB_XSUB(b.x)], 1u);
        const unsigned gen = old / nloc;
        if (old + 1u == (gen + 1u) * nloc) {
            __builtin_amdgcn_fence(__ATOMIC_RELEASE, "agent");
            asm volatile("s_waitcnt vmcnt(0)" ::: "memory");
            const unsigned og = xb_add(&bar[XB_TOP], 1u);
            const unsigned tg = og / nx;
            if (og + 1u == (tg + 1u) * nx) xb_add(&bar[XB_TOPGEN], 1u);
            else XB_SPIN(xb_ld(&bar[XB_TOPGEN]) == tg, bar);
            __builtin_amdgcn_fence(__ATOMIC_ACQUIRE, "agent");
            xb_add(&bar[XB_XGEN(b.x)], 1u);
            asm volatile("s_waitcnt vmcnt(0)" ::: "memory");
        } else {
            XB_SPIN(xb_ld(&bar[XB_XGEN(b.x)]) == gen, bar);
            __builtin_amdgcn_fence(__ATOMIC_ACQUIRE, "agent");
            asm volatile("s_waitcnt vmcnt(0)" ::: "memory");
        }
    }
    __syncthreads();
}

constexpr int LDS_BYTES = 139264;
struct Args { const float* in[25]; float* out; unsigned char* ws; int ph_lo, ph_hi; };

__device__ __forceinline__ void tr_item(const float* W, int ldw, bf16_t* dst, int ldd, LAS float* scr, int lane) {
    float tv[32];
#pragma unroll
    for (int i = 0; i < 32; ++i) tv[i] = W[(size_t)(2 * i + (lane >> 5)) * ldw + (lane & 31)];
#pragma unroll
    for (int i = 0; i < 32; ++i) scr[(2 * i + (lane >> 5)) * 33 + (lane & 31)] = tv[i];
    asm volatile("s_waitcnt lgkmcnt(0)" ::: "memory");
    const int c = lane & 7;
#pragma unroll
    for (int j = 0; j < 4; ++j) { const int n = (lane >> 3) + 8 * j; const LAS float* s = scr + (8 * c) * 33 + n;
        u32x4 o; o.x = cvt_pk_bf16(s[0 * 33], s[1 * 33]); o.y = cvt_pk_bf16(s[2 * 33], s[3 * 33]); o.z = cvt_pk_bf16(s[4 * 33], s[5 * 33]); o.w = cvt_pk_bf16(s[6 * 33], s[7 * 33]);
        *(u32x4*)(dst + (size_t)n * ldd + 8 * c) = o; }
    asm volatile("s_waitcnt lgkmcnt(0)" ::: "memory");
}


struct P2Row { f32x4 q[3], k[3]; u32x2 v[2]; int kind, t, e; };
__device__ __forceinline__ f32x4 ld_bf4(const bf16_t* p) { const u32x2 w = *(const u32x2*)p; return (f32x4){bflo(w.x), bfhi(w.x), bflo(w.y), bfhi(w.y)}; }
__device__ __forceinline__ void p2_load(P2Row& r, int e, int j, int hh, int s, const bf16_t* QKV, const float* KROPE, const float* cache_kr) {
    const float* krp; r.e = e; r.t = 0;
    if (e < NCTX) { r.kind = 0; krp = KROPE + (size_t)e * 32; }
    else { const int b = (e - NCTX) / KVB, tt = (e - NCTX) - b * KVB;
        if (tt < LLAT) { r.kind = 1; r.t = tt; krp = KROPE + (size_t)(NCTX + b * LLAT + tt) * 32; }
        else { r.kind = 2; krp = cache_kr + (((size_t)b * 2 + j) * 512 + (tt - LLAT)) * 32; } }
    const bf16_t* raw = QKV + (size_t)e * QLD;
#pragma unroll
    for (int jj = 0; jj < 3; ++jj) r.q[jj] = ld_bf4(raw + hh * 96 + 4 * (s + 8 * jj));
#pragma unroll
    for (int jj = 0; jj < 2; ++jj) { r.k[jj] = ld_bf4(raw + 768 + hh * 128 + 4 * (s + 8 * jj)); r.v[jj] = *(const u32x2*)(raw + 768 + hh * 128 + 64 + 4 * (s + 8 * jj)); }
    r.k[2] = *(const f32x4*)(krp + 4 * s);
}
__device__ __forceinline__ void p2_compute(P2Row& r, int s, const float* qn, const float* kn, const float* ROPE) {
    float sq = 0.f, sk = 0.f;
#pragma unroll
    for (int jj = 0; jj < 3; ++jj) { sq += (r.q[jj][0] * r.q[jj][0] + r.q[jj][1] * r.q[jj][1]) + (r.q[jj][2] * r.q[jj][2] + r.q[jj][3] * r.q[jj][3]);
                                     sk += (r.k[jj][0] * r.k[jj][0] + r.k[jj][1] * r.k[jj][1]) + (r.k[jj][2] * r.k[jj][2] + r.k[jj][3] * r.k[jj][3]); }
    sq += __shfl_xor(sq, 1); sq += __shfl_xor(sq, 2); sq += __shfl_xor(sq, 4);
    sk += __shfl_xor(sk, 1); sk += __shfl_xor(sk, 2); sk += __shfl_xor(sk, 4);
    const float rq = 1.0f / sqrtf(sq * (1.0f / 96.0f) + EPS), rk = 1.0f / sqrtf(sk * (1.0f / 96.0f) + EPS);
#pragma unroll
    for (int jj = 0; jj < 3; ++jj) { r.q[jj] = r.q[jj] * rq * *(const f32x4*)(qn + 4 * (s + 8 * jj)); r.k[jj] = r.k[jj] * rk * *(const f32x4*)(kn + 4 * (s + 8 * jj)); }
    f32x4 qp, kp;
#pragma unroll
    for (int c = 0; c < 4; ++c) { qp[c] = __shfl_xor(r.q[2][c], 2); kp[c] = __shfl_xor(r.k[2][c], 2); }
    if (r.kind == 1) {
        const int a = s >> 2, fi0 = (s & 1) * 4; const bool second = (s & 2) != 0;
        const f32x4 cs = *(const f32x4*)(ROPE + (size_t)r.t * 16 + a * 8 + fi0), sn = *(const f32x4*)(ROPE + 65536 + (size_t)r.t * 16 + a * 8 + fi0);
        if (!second) { r.q[2] = r.q[2] * cs - qp * sn; r.k[2] = r.k[2] * cs - kp * sn; }
        else { r.q[2] = qp * sn + r.q[2] * cs; r.k[2] = kp * sn + r.k[2] * cs; }
    }
}
__device__ __forceinline__ void p2_store(const P2Row& r, int hh, int s, bf16_t* QKV) {
    bf16_t* orow = QKV + (size_t)r.e * QLD;
#pragma unroll
    for (int jj = 0; jj < 3; ++jj) {
        if (r.kind != 2) { u32x2 w; w.x = cvt_pk_bf16(r.q[jj][0], r.q[jj][1]); w.y = cvt_pk_bf16(r.q[jj][2], r.q[jj][3]); *(u32x2*)(orow + hh * 96 + 4 * (s + 8 * jj)) = w; }
        u32x2 w2; w2.x = cvt_pk_bf16(r.k[jj][0], r.k[jj][1]); w2.y = cvt_pk_bf16(r.k[jj][2], r.k[jj][3]); *(u32x2*)(orow + 768 + hh * 96 + 4 * (s + 8 * jj)) = w2; }
#pragma unroll
    for (int jj = 0; jj < 2; ++jj) *(u32x2*)(orow + 1536 + hh * 64 + 4 * (s + 8 * jj)) = r.v[jj];
}
struct P1Row { f32x4 q4, k4, r4; };
__device__ __forceinline__ void p1_load(P1Row& p, const float* pr, int lane) {
    p.q4 = *(const f32x4*)(pr + 4 * lane);
    p.k4 = (f32x4){0.f, 0.f, 0.f, 0.f}; if (lane < 32) p.k4 = *(const f32x4*)(pr + 256 + 4 * lane);
    p.r4 = (f32x4){0.f, 0.f, 0.f, 0.f}; if (lane < 8) p.r4 = *(const f32x4*)(pr + 384 + 4 * lane);
}
__device__ __forceinline__ void p1_finish(const P1Row& p, int r, int j, int lane, const float* qan, const float* kvan, bf16_t* QKVLAT, float* KROPE, float* OUT_CKV, float* OUT_KR) {
    const int e = r < NCTX ? r : NCTX + ((r - NCTX) >> 12) * KVB + ((r - NCTX) & 4095);
    const float ssq = wave_sum((p.q4[0] * p.q4[0] + p.q4[1] * p.q4[1]) + (p.q4[2] * p.q4[2] + p.q4[3] * p.q4[3]));
    const float ssk = wave_sum((p.k4[0] * p.k4[0] + p.k4[1] * p.k4[1]) + (p.k4[2] * p.k4[2] + p.k4[3] * p.k4[3]));
    const float rq = 1.0f / sqrtf(ssq * (1.0f / 256.0f) + EPS), rk = 1.0f / sqrtf(ssk * (1.0f / 128.0f) + EPS);
    const f32x4 qo = p.q4 * rq * *(const f32x4*)(qan + 4 * lane);
    u32x2 w; w.x = cvt_pk_bf16(qo[0], qo[1]); w.y = cvt_pk_bf16(qo[2], qo[3]); *(u32x2*)(QKVLAT + (size_t)e * 384 + 4 * lane) = w;
    if (lane < 32) { const f32x4 ko = p.k4 * rk * *(const f32x4*)(kvan + 4 * lane); u32x2 w2; w2.x = cvt_pk_bf16(ko[0], ko[1]); w2.y = cvt_pk_bf16(ko[2], ko[3]);
        *(u32x2*)(QKVLAT + (size_t)e * 384 + 256 + 4 * lane) = w2;
        if (r < NCTX) *(f32x4*)(OUT_CKV + (((size_t)(r >> 8) * 2 + j) * 256 + (r & 255)) * 128 + 4 * lane) = ko; }
    if (lane < 8) { *(f32x4*)(KROPE + (size_t)r * 32 + 4 * lane) = p.r4;
        if (r < NCTX) *(f32x4*)(OUT_KR + (((size_t)(r >> 8) * 2 + j) * 256 + (r & 255)) * 32 + 4 * lane) = p.r4; }
}

#define DERIVE_PTRS \
    unsigned char* ws = args.ws; \
    float* X = args.out; \
    float* OUT_CKV = args.out + (size_t)MTOK * 1024; float* OUT_KR = OUT_CKV + (size_t)32 * 2 * 256 * 128; \
    bf16_t* W13 = (bf16_t*)(ws + OFF_W13); bf16_t* W2 = (bf16_t*)(ws + OFF_W2); bf16_t* WIN = (bf16_t*)(ws + OFF_WIN); bf16_t* WQKV = (bf16_t*)(ws + OFF_WQKV); \
    bf16_t* WOUT = (bf16_t*)(ws + OFF_WOUT); bf16_t* POOLT = (bf16_t*)(ws + OFF_POOLT); bf16_t* WSB = (bf16_t*)(ws + OFF_WS); \
    float* MOD = (float*)(ws + OFF_MOD); float* ROPE = (float*)(ws + OFF_ROPE); \
    bf16_t* H = (bf16_t*)(ws + OFF_H); bf16_t* MIX = H; \
    unsigned char* R = ws + OFF_R; \
    bf16_t* U = (bf16_t*)(R + R_U); bf16_t* PB = (bf16_t*)R; bf16_t* H2 = (bf16_t*)R; \
    float* RSS = (float*)(ws + OFF_RSS); float* B13 = (float*)(ws + OFF_B13); float* BIN = (float*)(ws + OFF_BIN); float* VSS = (float*)(ws + OFF_VSS); \
    bf16_t* QKVLAT = (bf16_t*)(R + R_QKVLAT); float* KROPE = (float*)(R + R_KROPE); float* PROJ = (float*)(R + R_PROJ); \
    bf16_t* GM = (bf16_t*)(R + R_GM); float* QKVRAW = (float*)(R + R_QKVRAW); bf16_t* QKV = (bf16_t*)(R + R_QKVRAW);

__global__ void __launch_bounds__(512, 2) fwd_mega(Args args) {
    extern __shared__ __attribute__((aligned(16))) unsigned char lds[];
    cg::grid_group grid = cg::this_grid();
    int tid = threadIdx.x, lane = tid & 63, wave = __builtin_amdgcn_readfirstlane(tid >> 6);
    const int G = gridDim.x, bid = blockIdx.x;
    int gw = bid * 8 + wave; const int NGW = G * 8;
    long gt = (long)bid * 512 + tid; const long NGT = (long)G * 512;
    const int lo = args.ph_lo, hi = args.ph_hi;
    int pid = 0;
    unsigned* BARW = (unsigned*)(args.ws + OFF_CTL);
    volatile LAS unsigned* MISC = (volatile LAS unsigned*)((LAS unsigned char*)lds + 131072);
    if (tid < 16) MISC[tid] = 0u;
    if (bid == 0) for (int i = tid; i < XCD_BAR_WORDS; i += 512) BARW[i] = 0u;
    __syncthreads();
    XcdBarrier xbar; xbar.bar = BARW; xbar.x = 0; xbar.st = MISC;

    for (int rep0 = 0; rep0 < ((DUPMASK & 1) ? 2 : 1); ++rep0)
    if (EN_PRO && pid >= lo && pid < hi) {
        DERIVE_PTRS
        if (bid < 288) {
            LAS float* S = (LAS float*)lds; LAS float* P = (LAS float*)(lds + 36864);
            for (int idx = tid; idx < 9216; idx += 512) { const int cv = idx >> 10, k = idx & 1023; const float x = cv == 0 ? args.in[5][k] : args.in[4][(cv - 1) * 1024 + k]; S[idx] = x / (1.0f + expf(-x)); }
            __syncthreads();
            for (int item = bid; item < 288; item += G) {
                const int l = item / 72, cb = item % 72, j = tid & 127, s = tid >> 7;
                float acc[9];
#pragma unroll
                for (int cv = 0; cv < 9; ++cv) acc[cv] = 0.f;
                const float* wp = args.in[6] + ((size_t)l * 1024 + s * 256) * NMOD + cb * 128 + j;
                for (int k = 0; k < 256; k += 16) {
                    float wv[16];
#pragma unroll
                    for (int i = 0; i < 16; ++i) wv[i] = wp[(size_t)(k + i) * NMOD];
#pragma unroll
                    for (int cv = 0; cv < 9; ++cv) { const LAS float* sp = S + cv * 1024 + s * 256 + k;
#pragma unroll
                        for (int i = 0; i < 16; ++i) acc[cv] += sp[i] * wv[i]; }
                }
#pragma unroll
                for (int cv = 0; cv < 9; ++cv) P[(s * 9 + cv) * 128 + j] = acc[cv];
                __syncthreads();
                for (int idx = tid; idx < 1152; idx += 512) { const int cv = idx >> 7, jj = idx & 127;
                    const float v = P[(0 * 9 + cv) * 128 + jj] + P[(1 * 9 + cv) * 128 + jj] + P[(2 * 9 + cv) * 128 + jj] + P[(3 * 9 + cv) * 128 + jj] + args.in[7][l * NMOD + cb * 128 + jj];
                    MOD[((size_t)l * 9 + cv) * NMOD + cb * 128 + jj] = v; }
                __syncthreads();
            }
        }
        __syncthreads();
        {
            LAS float* scr = (LAS float*)(lds + 57344 + wave * 8448);
            for (int it0 = gw; it0 < 36832; it0 += NGW) {
                int it = it0; const float* src; int ldw, ldd; bf16_t* dst;
                if (it < 33792) { const int ls = it / 4224, r = it % 4224, which = r / 1408, q = r % 1408;
                    if (which < 2) { const int kb = q / 88, nb = q % 88, k0 = kb * 64, n0 = nb * 32; src = args.in[which ? 10 : 9] + (size_t)ls * 1024 * FF + (size_t)k0 * FF + n0; ldw = FF;
                        const int drow = (n0 >> 7) * 256 + (n0 & 127) + which * 128; dst = W13 + (size_t)ls * 5632 * 1024 + (size_t)drow * 1024 + k0; ldd = 1024; }
                    else { const int kb = q / 32, nb = q % 32, k0 = kb * 64, n0 = nb * 32; src = args.in[11] + (size_t)ls * FF * 1024 + (size_t)k0 * 1024 + n0; ldw = 1024;
                        dst = W2 + (size_t)ls * 1024 * FF + (size_t)n0 * FF + k0; ldd = FF; } }
                else { it -= 33792;
                if (it < 1440) { const int j = it / 720, q = it % 720, kb = q / 45, nb = q % 45, k0 = kb * 64, n0 = nb * 32; src = args.in[12] + (size_t)j * 1024 * 1440 + (size_t)k0 * 1440 + n0; ldw = 1440;
                    const int drow = n0 < 416 ? n0 : n0 + 96; dst = WIN + (size_t)j * 1536 * 1024 + (size_t)drow * 1024 + k0; ldd = 1024; }
                else { it -= 1440;
                if (it < 192) { const int j = it / 96, q = it % 96, kb = q / 24, nb = q % 24, k0 = kb * 64, n0 = nb * 32; src = args.in[15] + (size_t)j * 256 * 768 + (size_t)k0 * 768 + n0; ldw = 768;
                    dst = WQKV + (size_t)j * 1792 * 384 + (size_t)n0 * 384 + k0; ldd = 384; }
                else { it -= 192;
                if (it < 128) { const int j = it / 64, q = it % 64, kb = q / 32, nb = q % 32, k0 = kb * 64, n0 = nb * 32; src = args.in[16] + (size_t)j * 128 * 1024 + (size_t)k0 * 1024 + n0; ldw = 1024;
                    dst = WQKV + (size_t)j * 1792 * 384 + (size_t)(768 + n0) * 384 + 256 + k0; ldd = 384; }
                else { it -= 128;
                if (it < 1024) { const int j = it / 512, q = it % 512, kb = q / 32, nb = q % 32, k0 = kb * 64, n0 = nb * 32; src = args.in[22] + (size_t)j * 1024 * 1024 + (size_t)k0 * 1024 + n0; ldw = 1024;
                    dst = WOUT + (size_t)j * 1024 * 1024 + (size_t)n0 * 1024 + k0; ldd = 1024; }
                else { it -= 1024;
                    const int jg = it / 32, q = it % 32, kb = q / 8, nb = q % 8, k0 = kb * 64, n0 = nb * 32; src = args.in[23] + (size_t)jg * 65536 + (size_t)k0 * 256 + n0; ldw = 256;
                    dst = POOLT + (size_t)jg * 65536 + (size_t)n0 * 256 + k0; ldd = 256; } } } } }
                tr_item(src, ldw, dst, ldd, scr, lane);
            }
        }
        {
            const u32x4 z = {0u, 0u, 0u, 0u};
            for (long i = gt; i < 2 * 12288; i += NGT) { const int j = (int)(i / 12288); const long q = i % 12288; *(u32x4*)(WIN + (size_t)j * 1536 * 1024 + (size_t)416 * 1024 + q * 8) = z; }
            for (long i = gt; i < 2 * 45056; i += NGT) { const int j = (int)(i / 45056); const long q = i % 45056; bf16_t* base = WQKV + (size_t)j * 1792 * 384;
                if (q < 12288) { const int row = (int)(q >> 4), c = (int)(q & 15); *(u32x4*)(base + (size_t)row * 384 + 256 + c * 8) = z; }
                else { const long q2 = q - 12288; const int row = 768 + (int)(q2 >> 5), c = (int)(q2 & 31); *(u32x4*)(base + (size_t)row * 384 + c * 8) = z; } }
        }
        for (long i = gt; i < 131072 / 4; i += NGT) { const f32x4 v = *(const f32x4*)(args.in[20] + i * 4); u32x2 w; w.x = cvt_pk_bf16(v[0], v[1]); w.y = cvt_pk_bf16(v[2], v[3]); *(u32x2*)(WSB + i * 4) = w; }
        for (long i = gt; i < 65536; i += NGT) { const int t = (int)(i >> 4), ai = (int)(i & 15), a = ai >> 3, fi = ai & 7;
            const float inv = powf(10000.0f, -(float)(2 * fi) / 16.0f); const float pos = (float)(a == 0 ? (t >> 6) : (t & 63)); const float ang = pos * inv;
            ROPE[i] = cosf(ang); ROPE[65536 + i] = sinf(ang); }
        { const f32x4 z4 = {0.f, 0.f, 0.f, 0.f}; for (long i = gt; i < (long)12 * MTOK / 4; i += NGT) *(f32x4*)(RSS + i * 4) = z4;
          for (long i = gt; i < (long)2 * MTOK / 4; i += NGT) *(f32x4*)(VSS + i * 4) = z4; }
    }
    grid.sync();
    xbar = xcd_barrier_post(BARW, MISC);
    ++pid;
    for (int rep1 = 0; rep1 < ((DUPMASK & 2) ? 2 : 1); ++rep1)
    if (pid >= lo && pid < hi) {
        DERIVE_PTRS
        for (int ck = gw; ck < 8 * 176 + 2 * 48; ck += NGW) {
            const bf16_t* __restrict__ wbase; const float* shp; float* __restrict__ outp; int cvs;
            if (ck < 8 * 176) { const int ls = ck / 176, n0 = (ck - ls * 176) * 32, l = ls >> 1, sub = ls & 1; wbase = W13 + ((size_t)ls * 5632 + n0) * 1024;
                shp = MOD + (size_t)l * 9 * NMOD + (sub ? 6 : 0) * 1024; outp = B13 + (size_t)ls * 9 * 5632 + n0; cvs = 5632; }
            else { const int q = ck - 8 * 176, jj = q / 48, n0 = (q - jj * 48) * 32; wbase = WIN + ((size_t)jj * 1536 + n0) * 1024;
                shp = MOD + (size_t)(2 * jj) * 9 * NMOD + 3 * 1024; outp = BIN + (size_t)jj * 9 * 1536 + n0; cvs = 1536; }
            f32x4 sh[9][4];
#pragma unroll
            for (int cv = 0; cv < 9; ++cv) { const float* sp = shp + (size_t)cv * NMOD;
                sh[cv][0] = *(const f32x4*)(sp + lane * 8); sh[cv][1] = *(const f32x4*)(sp + lane * 8 + 4); sh[cv][2] = *(const f32x4*)(sp + 512 + lane * 8); sh[cv][3] = *(const f32x4*)(sp + 512 + lane * 8 + 4); }
#pragma unroll 2
            for (int r = 0; r < 32; ++r) {
                const u32x4 w0 = *(const u32x4*)(wbase + (size_t)r * 1024 + lane * 8), w1 = *(const u32x4*)(wbase + (size_t)r * 1024 + 512 + lane * 8);
                const f32x4 wa = {bflo(w0[0]), bfhi(w0[0]), bflo(w0[1]), bfhi(w0[1])}, wb = {bflo(w0[2]), bfhi(w0[2]), bflo(w0[3]), bfhi(w0[3])};
                const f32x4 wc2 = {bflo(w1[0]), bfhi(w1[0]), bflo(w1[1]), bfhi(w1[1])}, wd = {bflo(w1[2]), bfhi(w1[2]), bflo(w1[3]), bfhi(w1[3])};
                float res = 0.f;
#pragma unroll
                for (int cv = 0; cv < 9; ++cv) { const f32x4 p = sh[cv][0] * wa + sh[cv][1] * wb + sh[cv][2] * wc2 + sh[cv][3] * wd;
                    float a2 = (p[0] + p[1]) + (p[2] + p[3]); a2 = wave_sum(a2); if (lane == cv) res = a2; }
                if (lane < 9) outp[(size_t)lane * cvs + r] = res;
            }
        }
        for (int rb = gw; rb < MTOK; rb += 2 * NGW) {
            f32x4 v[2][4]; float ss[2]; int rr[2];
#pragma unroll
            for (int u2 = 0; u2 < 2; ++u2) { const int r = (rb + u2 * NGW < MTOK) ? rb + u2 * NGW : rb; rr[u2] = r;
                const float* xr = r < NCTX ? args.in[0] + (size_t)r * 1024 : args.in[1] + (size_t)(r - NCTX) * 1024; ss[u2] = 0.f;
#pragma unroll
                for (int q = 0; q < 4; ++q) { v[u2][q] = *(const f32x4*)(xr + 4 * lane + 256 * q); ss[u2] += (v[u2][q][0] * v[u2][q][0] + v[u2][q][1] * v[u2][q][1]) + (v[u2][q][2] * v[u2][q][2] + v[u2][q][3] * v[u2][q][3]); } }
#pragma unroll
            for (int u2 = 0; u2 < 2; ++u2) { if (u2 == 1 && rb + NGW >= MTOK) break; const int r = rr[u2]; const int cv = cv_of_row(r);
                const float* scp = MOD + (size_t)cv * NMOD + 1024; const float* gptr = args.in[8];
                const float st = wave_sum(ss[u2]); if (lane == 0) RSS[r] = st;
#pragma unroll
                for (int q = 0; q < 4; ++q) { const int c = 4 * lane + 256 * q; const f32x4 g4 = *(const f32x4*)(gptr + c), sc = *(const f32x4*)(scp + c);
                    *(f32x4*)(X + (size_t)r * 1024 + c) = v[u2][q];
                    const f32x4 hh = v[u2][q] * g4 * (sc + 1.0f); u32x2 w; w.x = cvt_pk_bf16(hh[0], hh[1]); w.y = cvt_pk_bf16(hh[2], hh[3]);
                    *(u32x2*)(H + (size_t)r * 1024 + c) = w; } }
        }
        if (pid + 1 < hi) xcd_barrier(xbar);
    }
    ++pid;

    for (int layer = 0; layer < 4; ++layer) {
        const int j = layer >> 1;
        const unsigned long long prog = (layer & 1) ? 0xDCFE32ull : 0xDCA9876532ull;
        const int nsteps = (layer & 1) ? 6 : 10;
        for (int step = 0; step < nsteps; ++step, ++pid) {
            if (!(pid >= lo && pid < hi)) continue;
            const int op = (int)((prog >> (4 * step)) & 15ull);
            const int reps = ((DUPMASK >> op) & 1) ? 2 : 1;
            for (int rep = 0; rep < reps; ++rep) {
            DERIVE_PTRS
            int bid = blockIdx.x; asm volatile("" : "+s"(bid)); int G = gridDim.x; asm volatile("" : "+s"(G));
            const int NGW = G * 8; const long NGT = (long)G * 512;
            const float* MODL = MOD + (size_t)layer * 9 * NMOD;
            tid = threadIdx.x; asm volatile("" : "+v"(tid)); lane = tid & 63; wave = __builtin_amdgcn_readfirstlane(tid >> 6); gw = bid * 8 + wave; gt = (long)bid * 512 + tid;
            if (EN_G1 && (op == 2 || op == 12)) {
                const int sub = op == 2 ? 0 : 1;
                const bf16_t* Ain = (sub == 1 && !(layer & 1)) ? H2 : H;
                pg8::Gemm g{Ain, W13 + (size_t)(layer * 2 + sub) * 5632 * 1024, MTOK, 5632, 1024, 1024, 1024, 0};
                pg8::StaticOrder S; S.init(MTOK, 5632, G, bid);
                pg8::EpiSwiglu E{U, RSS + (size_t)(layer * 3 + (sub ? 2 : 0)) * MTOK, B13 + (size_t)(layer * 2 + sub) * 9 * 5632};
                pg8::gemm_phase<pg8::EpiSwiglu>((LAS unsigned char*)lds, g, S, E);
            } else if (EN_GRES && (op == 3 || op == 13 || op == 10 || op == 15)) {
                const bf16_t* gA; const bf16_t* gB; int gK, glda, gldb, gapn; const float* egate; const float* escale; float ecoef;
                if (op == 3 || op == 13) { const int sub = op == 3 ? 0 : 1; gA = U; gB = W2 + (size_t)(layer * 2 + sub) * 1024 * FF; gK = FF; glda = FF; gldb = FF; gapn = 0;
                    egate = MODL + (sub ? 8 : 2) * 1024; escale = nullptr; ecoef = 0.5f; }
                else if (op == 10) { gA = MIX; gB = WOUT + (size_t)j * 1024 * 1024; gK = 1024; glda = 1024; gldb = 1024; gapn = 0; egate = MODL + 5 * 1024; escale = nullptr; ecoef = 1.0f; }
                else { gA = PB; gB = POOLT + (size_t)j * 1024 * 256; gK = 256; glda = 1024; gldb = 256; gapn = 512; egate = MODL + 5 * 1024; escale = args.in[24] + (size_t)j * 1024; ecoef = 1.0f; }
                int ln = layer, kn; bf16_t* an = H;
                if (op == 3) kn = 1; else if (op == 13) { ln = layer + 1; kn = 0; } else { kn = 2; if (op == 10) an = H2; }
                if (ln >= 4) { an = nullptr; ln = 0; }
                const pg8::Gemm g{gA, gB, MTOK, 1024, gK, glda, gldb, gapn};
                const pg8::EpiResid E{X, egate, escale, an, args.in[8] + ((size_t)ln * 3 + kn) * 1024, MOD + (size_t)ln * 9 * NMOD + (3 * kn + 1) * 1024, RSS + (size_t)(ln * 3 + kn) * MTOK, ecoef, 0};
                pg8::StaticOrder S; S.init(MTOK, 1024, G, bid, 1);
                pg8::gemm_phase<pg8::EpiResid, true>((LAS unsigned char*)lds, g, S, E);
            } else if (EN_GRAW && (op == 5 || op == 7)) {
                const bool gin = op == 5;
                const pg8::Gemm g{gin ? (const bf16_t*)H : (const bf16_t*)QKVLAT, gin ? WIN + (size_t)j * 1536 * 1024 : WQKV + (size_t)j * 1792 * 384, gin ? MTOK : MEXT, gin ? 1536 : 1792, gin ? 1024 : 384, gin ? 1024 : 384, gin ? 1024 : 384, 0};
                const pg8::EpiRaw E{PROJ, gin ? GM : QKV, gin ? RSS + (size_t)(layer * 3 + 1) * MTOK : (const float*)nullptr, BIN + (size_t)j * 9 * 1536, gin ? VSS + (size_t)j * MTOK : (float*)nullptr, 512, gin ? 2 : 0, gin ? 1024 : QLD, gin ? 1 : 0};
                pg8::StaticOrder S; S.init(gin ? MTOK : MEXT, gin ? 1536 : 1792, G, bid);
                pg8::gemm_phase<pg8::EpiRaw>((LAS unsigned char*)lds, g, S, E);
            } else if (EN_POST1 && op == 6) {
                {
                    LAS float* rs = (LAS float*)lds; LAS bf16_t* tT = (LAS bf16_t*)(lds + 1024);
                    const float* vn = args.in[19] + (size_t)j * 512; const float* gb = args.in[21] + (size_t)j * 512;
                    for (int item = bid; item < 1280; item += G) {
                        const int chunk = item >> 2, gq = item & 3; const size_t tok0 = (size_t)chunk * 128;
                        if (tid < 128) rs[tid] = __builtin_amdgcn_rsqf(VSS[(size_t)j * MTOK + tok0 + tid] * (1.0f / 512.0f) + EPS);
                        __syncthreads();
                        { const int q = tid >> 2, cp = tid & 3; const float rq = rs[q];
#pragma unroll
                          for (int cc = 0; cc < 4; ++cc) { const int c0 = cp * 32 + cc * 8; const u32x4 w = *(const u32x4*)(GM + (tok0 + q) * 1024 + 512 + gq * 128 + c0);
                              const f32x4 n0 = *(const f32x4*)(vn + gq * 128 + c0), n1 = *(const f32x4*)(vn + gq * 128 + c0 + 4);
                              float v[8] = {bflo(w[0]) * n0[0], bfhi(w[0]) * n0[1], bflo(w[1]) * n0[2], bfhi(w[1]) * n0[3], bflo(w[2]) * n1[0], bfhi(w[2]) * n1[1], bflo(w[3]) * n1[2], bfhi(w[3]) * n1[3]};
#pragma unroll
                              for (int e = 0; e < 8; ++e) tT[(c0 + e) * 136 + q] = (bf16_t)(cvt_pk_bf16(v[e] * rq, 0.f) & 0xffffu); } }
                        __syncthreads();
                        f32x4 acc[8];
#pragma unroll
                        for (int n = 0; n < 8; ++n) acc[n] = (f32x4){0.f, 0.f, 0.f, 0.f};
                        const bf16_t* wsp = WSB + ((size_t)(j * 4 + gq) * 128 + wave * 16 + (lane & 15)) * 128 + 8 * (lane >> 4);
#pragma unroll
                        for (int ks = 0; ks < 4; ++ks) { const bf16x8 a = *(const bf16x8*)(wsp + 32 * ks);
#pragma unroll
                            for (int n = 0; n < 8; ++n) { const bf16x8 b = *(const LAS bf16x8*)(tT + (16 * n + (lane & 15)) * 136 + 32 * ks + 8 * (lane >> 4));
                                acc[n] = __builtin_amdgcn_mfma_f32_16x16x32_bf16(b, a, acc[n], 0, 0, 0); } }
                        { const int p = wave * 16 + (lane & 15); const size_t tok = tok0 + p; const float bsp = gb[gq * 128 + p];
                          u32x2 uu[8];
#pragma unroll
                          for (int n = 0; n < 8; ++n) uu[n] = *(const u32x2*)(GM + tok * 1024 + gq * 128 + 16 * n + 4 * (lane >> 4));
#pragma unroll
                          for (int n = 0; n < 8; ++n) { u32x2 w; w.x = cvt_pk_bf16(bflo(uu[n].x) * (acc[n][0] + bsp), bfhi(uu[n].x) * (acc[n][1] + bsp)); w.y = cvt_pk_bf16(bflo(uu[n].y) * (acc[n][2] + bsp), bfhi(uu[n].y) * (acc[n][3] + bsp));
                              *(u32x2*)(MIX + tok * 1024 + 512 + gq * 128 + 16 * n + 4 * (lane >> 4)) = w; } }
                        __syncthreads();
                    }
                }
                const float* qan = args.in[13] + (size_t)j * 256; const float* kvan = args.in[14] + (size_t)j * 128;
                for (int r = gw; r < MTOK; r += 2 * NGW) {
                    const int r1 = r + NGW; const bool has1 = r1 < MTOK;
                    P1Row p0, p1; p1_load(p0, PROJ + (size_t)r * 512, lane); p1_load(p1, PROJ + (size_t)(has1 ? r1 : r) * 512, lane);
                    p1_finish(p0, r, j, lane, qan, kvan, QKVLAT, KROPE, OUT_CKV, OUT_KR); if (has1) p1_finish(p1, r1, j, lane, qan, kvan, QKVLAT, KROPE, OUT_CKV, OUT_KR);
                }
                for (int cidx = gw; cidx < 4096; cidx += NGW) {
                    const int b = cidx >> 9, p = cidx & 511; const int e = NCTX + b * KVB + LLAT + p;
                    const u32x2 z = {0u, 0u}; *(u32x2*)(QKVLAT + (size_t)e * 384 + 4 * lane) = z;
                    if (lane < 32) { const f32x4 kv = *(const f32x4*)(args.in[2] + (((size_t)b * 2 + j) * 512 + p) * 128 + 4 * lane); u32x2 w2; w2.x = cvt_pk_bf16(kv[0], kv[1]); w2.y = cvt_pk_bf16(kv[2], kv[3]);
                        *(u32x2*)(QKVLAT + (size_t)e * 384 + 256 + 4 * lane) = w2; }
                }
            } else if (EN_POST2 && op == 8) {
                const float* qn = args.in[17] + (size_t)j * 96; const float* kn = args.in[18] + (size_t)j * 96;
                const int hh = lane >> 3, s = lane & 7;
                for (int e = gw; e < MEXT; e += 2 * NGW) {
                    const int e1 = e + NGW; const bool has1 = e1 < MEXT;
                    P2Row r0, r1;
                    p2_load(r0, e, j, hh, s, QKV, KROPE, args.in[3]); p2_load(r1, has1 ? e1 : e, j, hh, s, QKV, KROPE, args.in[3]);
                    p2_compute(r0, s, qn, kn, ROPE); p2_compute(r1, s, qn, kn, ROPE);
                    asm volatile("s_waitcnt vmcnt(0)" ::: "memory");
                    p2_store(r0, hh, s, QKV); if (has1) p2_store(r1, hh, s, QKV);
                    asm volatile("" ::: "memory");
                }
            } else if (EN_ATT && op == 9) {
                const int vcu = (G % 8 == 0) ? (bid % 8) * (G / 8) + bid / 8 : bid;
                for (int u = vcu; u < 1280; u += G) {
                    const bf16_t *Qb, *Kh, *Vh; bf16_t* Ob; int seq;
                    if (u < 1024) { const int bh = u >> 4, qt = u & 15, b = bh >> 3, h = bh & 7; const size_t e0 = NCTX + (size_t)b * KVB;
                        Qb = QKV + (e0 + qt * 256) * QLD + h * 96; Kh = QKV + e0 * QLD + 768 + h * 96; Vh = QKV + e0 * QLD + 1536 + h * 64;
                        Ob = MIX + ((size_t)NCTX + (size_t)b * LLAT + qt * 256) * 1024 + h * 64; seq = KVB; }
                    else { const int vv = u - 1024, b = vv >> 3, h = vv & 7; const size_t e0 = (size_t)b * 256;
                        Qb = QKV + e0 * QLD + h * 96; Kh = QKV + e0 * QLD + 768 + h * 96; Vh = QKV + e0 * QLD + 1536 + h * 64; Ob = MIX + e0 * 1024 + h * 64; seq = 256; }
                    __syncthreads();
                    att::attn_unit(Qb, Kh, Vh, Ob, seq, (char*)lds);
                }
            } else if (EN_POOL && op == 14) {
                const float* rs = RSS + (size_t)(layer * 3 + 1) * MTOK;
                for (long i = gt; i < (long)(MTOK / 32) * 128; i += NGT) {
                    const int seg = (int)(i >> 7), ch = (int)(i & 127), hw = 1 << (ch >> 5);
                    const int r0 = seg * 32; int t0, L; if (r0 < NCTX) { t0 = r0 & 255; L = 256; } else { t0 = (r0 - NCTX) & 4095; L = 4096; }
                    const int base = r0 - t0; const bf16_t* __restrict__ hp = H + (size_t)base * 1024 + ch * 8; const float* __restrict__ rsp = rs + base; bf16_t* __restrict__ pbp = PB + (size_t)base * 1024 + ch * 8;
                    float sum[8];
#pragma unroll
                    for (int e2 = 0; e2 < 8; ++e2) sum[e2] = 0.f;
#define POOL_LD(tt, wgt) do { const u32x4 w_ = *(const u32x4*)(hp + (size_t)(tt) * 1024); const float q_ = (wgt) * __builtin_amdgcn_rsqf(rsp[tt] * (1.0f / 1024.0f) + EPS); \
                        _Pragma("unroll") for (int e2 = 0; e2 < 4; ++e2) { sum[2 * e2] += bflo(w_[e2]) * q_; sum[2 * e2 + 1] += bfhi(w_[e2]) * q_; } } while (0)
#pragma unroll
                    for (int i2 = 0; i2 < 16; ++i2) { const int tt = t0 - hw + i2; const bool ok = (i2 < 2 * hw) && tt >= 0; const int tc = tt < 0 ? 0 : (tt > L - 1 ? L - 1 : tt); POOL_LD(tc, ok ? 1.0f : 0.0f); }
#pragma unroll 4
                    for (int t = t0; t < t0 + 32; ++t) {
                        const int lo2 = t - hw < 0 ? 0 : t - hw, hi2 = t + hw > L ? L : t + hw; const float inv = 1.0f / (float)(hi2 - lo2);
                        const u32x4 w0 = *(const u32x4*)(hp + (size_t)t * 1024); const float q0 = __builtin_amdgcn_rsqf(rsp[t] * (1.0f / 1024.0f) + EPS); u32x4 o;
#pragma unroll
                        for (int e2 = 0; e2 < 4; ++e2) o[e2] = cvt_pk_bf16(sum[2 * e2] * inv - bflo(w0[e2]) * q0, sum[2 * e2 + 1] * inv - bfhi(w0[e2]) * q0);
                        *(u32x4*)(pbp + (size_t)t * 1024) = o;
                        { const int tp = t + hw, tm = t - hw; const int tpc = tp > L - 1 ? L - 1 : tp, tmc = tm < 0 ? 0 : tm;
                          POOL_LD(tpc, tp < L ? 1.0f : 0.0f); POOL_LD(tmc, tm >= 0 ? -1.0f : 0.0f); }
                    }
#undef POOL_LD
                }
            }
            if (rep + 1 < reps || pid + 1 < hi) xcd_barrier(xbar);
            }
        }
    }
}

extern "C" void kernel_launch(void* const* d_in, const int* in_sizes, int n_in, void* d_out, int out_size, void* d_ws, size_t ws_size, hipStream_t stream) {
    static int grid = 0;
    if (grid == 0) {
        if (n_in != 25 || ws_size < WS_NEED) { fprintf(stderr, "kernel_launch: n_in %d ws %zu (need %zu)\n", n_in, ws_size, (size_t)WS_NEED); grid = -1; return; }
        int dev = 0, cus = 0, per_cu = 0;
        hipGetDevice(&dev); hipDeviceGetAttribute(&cus, hipDeviceAttributeMultiprocessorCount, dev);
        if (hipFuncSetAttribute((const void*)fwd_mega, hipFuncAttributeMaxDynamicSharedMemorySize, LDS_BYTES) != hipSuccess) { fprintf(stderr, "kernel_launch: hipFuncSetAttribute failed\n"); grid = -1; return; }
        if (hipOccupancyMaxActiveBlocksPerMultiprocessor(&per_cu, (const void*)fwd_mega, 512, LDS_BYTES) != hipSuccess || per_cu < 1) { fprintf(stderr, "kernel_launch: occupancy query gave %d\n", per_cu); per_cu = 1; }
        (void)hipGetLastError();
        grid = cus * per_cu;
    }
    if (grid < 0) return;
    Args a{};
    for (int i = 0; i < 25; ++i) a.in[i] = (const float*)d_in[i];
    a.out = (float*)d_out; a.ws = (unsigned char*)d_ws; a.ph_lo = 0; a.ph_hi = 34;
    void* kargs[] = {&a};
    hipError_t e = hipLaunchCooperativeKernel((const void*)fwd_mega, dim3(grid), dim3(512), kargs, LDS_BYTES, stream);
    if (e != hipSuccess) fprintf(stderr, "kernel_launch: cooperative launch failed: %s (grid %d)\n", hipGetErrorString(e), grid);
}
```

```cpp
#include <hip/hip_runtime.h>
#include <hip/hip_cooperative_groups.h>
#include <cstdio>
#include <cstdint>
namespace cg = cooperative_groups;
#ifndef EN_NORM
#define EN_NORM 1
#endif
#ifndef EN_G1
#define EN_G1 1
#endif
#ifndef EN_GRES
#define EN_GRES 1
#endif
#ifndef EN_GRAW
#define EN_GRAW 1
#endif
#ifndef EN_POST1
#define EN_POST1 1
#endif
#ifndef EN_POST2
#define EN_POST2 1
#endif
#ifndef EN_ATT
#define EN_ATT 1
#endif
#ifndef EN_POOL
#define EN_POOL 1
#endif
#ifndef EN_PRO
#define EN_PRO 1
#endif
#ifndef DUPMASK
#define DUPMASK 0
#endif

#define LAS __attribute__((address_space(3)))
typedef unsigned short bf16_t;
typedef short bf16x8 __attribute__((ext_vector_type(8)));
typedef short s16x4 __attribute__((ext_vector_type(4)));
typedef float f32x4 __attribute__((ext_vector_type(4)));
typedef float f32x16 __attribute__((ext_vector_type(16)));
typedef unsigned u32x4 __attribute__((ext_vector_type(4)));
typedef unsigned u32x2 __attribute__((ext_vector_type(2)));

constexpr int DM = 1024, FF = 2816, MTOK = 40960, MEXT = 45056, NCTX = 8192, LLAT = 4096, PAST = 512, KVB = 4608;
constexpr int NMOD = 9216;
constexpr int QLD = 2048;
constexpr float EPS = 1e-6f;
constexpr size_t SZ_W13 = (size_t)8 * 5632 * 1024 * 2, SZ_W2 = (size_t)8 * 1024 * 2816 * 2, SZ_WIN = (size_t)2 * 1536 * 1024 * 2,
                 SZ_WQKV = (size_t)2 * 1792 * 384 * 2, SZ_WOUT = (size_t)2 * 1024 * 1024 * 2, SZ_POOLT = (size_t)2 * 1024 * 256 * 2,
                 SZ_WS = (size_t)2 * 4 * 128 * 128 * 2, SZ_MOD = (size_t)4 * 9 * NMOD * 4, SZ_ROPE = (size_t)2 * 4096 * 16 * 4,
                 SZ_H = (size_t)MTOK * 1024 * 2;
constexpr size_t OFF_W13 = 0, OFF_W2 = OFF_W13 + SZ_W13, OFF_WIN = OFF_W2 + SZ_W2, OFF_WQKV = OFF_WIN + SZ_WIN, OFF_WOUT = OFF_WQKV + SZ_WQKV,
                 OFF_POOLT = OFF_WOUT + SZ_WOUT, OFF_WS = OFF_POOLT + SZ_POOLT, OFF_MOD = OFF_WS + SZ_WS, OFF_ROPE = OFF_MOD + SZ_MOD,
                 OFF_H = OFF_ROPE + SZ_ROPE, OFF_R = OFF_H + SZ_H;
constexpr size_t R_QKVLAT = 0, R_KROPE = (size_t)MEXT * 384 * 2, R_PROJ = 41943040, R_GM = R_PROJ + (size_t)MTOK * 512 * 4,
                 R_QKVRAW = R_PROJ, SZ_R = SZ_H + (size_t)MTOK * 2816 * 2;
static_assert(R_KROPE + (size_t)MTOK * 32 * 4 <= R_PROJ, "ws map");
static_assert(R_QKVRAW + (size_t)MEXT * QLD * 2 <= SZ_R, "ws map");
constexpr size_t OFF_CTL = OFF_R + SZ_R, SZ_CTL = 16384;
constexpr size_t OFF_RSS = OFF_CTL + SZ_CTL, SZ_RSS = (size_t)12 * MTOK * 4;
constexpr size_t OFF_B13 = OFF_RSS + SZ_RSS, SZ_B13 = (size_t)8 * 9 * 5632 * 4;
constexpr size_t OFF_BIN = OFF_B13 + SZ_B13, SZ_BIN = (size_t)2 * 9 * 1536 * 4;
constexpr size_t R_U = SZ_H;
static_assert(R_U + (size_t)MTOK * 2816 * 2 <= SZ_R, "ws map");
constexpr size_t OFF_VSS = OFF_BIN + SZ_BIN, SZ_VSS = (size_t)2 * MTOK * 4;
constexpr size_t WS_NEED = OFF_VSS + SZ_VSS;

__device__ __forceinline__ unsigned cvt_pk_bf16(float lo, float hi) { unsigned r; asm volatile("v_cvt_pk_bf16_f32 %0, %1, %2" : "=v"(r) : "v"(lo), "v"(hi)); return r; }
__device__ __forceinline__ float bf2f(unsigned short b) { return __uint_as_float(((unsigned)b) << 16); }
__device__ __forceinline__ float bflo(unsigned w) { return __uint_as_float(w << 16); }
__device__ __forceinline__ float bfhi(unsigned w) { return __uint_as_float(w & 0xffff0000u); }
__device__ __forceinline__ float wave_sum(float v) {
#pragma unroll
    for (int o = 1; o < 64; o <<= 1) v += __shfl_xor(v, o);
    return v;
}
__device__ __forceinline__ float fast_sigmoid(float x) { return __builtin_amdgcn_rcpf(1.0f + __builtin_amdgcn_exp2f(-1.4426950408889634f * x)); }
__device__ __forceinline__ float silu_f(float x) { return x * fast_sigmoid(x); }
__device__ __forceinline__ float gelu_tanh_f(float x) { const float y = 0.7978845608028654f * (x + 0.044715f * x * x * x); return x * fast_sigmoid(2.0f * y); }
__device__ __forceinline__ f32x4 sigmoid4(f32x4 x) {
    const f32x4 t = x * -1.4426950408889634f; f32x4 e;
#pragma unroll
    for (int i = 0; i < 4; ++i) e[i] = __builtin_amdgcn_exp2f(t[i]);
    const f32x4 d = e + 1.0f; f32x4 r;
#pragma unroll
    for (int i = 0; i < 4; ++i) r[i] = __builtin_amdgcn_rcpf(d[i]);
    return r;
}
__device__ __forceinline__ f32x4 silu4(f32x4 x) { return x * sigmoid4(x); }
__device__ __forceinline__ f32x4 gelu_tanh4(f32x4 x) { const f32x4 y = (x + x * x * x * 0.044715f) * (2.0f * 0.7978845608028654f); return x * sigmoid4(y); }
__device__ __forceinline__ int cv_of_row(int r) { return r < NCTX ? 0 : 1 + ((r - NCTX) >> 12); }

#ifndef PROBE_KREP
#define PROBE_KREP 1
#endif
namespace pg8 {
constexpr int BM = 256, BK = 64, HALF = 128, HTB = HALF * BK * 2, STAGE_BYTES = 8 * HTB, NXCD = 8, WGM = 8;
__host__ __device__ __forceinline__ int lds_byte(int r, int c) { const int st = (r >> 4) * 2 + (c >> 5), rr = r & 15, cc = c & 31, ob = rr * 64 + cc * 2; return st * 1024 + (ob ^ (((ob >> 9) & 1) << 5)); }
__host__ __device__ __forceinline__ void stage_rc(int b, int& R, int& C) { const int st = b / 1024, sb = b % 1024, swz = sb ^ (((sb >> 9) & 1) << 5); R = (st >> 1) * 16 + swz / 64; C = (st & 1) * 32 + (swz % 64) / 2; }
__host__ __device__ __forceinline__ int perm32(int rho) { const int n = rho >> 4, i = rho & 15; return 8 * (i >> 2) + 4 * n + (i & 3); }

struct Unit { int pm, pn, half; };
struct Gemm { const bf16_t* A; const bf16_t* Bt; int M, N, K, lda, ldb, apn; };

struct StaticOrder {
    int nM, nN, nwg, G, c, ht;
    __device__ void init(int M, int N, int G_, int c_, int ht_ = 0) { nM = M / BM; nN = N / BM; nwg = nM * nN; G = G_; c = c_; ht = ht_; }
    __device__ bool next(int i, Unit& u) const {
        long L = (long)i * G + c; u.half = -1;
        if (ht) { const int nfull = nwg / G, rem = nwg - nfull * G;
            if (rem > 0 && 2 * rem <= G && i >= nfull) { if (i > nfull || (c >> 1) >= rem) return false; L = (long)nfull * G + (c >> 1); u.half = c & 1; } }
        if (L >= nwg) return false;
        int wgid = (int)L; { const int q = nwg / NXCD, r = nwg % NXCD, xcd = wgid % NXCD, off = wgid / NXCD; wgid = (xcd < r ? xcd * (q + 1) : r * (q + 1) + (xcd - r) * q) + off; }
        const int nig = WGM * nN, gid = wgid / nig, fm = gid * WGM, gsz = (nM - fm) < WGM ? (nM - fm) : WGM;
        u.pm = fm + ((wgid % nig) % gsz); u.pn = (wgid % nig) / gsz; return true;
    }
};

struct EpiSwiglu {
    static constexpr bool PERM = true; static constexpr int KREP = PROBE_KREP;
    bf16_t* U; const float* rss; const float* bias;
    static constexpr bool PREF = true;
    __device__ __forceinline__ bool pref_on() const { return true; }
    __device__ __forceinline__ const float* pref_ptr(const Unit& u, int tid) const { const int cv = u.pm < 32 ? 0 : 1 + ((u.pm - 32) >> 4);
        return tid < 256 ? rss + u.pm * BM + tid : bias + (size_t)cv * 5632 + u.pn * BM + (tid - 256); }
    __device__ __forceinline__ void run(f32x4 (&acc)[2][2][4][2], const Unit& u, int wr, int wc, int fr, int fq, const LAS float* sc) const {
        const int row0 = u.pm * BM + wr * 64 + fr, col0 = u.pn * HALF + wc * 32 + 8 * fq;
        const LAS float* bp = sc + 256 + wc * 32 + 8 * fq;
        const f32x4 ba0 = *(const LAS f32x4*)(bp), ba1 = *(const LAS f32x4*)(bp + 4), bb0 = *(const LAS f32x4*)(bp + HALF), bb1 = *(const LAS f32x4*)(bp + HALF + 4);
#pragma unroll
        for (int ai = 0; ai < 2; ++ai)
#pragma unroll
            for (int m = 0; m < 4; ++m) {
                const int row = row0 + ai * HALF + m * 16;
                bf16_t* rowp = U + (size_t)row * FF + col0;
                const float rstd = (1.0f / (float)KREP) * __builtin_amdgcn_rsqf(sc[ai * HALF + wr * 64 + m * 16 + fr] * (1.0f / 1024.0f) + EPS);
                const f32x4 a0 = acc[ai][0][m][0] * rstd + ba0, a1 = acc[ai][0][m][1] * rstd + ba1, b0 = acc[ai][1][m][0] * rstd + bb0, b1 = acc[ai][1][m][1] * rstd + bb1;
                const f32x4 v0 = silu4(a0) * b0, v1 = silu4(a1) * b1;
                u32x4 w; w.x = cvt_pk_bf16(v0[0], v0[1]); w.y = cvt_pk_bf16(v0[2], v0[3]); w.z = cvt_pk_bf16(v1[0], v1[1]); w.w = cvt_pk_bf16(v1[2], v1[3]);
                *(u32x4*)rowp = w;
            }
    }
};
struct EpiResid {
    static constexpr bool PERM = true; static constexpr int KREP = 1;
    float* X; const float* gate; const float* scale;
    bf16_t* An; const float* gn; const float* scn; float* rssn;
    float coef; int pad_;
    static constexpr bool PREF = false;
    __device__ __forceinline__ bool pref_on() const { return false; }
    __device__ __forceinline__ const float* pref_ptr(const Unit&, int) const { return nullptr; }
    __device__ __forceinline__ void run(f32x4 (&acc)[2][2][4][2], const Unit& u, int wr, int wc, int fr, int fq, const LAS float*) const {
        const int row0 = u.pm * BM + wr * 64 + fr; int col0 = u.pn * BM + wc * 32 + 8 * fq;
        const int cv = u.pm < 32 ? 0 : 1 + ((u.pm - 32) >> 4);
        const bool nx = An != nullptr;
        const int hb = u.half > 0 ? HALF : 0, nbj = u.half < 0 ? 2 : 1;
        col0 += hb;
        f32x4 gv[2][2], gm[2][2];
#pragma unroll
        for (int bj = 0; bj < 2; ++bj)
#pragma unroll
            for (int n = 0; n < 2; ++n) { const int c = col0 + (bj < nbj ? bj : 0) * HALF + 4 * n; f32x4 g = *(const f32x4*)(gate + (size_t)cv * NMOD + c) * coef;
                if (scale) g = g * *(const f32x4*)(scale + c); gv[bj][n] = g;
                gm[bj][n] = nx ? *(const f32x4*)(gn + c) * (*(const f32x4*)(scn + (size_t)cv * NMOD + c) + 1.0f) : (f32x4){0.f, 0.f, 0.f, 0.f}; }
#pragma unroll
        for (int ai = 0; ai < 2; ++ai)
#pragma unroll
            for (int m = 0; m < 4; ++m) { const int row = row0 + ai * HALF + m * 16; float* rowp = X + (size_t)row * DM + col0;
                float ss = 0.f;
#pragma unroll
                for (int bj = 0; bj < 2; ++bj) if (bj < nbj) { f32x4* p = (f32x4*)(rowp + bj * HALF);
                    const f32x4 x0 = __builtin_nontemporal_load(p) + acc[ai][bj][m][0] * gv[bj][0], x1 = __builtin_nontemporal_load(p + 1) + acc[ai][bj][m][1] * gv[bj][1];
                    __builtin_nontemporal_store(x0, p); __builtin_nontemporal_store(x1, p + 1);
                    if (nx) { ss += ((x0[0] * x0[0] + x0[1] * x0[1]) + (x0[2] * x0[2] + x0[3] * x0[3])) + ((x1[0] * x1[0] + x1[1] * x1[1]) + (x1[2] * x1[2] + x1[3] * x1[3]));
                        const f32x4 a0 = x0 * gm[bj][0], a1 = x1 * gm[bj][1]; u32x4 w; w.x = cvt_pk_bf16(a0[0], a0[1]); w.y = cvt_pk_bf16(a0[2], a0[3]); w.z = cvt_pk_bf16(a1[0], a1[1]); w.w = cvt_pk_bf16(a1[2], a1[3]);
                        *(u32x4*)(An + (size_t)row * DM + col0 + bj * HALF) = w; } }
                if (nx) { ss += __shfl_xor(ss, 16); ss += __shfl_xor(ss, 32);
                    if (fq == 0) (void)__hip_atomic_fetch_add(rssn + row, ss, __ATOMIC_RELAXED, __HIP_MEMORY_SCOPE_AGENT); } }
    }
};
struct EpiRaw {
    static constexpr bool PERM = true; static constexpr int KREP = 1;
    float* R; bf16_t* G; const float* rss; const float* bias; float* vss; int ldr, nraw, ldg, act;
    static constexpr bool PREF = true;
    __device__ __forceinline__ bool pref_on() const { return rss != nullptr; }
    __device__ __forceinline__ const float* pref_ptr(const Unit& u, int tid) const { const int cv = u.pm < 32 ? 0 : 1 + ((u.pm - 32) >> 4);
        return tid < 256 ? rss + u.pm * BM + tid : bias + (size_t)cv * 1536 + u.pn * BM + (tid - 256); }
    __device__ __forceinline__ void run(f32x4 (&acc)[2][2][4][2], const Unit& u, int wr, int wc, int fr, int fq, const LAS float* sc) const {
        const int row0 = u.pm * BM + wr * 64 + fr, cw = wc * 32 + 8 * fq;
        if (rss) {
            f32x4 bv[2][2];
#pragma unroll
            for (int bj = 0; bj < 2; ++bj)
#pragma unroll
                for (int n = 0; n < 2; ++n) bv[bj][n] = *(const LAS f32x4*)(sc + 256 + cw + bj * HALF + 4 * n);
#pragma unroll
            for (int ai = 0; ai < 2; ++ai)
#pragma unroll
                for (int m = 0; m < 4; ++m) { const float rstd = __builtin_amdgcn_rsqf(sc[ai * HALF + wr * 64 + m * 16 + fr] * (1.0f / 1024.0f) + EPS);
#pragma unroll
                    for (int bj = 0; bj < 2; ++bj)
#pragma unroll
                        for (int n = 0; n < 2; ++n) acc[ai][bj][m][n] = acc[ai][bj][m][n] * rstd + bv[bj][n]; }
        }
        if (u.pn < nraw) {
#pragma unroll
            for (int ai = 0; ai < 2; ++ai)
#pragma unroll
                for (int m = 0; m < 4; ++m) { float* rowp = R + (size_t)(row0 + ai * HALF + m * 16) * ldr + u.pn * BM + cw;
#pragma unroll
                    for (int bj = 0; bj < 2; ++bj) { *(f32x4*)(rowp + bj * HALF) = acc[ai][bj][m][0]; *(f32x4*)(rowp + bj * HALF + 4) = acc[ai][bj][m][1]; } }
        } else {
            const bool dovs = vss != nullptr && (u.pn - nraw) >= 2;
#pragma unroll
            for (int ai = 0; ai < 2; ++ai)
#pragma unroll
                for (int m = 0; m < 4; ++m) { bf16_t* rowp = G + (size_t)(row0 + ai * HALF + m * 16) * ldg + (u.pn - nraw) * BM + cw; float vs = 0.f;
#pragma unroll
                    for (int bj = 0; bj < 2; ++bj) { f32x4 v0 = acc[ai][bj][m][0], v1 = acc[ai][bj][m][1];
                        if (act) { v0 = gelu_tanh4(v0); v1 = gelu_tanh4(v1); }
                        vs += ((v0[0] * v0[0] + v0[1] * v0[1]) + (v0[2] * v0[2] + v0[3] * v0[3])) + ((v1[0] * v1[0] + v1[1] * v1[1]) + (v1[2] * v1[2] + v1[3] * v1[3]));
                        u32x4 w; w.x = cvt_pk_bf16(v0[0], v0[1]); w.y = cvt_pk_bf16(v0[2], v0[3]); w.z = cvt_pk_bf16(v1[0], v1[1]); w.w = cvt_pk_bf16(v1[2], v1[3]);
                        *(u32x4*)(rowp + bj * HALF) = w; }
                    if (dovs) { vs += __shfl_xor(vs, 16); vs += __shfl_xor(vs, 32);
                        if (fq == 0) (void)__hip_atomic_fetch_add(vss + row0 + ai * HALF + m * 16, vs, __ATOMIC_RELAXED, __HIP_MEMORY_SCOPE_AGENT); } }
        }
    }
};

template <class Epi, bool HT = false>
__device__ __forceinline__ void gemm_phase(LAS unsigned char* lds, const Gemm g, const StaticOrder S, const Epi E) {
    int tid = threadIdx.x; asm volatile("" : "+v"(tid));
    const int wid = __builtin_amdgcn_readfirstlane(tid >> 6), lane = tid & 63, wr = wid >> 2, wc = wid & 3, fr = lane & 15, fq = lane >> 4;
    const int nt = g.K / BK;
    unsigned voffA[2], voffB[2];
#pragma unroll
    for (int i = 0; i < 2; ++i) { int R, C; stage_rc(tid * 16 + i * 8192, R, C); const int Rb = Epi::PERM ? ((R & ~31) + perm32(R & 31)) : R;
        voffA[i] = (unsigned)(R * g.lda + C) * 2u; voffB[i] = (unsigned)(Rb * g.ldb + C) * 2u; }
    const size_t kstep = (size_t)(BK * 2);
    const size_t hstepA = (size_t)HALF * g.lda * 2, hstepB = (size_t)HALF * g.ldb * 2;
    const size_t tstepA = 2 * hstepA, tstepB = 2 * hstepB;
    const unsigned ldsw = (unsigned)wid * 1024u;
    const int aoff = lds_byte(wr * 64 + fr, fq * 8), boff = lds_byte(wc * 32 + fr, fq * 8);
#define PG8_SA(b, h) (((b) * 2 + (h)) * HTB)
#define PG8_SB(b, h) ((4 + (b) * 2 + (h)) * HTB)
#define PG8_STAGE(bufoff, gbase, voff) do { _Pragma("unroll") for (int _i = 0; _i < 2; ++_i) \
        __builtin_amdgcn_global_load_lds((const unsigned*)((const char*)(gbase) + (voff)[_i]), (LAS unsigned*)(lds + (bufoff) + ldsw + _i * 8192), 16, 0, 0); } while (0)
#define PG8_LDA(dst, b, h) do { _Pragma("unroll") for (int m = 0; m < 4; ++m) _Pragma("unroll") for (int k = 0; k < 2; ++k) dst[m][k] = *(const LAS bf16x8*)(lds + PG8_SA(b, h) + aoff + m * 2048 + k * 1024); } while (0)
#define PG8_LDB(dst, b, h) do { _Pragma("unroll") for (int n = 0; n < 2; ++n) _Pragma("unroll") for (int k = 0; k < 2; ++k) dst[n][k] = *(const LAS bf16x8*)(lds + PG8_SB(b, h) + boff + n * 2048 + k * 1024); } while (0)
#define PG8_MMA(ai, bj, At, Bt) do { __builtin_amdgcn_s_setprio(1); _Pragma("unroll") for (int m = 0; m < 4; ++m) _Pragma("unroll") for (int n = 0; n < 2; ++n) _Pragma("unroll") for (int k = 0; k < 2; ++k) \
        acc[ai][bj][m][n] = __builtin_amdgcn_mfma_f32_16x16x32_bf16(Bt[n][k], At[m][k], acc[ai][bj][m][n], 0, 0, 0); __builtin_amdgcn_s_setprio(0); } while (0)
#define PG8_WAIT_V(n) asm volatile("s_waitcnt vmcnt(" #n ")" ::: "memory")
#define PG8_WAIT_L(n) asm volatile("s_waitcnt lgkmcnt(" #n ")" ::: "memory")
#define PG8_BAR __builtin_amdgcn_s_barrier()
#define PG8_SCHED __builtin_amdgcn_sched_barrier(0)
    Unit cur, nxt; int ui = 0;
    if (!S.next(0, cur)) return;
    constexpr int EPI_LDS = 131328;
#define PG8_PREF(u) do { if (Epi::PREF && E.pref_on()) __builtin_amdgcn_global_load_lds((const unsigned*)E.pref_ptr(u, tid), (LAS unsigned*)(lds + EPI_LDS + (ui & 1) * 2048 + wid * 256), 4, 0, 0); } while (0)
    PG8_PREF(cur);
    f32x4 acc[2][2][4][2];
#pragma unroll
    for (int a = 0; a < 2; ++a)
#pragma unroll
        for (int b = 0; b < 2; ++b)
#pragma unroll
            for (int m = 0; m < 4; ++m)
#pragma unroll
                for (int n = 0; n < 2; ++n) acc[a][b][m][n] = (f32x4){0.f, 0.f, 0.f, 0.f};
    bf16x8 At[4][2], B0[2][2], B1[2][2];
    const char* cA = (const char*)g.A + (size_t)cur.pm * tstepA + (size_t)cur.pn * g.apn; const char* cB = (const char*)g.Bt + (size_t)cur.pn * tstepB + ((HT && cur.half > 0) ? hstepB : 0);
    size_t hBc = (HT && cur.half >= 0) ? 0 : hstepB;
    PG8_STAGE(PG8_SB(0, 0), cB, voffB); PG8_STAGE(PG8_SB(0, 1), cB + hBc, voffB); PG8_STAGE(PG8_SA(0, 0), cA, voffA); PG8_STAGE(PG8_SA(0, 1), cA + hstepA, voffA);
    if (wr == 1) PG8_BAR;
    PG8_WAIT_V(2); PG8_BAR;
    PG8_STAGE(PG8_SB(1, 0), cB + kstep, voffB); PG8_STAGE(PG8_SA(1, 0), cA + kstep, voffA); PG8_STAGE(PG8_SB(1, 1), cB + hBc + kstep, voffB);
    PG8_WAIT_V(6); PG8_BAR;
#define PG8_KBODY(B1ON) \
        for (int t = 0, tk = 0; t < nt * Epi::KREP; t += 2) { \
            const bool last = (t == nt * Epi::KREP - 2); \
            const int tk2 = (tk + 2 >= nt) ? tk + 2 - nt : tk + 2; \
            const char* a1 = cA + (size_t)(tk + 1) * kstep; \
            const char* a2 = last ? nA : cA + (size_t)tk2 * kstep; const char* b2 = last ? nB : cB + (size_t)tk2 * kstep; const size_t hb2 = last ? nhB : hBc; tk = tk2; \
            const char* a3 = a2 + kstep; const char* b3 = b2 + kstep; \
            PG8_LDB(B0, 0, 0); if (B1ON) PG8_LDB(B1, 0, 1); PG8_SCHED; PG8_LDA(At, 0, 0); PG8_STAGE(PG8_SA(1, 1), a1 + hstepA, voffA); \
            PG8_WAIT_V(8); PG8_WAIT_L(0); PG8_BAR; PG8_MMA(0, 0, At, B0); if (B1ON) PG8_MMA(0, 1, At, B1); PG8_BAR; PG8_SCHED; \
            PG8_LDA(At, 0, 1); PG8_STAGE(PG8_SB(0, 0), b2, voffB); PG8_STAGE(PG8_SB(0, 1), b2 + hb2, voffB); PG8_STAGE(PG8_SA(0, 0), a2, voffA); \
            PG8_WAIT_V(8); PG8_WAIT_L(0); PG8_BAR; PG8_MMA(1, 0, At, B0); if (B1ON) PG8_MMA(1, 1, At, B1); PG8_BAR; PG8_SCHED; \
            PG8_LDB(B0, 1, 0); if (B1ON) PG8_LDB(B1, 1, 1); PG8_SCHED; PG8_LDA(At, 1, 0); PG8_STAGE(PG8_SA(0, 1), a2 + hstepA, voffA); \
            PG8_WAIT_V(8); PG8_WAIT_L(0); PG8_BAR; PG8_MMA(0, 0, At, B0); if (B1ON) PG8_MMA(0, 1, At, B1); PG8_BAR; PG8_SCHED; \
            PG8_LDA(At, 1, 1); PG8_STAGE(PG8_SB(1, 0), b3, voffB); PG8_STAGE(PG8_SB(1, 1), b3 + hb2, voffB); PG8_STAGE(PG8_SA(1, 0), a3, voffA); \
            PG8_WAIT_V(8); PG8_WAIT_L(0); PG8_BAR; PG8_MMA(1, 0, At, B0); if (B1ON) PG8_MMA(1, 1, At, B1); PG8_BAR; PG8_SCHED; \
        }
    for (;;) {
        const bool has_next = S.next(ui + 1, nxt);
        const char* nA = has_next ? (const char*)g.A + (size_t)nxt.pm * tstepA + (size_t)nxt.pn * g.apn : cA;
        const char* nB = has_next ? (const char*)g.Bt + (size_t)nxt.pn * tstepB + ((HT && nxt.half > 0) ? hstepB : 0) : cB;
        const size_t nhB = has_next ? ((HT && nxt.half >= 0) ? 0 : hstepB) : hBc;
        if (HT && cur.half >= 0) { PG8_KBODY(false) } else { PG8_KBODY(true) }
        if (wr == 0) PG8_BAR;
        E.run(acc, cur, wr, wc, fr, fq, (const LAS float*)(lds + EPI_LDS + (ui & 1) * 2048));
        if (!has_next) break;
#pragma unroll
        for (int a = 0; a < 2; ++a)
#pragma unroll
            for (int b = 0; b < 2; ++b)
#pragma unroll
                for (int m = 0; m < 4; ++m)
#pragma unroll
                    for (int n = 0; n < 2; ++n) acc[a][b][m][n] = (f32x4){0.f, 0.f, 0.f, 0.f};
        cur = nxt; cA = nA; cB = nB; hBc = nhB; ++ui;
        PG8_PREF(cur);
        if (wr == 1) PG8_BAR;
    }
    PG8_WAIT_V(0);
    PG8_BAR;
#undef PG8_KBODY
#undef PG8_PREF
#undef PG8_SA
#undef PG8_SB
#undef PG8_STAGE
#undef PG8_LDA
#undef PG8_LDB
#undef PG8_MMA
#undef PG8_WAIT_V
#undef PG8_WAIT_L
#undef PG8_BAR
#undef PG8_SCHED
}
}

namespace att {
constexpr int NW = 8, QBLK = 32, KVBLK = 64;
constexpr float SCALE = 0.10206207261596575f;
constexpr float THR = 8.f;
constexpr size_t SHM_V = 16384, SHM_K = 16384, SHM_ATTN = 2 * SHM_V + 2 * SHM_K + NW * 64 * 4;
#define KSWZ(row, colB) ((row) * 256 + ((colB) ^ (((row) & 7) << 4)))
#define SBAR() __builtin_amdgcn_sched_barrier(0)
__device__ __forceinline__ int crow(int r, int hi) { return (r & 3) + 8 * (r >> 2) + 4 * hi; }
__device__ __forceinline__ void partialSM(f32x16& p0, f32x16& p1, float& m_reg, float& mn, float& alpha) {
  constexpr float C = SCALE * 1.4426950408889634f;
  float pmax = p0[0];
#pragma unroll
  for (int r = 1; r < 16; ++r) pmax = fmaxf(pmax, p0[r]);
#pragma unroll
  for (int r = 0; r < 16; ++r) pmax = fmaxf(pmax, p1[r]);
  { auto rr = __builtin_amdgcn_permlane32_swap(__float_as_uint(pmax), __float_as_uint(pmax), false, false);
    pmax = fmaxf(__uint_as_float(rr[0]), __uint_as_float(rr[1])); }
  if (__builtin_expect(__all(pmax - m_reg <= THR / SCALE), 1)) { mn = m_reg; alpha = 1.f; }
  else { mn = fmaxf(m_reg, pmax); alpha = __builtin_amdgcn_exp2f((m_reg - mn) * C); m_reg = mn; }
  float mnC = -mn * C;
#pragma unroll
  for (int r = 0; r < 16; ++r) p0[r] = fmaf(p0[r], C, mnC);
#pragma unroll
  for (int r = 0; r < 16; ++r) p1[r] = fmaf(p1[r], C, mnC);
#pragma unroll
  for (int r = 0; r < 16; ++r) p0[r] = __builtin_amdgcn_exp2f(p0[r]);
}
__device__ __forceinline__ void finishSM(f32x16& p0, f32x16& p1, float alpha, float& l_reg, bf16x8& pa0, bf16x8& pa1, bf16x8& pa2, bf16x8& pa3) {
#pragma unroll
  for (int r = 0; r < 16; ++r) p1[r] = __builtin_amdgcn_exp2f(p1[r]);
  float ps = 0;
#pragma unroll
  for (int r = 0; r < 16; ++r) ps += p0[r];
#pragma unroll
  for (int r = 0; r < 16; ++r) ps += p1[r];
  { auto rr = __builtin_amdgcn_permlane32_swap(__float_as_uint(ps), __float_as_uint(ps), false, false);
    ps = __uint_as_float(rr[0]) + __uint_as_float(rr[1]); }
  l_reg = l_reg * alpha + ps;
#define PK4(P, BASE, OUT) do { unsigned a0 = cvt_pk_bf16(P[BASE + 0], P[BASE + 1]), a1 = cvt_pk_bf16(P[BASE + 2], P[BASE + 3]);   \
    unsigned b0 = cvt_pk_bf16(P[BASE + 4], P[BASE + 5]), b1 = cvt_pk_bf16(P[BASE + 6], P[BASE + 7]);                              \
    auto r0 = __builtin_amdgcn_permlane32_swap(a0, b0, false, false); auto r1 = __builtin_amdgcn_permlane32_swap(a1, b1, false, false); \
    u32x4 w = {r0[0], r1[0], r0[1], r1[1]}; OUT = *reinterpret_cast<bf16x8*>(&w); } while (0)
  PK4(p0, 0, pa0); PK4(p0, 8, pa1); PK4(p1, 0, pa2); PK4(p1, 8, pa3);
#undef PK4
}
__device__ __forceinline__ void qkt(f32x16& p0, f32x16& p1, const char* Ks, const bf16x8* qr, int r32, int hi) {
  p0 = f32x16{}; p1 = f32x16{};
#pragma unroll
  for (int d0 = 0; d0 < 6; ++d0) { int cb = (d0 * 16 + hi * 8) * 2;
    bf16x8 b0 = *reinterpret_cast<const bf16x8*>(Ks + KSWZ(r32, cb));
    bf16x8 b1 = *reinterpret_cast<const bf16x8*>(Ks + KSWZ(32 + r32, cb));
    p0 = __builtin_amdgcn_mfma_f32_32x32x16_bf16(b0, qr[d0], p0, 0, 0, 0);
    p1 = __builtin_amdgcn_mfma_f32_32x32x16_bf16(b1, qr[d0], p1, 0, 0, 0); }
}
__device__ __forceinline__ int v_st(int k, int c) { const int kk = (k & ~0xC) | ((k & 4) << 1) | ((k & 8) >> 1); return ((kk >> 3) * 4 + (c >> 5)) * 512 + ((kk & 7) * 32 + (c & 31)) * 2; }
__device__ __forceinline__ int v_rd_base(int lane) { return ((lane & 3) << 3) | (((lane >> 2) & 3) << 6) | (((lane >> 4) & 1) << 5) | (((lane >> 5) & 1) << 8); }
constexpr int v_rd_off(int d0, int ks, int half) { return d0 * 512 + ks * 4096 + half * 2048; }
template <int OFF> __device__ __forceinline__ s16x4 tr_read(int vb) {
  s16x4 r; asm volatile("ds_read_b64_tr_b16 %0, %1 offset:%2" : "=&v"(r) : "v"(vb), "i"(OFF) : "memory"); return r;
}
template <int D0> __device__ __forceinline__ void pv_one(f32x16& od, int vb, bf16x8 pa0, bf16x8 pa1, bf16x8 pa2, bf16x8 pa3) {
  const s16x4 l0 = tr_read<v_rd_off(D0, 0, 0)>(vb), h0 = tr_read<v_rd_off(D0, 0, 1)>(vb), l1 = tr_read<v_rd_off(D0, 1, 0)>(vb), h1 = tr_read<v_rd_off(D0, 1, 1)>(vb);
  const s16x4 l2 = tr_read<v_rd_off(D0, 2, 0)>(vb), h2 = tr_read<v_rd_off(D0, 2, 1)>(vb), l3 = tr_read<v_rd_off(D0, 3, 0)>(vb), h3 = tr_read<v_rd_off(D0, 3, 1)>(vb);
  asm volatile("s_waitcnt lgkmcnt(0)" ::: "memory"); SBAR();
#define PK(L, H) (bf16x8){L[0], L[1], L[2], L[3], H[0], H[1], H[2], H[3]}
  od = __builtin_amdgcn_mfma_f32_32x32x16_bf16(pa0, PK(l0, h0), od, 0, 0, 0);
  od = __builtin_amdgcn_mfma_f32_32x32x16_bf16(pa1, PK(l1, h1), od, 0, 0, 0);
  od = __builtin_amdgcn_mfma_f32_32x32x16_bf16(pa2, PK(l2, h2), od, 0, 0, 0);
  od = __builtin_amdgcn_mfma_f32_32x32x16_bf16(pa3, PK(l3, h3), od, 0, 0, 0);
#undef PK
}
__device__ __forceinline__ void pv_d0(f32x16* o, int vb, bf16x8 pa0, bf16x8 pa1, bf16x8 pa2, bf16x8 pa3) {
  pv_one<0>(o[0], vb, pa0, pa1, pa2, pa3); pv_one<1>(o[1], vb, pa0, pa1, pa2, pa3);
}
__device__ __forceinline__ void attn_unit(const bf16_t* __restrict__ Qb, const bf16_t* __restrict__ Kh, const bf16_t* __restrict__ Vh,
                                          bf16_t* __restrict__ Ob, int seq, char* lds) {
  int tid = threadIdx.x; asm volatile("" : "+v"(tid));
  const int wid = tid >> 6, lane = tid & 63, r32 = lane & 31, hi = lane >> 5;
  char* V_lds = lds; char* K_lds = lds + 2 * SHM_V;
  float* ws = (float*)(lds + 2 * SHM_V + 2 * SHM_K) + wid * 64; float* li_l = ws; float* al_l = ws + 32;
  float m_reg = -1e30f, l_reg = 0; f32x16 o[2] = {}; bf16x8 qr[6];
  const bf16_t* Qw = Qb + (long)(wid * QBLK + r32) * QLD + hi * 8;
#pragma unroll
  for (int d0 = 0; d0 < 6; ++d0) qr[d0] = *reinterpret_cast<const bf16x8*>(Qw + d0 * 16);
  const bool kld = wid < 6;
  const int ksr = tid / 12, ksc = (tid - ksr * 12) * 8;
  const int vsr = tid >> 3, vsc = (tid & 7) * 8, vst0 = v_st(vsr, vsc);
  const int vb0 = (int)(uintptr_t)V_lds + v_rd_base(lane);
  struct { bf16x8 vs0, ks0, ks1; } sr_[2];
#define SLOAD(i, k0) do { sr_[i].vs0 = *reinterpret_cast<const bf16x8*>(&Vh[(long)((k0) + vsr) * QLD + vsc]); \
    if (kld) { sr_[i].ks0 = *reinterpret_cast<const bf16x8*>(&Kh[(long)((k0) + ksr) * QLD + ksc]); sr_[i].ks1 = *reinterpret_cast<const bf16x8*>(&Kh[(long)((k0) + 32 + ksr) * QLD + ksc]); } } while (0)
#define SWRITE(b, i) do { *(bf16x8*)(V_lds + (b) * SHM_V + vst0) = sr_[i].vs0; \
    if (kld) { int kc = ksc * 2; *(bf16x8*)(K_lds + (b) * SHM_K + KSWZ(ksr, kc)) = sr_[i].ks0; *(bf16x8*)(K_lds + (b) * SHM_K + KSWZ(32 + ksr, kc)) = sr_[i].ks1; } } while (0)
#define SWAIT() asm volatile("s_waitcnt vmcnt(3)" ::: "memory")
#define RESC(a) do { if (__any((a) < 1.f)) { if (hi == 0) al_l[r32] = (a); asm volatile("s_waitcnt lgkmcnt(0)" ::: "memory"); \
    _Pragma("unroll") for (int d = 0; d < 2; ++d) _Pragma("unroll") for (int r = 0; r < 16; ++r) o[d][r] *= al_l[crow(r, hi)]; } } while (0)
  f32x16 pA0, pA1, pB0, pB1; float mnA, mnB, alA, alB; bf16x8 pa0, pa1, pa2, pa3; const int NT = seq / KVBLK;
  constexpr int SE = 0, SO = 1;
  SLOAD(SE, 0); asm volatile("s_waitcnt vmcnt(0)" ::: "memory"); SWRITE(0, SE); __syncthreads();
  qkt(pA0, pA1, K_lds, qr, r32, hi); partialSM(pA0, pA1, m_reg, mnA, alA);
  SLOAD(SO, KVBLK); if (2 < NT) SLOAD(SE, 2 * KVBLK);
  SWAIT(); SWRITE(1, SO); __syncthreads();
  for (int j = 1; j + 1 < NT; j += 2) {
    SBAR(); qkt(pB0, pB1, K_lds + SHM_K, qr, r32, hi);
    finishSM(pA0, pA1, alA, l_reg, pa0, pa1, pa2, pa3); SBAR();
    SLOAD(SO, (j + 2) * KVBLK); SBAR();
    pv_d0(o, vb0, pa0, pa1, pa2, pa3); partialSM(pB0, pB1, m_reg, mnB, alB);
    __syncthreads(); SWAIT(); SWRITE(0, SE);
    RESC(alB); __syncthreads();
    SBAR(); qkt(pA0, pA1, K_lds, qr, r32, hi);
    finishSM(pB0, pB1, alB, l_reg, pa0, pa1, pa2, pa3); SBAR();
    if (j + 3 < NT) SLOAD(SE, (j + 3) * KVBLK); SBAR();
    pv_d0(o, vb0 + (int)SHM_V, pa0, pa1, pa2, pa3); partialSM(pA0, pA1, m_reg, mnA, alA);
    __syncthreads(); SWAIT(); SWRITE(1, SO);
    RESC(alA); __syncthreads();
  }
  SBAR(); qkt(pB0, pB1, K_lds + SHM_K, qr, r32, hi);
  finishSM(pA0, pA1, alA, l_reg, pa0, pa1, pa2, pa3); SBAR();
  pv_d0(o, vb0, pa0, pa1, pa2, pa3); partialSM(pB0, pB1, m_reg, mnB, alB);
  __syncthreads(); RESC(alB);
  finishSM(pB0, pB1, alB, l_reg, pa0, pa1, pa2, pa3); SBAR();
  pv_d0(o, vb0 + (int)SHM_V, pa0, pa1, pa2, pa3);
  if (hi == 0) li_l[r32] = l_reg; asm volatile("s_waitcnt lgkmcnt(0)" ::: "memory");
  bf16_t* Ow = Ob + (long)(wid * QBLK) * 1024;
#pragma unroll
  for (int r = 0; r < 16; ++r) { const int orow = crow(r, hi); const float rl = __builtin_amdgcn_rcpf(li_l[orow]);
#pragma unroll
    for (int d0 = 0; d0 < 2; ++d0) Ow[(long)orow * 1024 + d0 * 32 + r32] = (bf16_t)(cvt_pk_bf16(o[d0][r] * rl, 0.f) & 0xffffu); }
#undef SLOAD
#undef SWRITE
#undef SWAIT
#undef RESC
}
}


#define XB_TMO      128
#define XB_XCNT(j)  (256  + 64 * (j))
#define XB_XSUB(j)  (1280 + 64 * (j))
#define XB_XGEN(j)  (2304 + 64 * (j))
#define XB_TOP      3328
#define XB_TOPGEN   3392
#define XCD_BAR_WORDS 3456
#define XB_SPIN_CAP (1u << 20)
__device__ __forceinline__ unsigned xb_ld(unsigned* p)              { return __hip_atomic_load(p, __ATOMIC_RELAXED, __HIP_MEMORY_SCOPE_AGENT); }
__device__ __forceinline__ unsigned xb_add(unsigned* p, unsigned v) { return __hip_atomic_fetch_add(p, v, __ATOMIC_RELAXED, __HIP_MEMORY_SCOPE_AGENT); }
__device__ __forceinline__ unsigned xb_xcc_id() { return (unsigned)__builtin_amdgcn_s_getreg((3 << 11) | 20) & 0xFu; }
#define XB_SPIN(cond, bar) do { unsigned _sp = 0; while (cond) { __builtin_amdgcn_s_sleep(1); \
    if ((++_sp & 255u) == 0u) { if (xb_ld(&(bar)[XB_TMO])) break; if (_sp > XB_SPIN_CAP) { atomicAdd(&(bar)[XB_TMO], 1u); break; } } } } while (0)
struct XcdBarrier { unsigned* bar; unsigned x; volatile LAS unsigned* st; };
__device__ __forceinline__ XcdBarrier xcd_barrier_post(unsigned* bar, volatile LAS unsigned* st) {
    XcdBarrier b; b.bar = bar; b.x = xb_xcc_id(); b.st = st;
    if (threadIdx.x == 0) (void)xb_add(&bar[XB_XCNT(b.x)], 1u);
    return b;
}
__device__ __forceinline__ void xcd_barrier_complete(unsigned* bar, unsigned x, unsigned& nloc, unsigned& nx) {
    const unsigned G = gridDim.x * gridDim.y * gridDim.z;
    unsigned sum, cnt, mine, sp = 0u;
    for (;;) {
        sum = 0u; cnt = 0u; mine = 0u;
#pragma unroll
        for (unsigned j = 0; j < 16; ++j) { const unsigned c = xb_ld(&bar[XB_XCNT(j)]); sum += c; cnt += (c > 0u) ? 1u : 0u; mine = (j == x) ? c : mine; }
        if (sum == G) break;
        __builtin_amdgcn_s_sleep(1);
        if ((++sp & 255u) == 0u) { if (xb_ld(&bar[XB_TMO])) break; if (sp > XB_SPIN_CAP) { atomicAdd(&bar[XB_TMO], 1u); break; } }
    }
    nloc = mine > 0u ? mine : 1u; nx = cnt > 0u ? cnt : 1u;
}
__device__ __forceinline__ void xcd_barrier(const XcdBarrier& b) {
    asm volatile("s_waitcnt vmcnt(0)" ::: "memory");
    __syncthreads();
    if (threadIdx.x == 0) {
        unsigned* bar = b.bar;
        __builtin_amdgcn_s_waitcnt(0);
        unsigned nloc = b.st[0], nx = b.st[1];
        if (nloc == 0u) { xcd_barrier_complete(bar, b.x, nloc, nx); b.st[0] = nloc; b.st[1] = nx; }
        const unsigned old = xb_add(&bar[XB_XSUB(b.x)], 1u);
        const unsigned gen = old / nloc;
        if (old + 1u == (gen + 1u) * nloc) {
            __builtin_amdgcn_fence(__ATOMIC_RELEASE, "agent");
            asm volatile("s_waitcnt vmcnt(0)" ::: "memory");
            const unsigned og = xb_add(&bar[XB_TOP], 1u);
            const unsigned tg = og / nx;
            if (og + 1u == (tg + 1u) * nx) xb_add(&bar[XB_TOPGEN], 1u);
            else XB_SPIN(xb_ld(&bar[XB_TOPGEN]) == tg, bar);
            __builtin_amdgcn_fence(__ATOMIC_ACQUIRE, "agent");
            xb_add(&bar[XB_XGEN(b.x)], 1u);
            asm volatile("s_waitcnt vmcnt(0)" ::: "memory");
        } else {
            XB_SPIN(xb_ld(&bar[XB_XGEN(b.x)]) == gen, bar);
            __builtin_amdgcn_fence(__ATOMIC_ACQUIRE, "agent");
            asm volatile("s_waitcnt vmcnt(0)" ::: "memory");
        }
    }
    __syncthreads();
}

constexpr int LDS_BYTES = 139264;
struct Args { const float* in[25]; float* out; unsigned char* ws; int ph_lo, ph_hi; };

__device__ __forceinline__ void tr_item(const float* W, int ldw, bf16_t* dst, int ldd, LAS float* scr, int lane) {
    float tv[32];
#pragma unroll
    for (int i = 0; i < 32; ++i) tv[i] = W[(size_t)(2 * i + (lane >> 5)) * ldw + (lane & 31)];
#pragma unroll
    for (int i = 0; i < 32; ++i) scr[(2 * i + (lane >> 5)) * 33 + (lane & 31)] = tv[i];
    asm volatile("s_waitcnt lgkmcnt(0)" ::: "memory");
    const int c = lane & 7;
#pragma unroll
    for (int j = 0; j < 4; ++j) { const int n = (lane >> 3) + 8 * j; const LAS float* s = scr + (8 * c) * 33 + n;
        u32x4 o; o.x = cvt_pk_bf16(s[0 * 33], s[1 * 33]); o.y = cvt_pk_bf16(s[2 * 33], s[3 * 33]); o.z = cvt_pk_bf16(s[4 * 33], s[5 * 33]); o.w = cvt_pk_bf16(s[6 * 33], s[7 * 33]);
        *(u32x4*)(dst + (size_t)n * ldd + 8 * c) = o; }
    asm volatile("s_waitcnt lgkmcnt(0)" ::: "memory");
}


struct P2Row { f32x4 q[3], k[3]; u32x2 v[2]; int kind, t, e; };
__device__ __forceinline__ f32x4 ld_bf4(const bf16_t* p) { const u32x2 w = *(const u32x2*)p; return (f32x4){bflo(w.x), bfhi(w.x), bflo(w.y), bfhi(w.y)}; }
__device__ __forceinline__ void p2_load(P2Row& r, int e, int j, int hh, int s, const bf16_t* QKV, const float* KROPE, const float* cache_kr) {
    const float* krp; r.e = e; r.t = 0;
    if (e < NCTX) { r.kind = 0; krp = KROPE + (size_t)e * 32; }
    else { const int b = (e - NCTX) / KVB, tt = (e - NCTX) - b * KVB;
        if (tt < LLAT) { r.kind = 1; r.t = tt; krp = KROPE + (size_t)(NCTX + b * LLAT + tt) * 32; }
        else { r.kind = 2; krp = cache_kr + (((size_t)b * 2 + j) * 512 + (tt - LLAT)) * 32; } }
    const bf16_t* raw = QKV + (size_t)e * QLD;
#pragma unroll
    for (int jj = 0; jj < 3; ++jj) r.q[jj] = ld_bf4(raw + hh * 96 + 4 * (s + 8 * jj));
#pragma unroll
    for (int jj = 0; jj < 2; ++jj) { r.k[jj] = ld_bf4(raw + 768 + hh * 128 + 4 * (s + 8 * jj)); r.v[jj] = *(const u32x2*)(raw + 768 + hh * 128 + 64 + 4 * (s + 8 * jj)); }
    r.k[2] = *(const f32x4*)(krp + 4 * s);
}
__device__ __forceinline__ void p2_compute(P2Row& r, int s, const float* qn, const float* kn, const float* ROPE) {
    float sq = 0.f, sk = 0.f;
#pragma unroll
    for (int jj = 0; jj < 3; ++jj) { sq += (r.q[jj][0] * r.q[jj][0] + r.q[jj][1] * r.q[jj][1]) + (r.q[jj][2] * r.q[jj][2] + r.q[jj][3] * r.q[jj][3]);
                                     sk += (r.k[jj][0] * r.k[jj][0] + r.k[jj][1] * r.k[jj][1]) + (r.k[jj][2] * r.k[jj][2] + r.k[jj][3] * r.k[jj][3]); }
    sq += __shfl_xor(sq, 1); sq += __shfl_xor(sq, 2); sq += __shfl_xor(sq, 4);
    sk += __shfl_xor(sk, 1); sk += __shfl_xor(sk, 2); sk += __shfl_xor(sk, 4);
    const float rq = 1.0f / sqrtf(sq * (1.0f / 96.0f) + EPS), rk = 1.0f / sqrtf(sk * (1.0f / 96.0f) + EPS);
#pragma unroll
    for (int jj = 0; jj < 3; ++jj) { r.q[jj] = r.q[jj] * rq * *(const f32x4*)(qn + 4 * (s + 8 * jj)); r.k[jj] = r.k[jj] * rk * *(const f32x4*)(kn + 4 * (s + 8 * jj)); }
    f32x4 qp, kp;
#pragma unroll
    for (int c = 0; c < 4; ++c) { qp[c] = __shfl_xor(r.q[2][c], 2); kp[c] = __shfl_xor(r.k[2][c], 2); }
    if (r.kind == 1) {
        const int a = s >> 2, fi0 = (s & 1) * 4; const bool second = (s & 2) != 0;
        const f32x4 cs = *(const f32x4*)(ROPE + (size_t)r.t * 16 + a * 8 + fi0), sn = *(const f32x4*)(ROPE + 65536 + (size_t)r.t * 16 + a * 8 + fi0);
        if (!second) { r.q[2] = r.q[2] * cs - qp * sn; r.k[2] = r.k[2] * cs - kp * sn; }
        else { r.q[2] = qp * sn + r.q[2] * cs; r.k[2] = kp * sn + r.k[2] * cs; }
    }
}
__device__ __forceinline__ void p2_store(const P2Row& r, int hh, int s, bf16_t* QKV) {
    bf16_t* orow = QKV + (size_t)r.e * QLD;
#pragma unroll
    for (int jj = 0; jj < 3; ++jj) {
        if (r.kind != 2) { u32x2 w; w.x = cvt_pk_bf16(r.q[jj][0], r.q[jj][1]); w.y = cvt_pk_bf16(r.q[jj][2], r.q[jj][3]); *(u32x2*)(orow + hh * 96 + 4 * (s + 8 * jj)) = w; }
        u32x2 w2; w2.x = cvt_pk_bf16(r.k[jj][0], r.k[jj][1]); w2.y = cvt_pk_bf16(r.k[jj][2], r.k[jj][3]); *(u32x2*)(orow + 768 + hh * 96 + 4 * (s + 8 * jj)) = w2; }
#pragma unroll
    for (int jj = 0; jj < 2; ++jj) *(u32x2*)(orow + 1536 + hh * 64 + 4 * (s + 8 * jj)) = r.v[jj];
}
struct P1Row { f32x4 q4, k4, r4; };
__device__ __forceinline__ void p1_load(P1Row& p, const float* pr, int lane) {
    p.q4 = *(const f32x4*)(pr + 4 * lane);
    p.k4 = (f32x4){0.f, 0.f, 0.f, 0.f}; if (lane < 32) p.k4 = *(const f32x4*)(pr + 256 + 4 * lane);
    p.r4 = (f32x4){0.f, 0.f, 0.f, 0.f}; if (lane < 8) p.r4 = *(const f32x4*)(pr + 384 + 4 * lane);
}
__device__ __forceinline__ void p1_finish(const P1Row& p, int r, int j, int lane, const float* qan, const float* kvan, bf16_t* QKVLAT, float* KROPE, float* OUT_CKV, float* OUT_KR) {
    const int e = r < NCTX ? r : NCTX + ((r - NCTX) >> 12) * KVB + ((r - NCTX) & 4095);
    const float ssq = wave_sum((p.q4[0] * p.q4[0] + p.q4[1] * p.q4[1]) + (p.q4[2] * p.q4[2] + p.q4[3] * p.q4[3]));
    const float ssk = wave_sum((p.k4[0] * p.k4[0] + p.k4[1] * p.k4[1]) + (p.k4[2] * p.k4[2] + p.k4[3] * p.k4[3]));
    const float rq = 1.0f / sqrtf(ssq * (1.0f / 256.0f) + EPS), rk = 1.0f / sqrtf(ssk * (1.0f / 128.0f) + EPS);
    const f32x4 qo = p.q4 * rq * *(const f32x4*)(qan + 4 * lane);
    u32x2 w; w.x = cvt_pk_bf16(qo[0], qo[1]); w.y = cvt_pk_bf16(qo[2], qo[3]); *(u32x2*)(QKVLAT + (size_t)e * 384 + 4 * lane) = w;
    if (lane < 32) { const f32x4 ko = p.k4 * rk * *(const f32x4*)(kvan + 4 * lane); u32x2 w2; w2.x = cvt_pk_bf16(ko[0], ko[1]); w2.y = cvt_pk_bf16(ko[2], ko[3]);
        *(u32x2*)(QKVLAT + (size_t)e * 384 + 256 + 4 * lane) = w2;
        if (r < NCTX) *(f32x4*)(OUT_CKV + (((size_t)(r >> 8) * 2 + j) * 256 + (r & 255)) * 128 + 4 * lane) = ko; }
    if (lane < 8) { *(f32x4*)(KROPE + (size_t)r * 32 + 4 * lane) = p.r4;
        if (r < NCTX) *(f32x4*)(OUT_KR + (((size_t)(r >> 8) * 2 + j) * 256 + (r & 255)) * 32 + 4 * lane) = p.r4; }
}

#define DERIVE_PTRS \
    unsigned char* ws = args.ws; \
    float* X = args.out; \
    float* OUT_CKV = args.out + (size_t)MTOK * 1024; float* OUT_KR = OUT_CKV + (size_t)32 * 2 * 256 * 128; \
    bf16_t* W13 = (bf16_t*)(ws + OFF_W13); bf16_t* W2 = (bf16_t*)(ws + OFF_W2); bf16_t* WIN = (bf16_t*)(ws + OFF_WIN); bf16_t* WQKV = (bf16_t*)(ws + OFF_WQKV); \
    bf16_t* WOUT = (bf16_t*)(ws + OFF_WOUT); bf16_t* POOLT = (bf16_t*)(ws + OFF_POOLT); bf16_t* WSB = (bf16_t*)(ws + OFF_WS); \
    float* MOD = (float*)(ws + OFF_MOD); float* ROPE = (float*)(ws + OFF_ROPE); \
    bf16_t* H = (bf16_t*)(ws + OFF_H); bf16_t* MIX = H; \
    unsigned char* R = ws + OFF_R; \
    bf16_t* U = (bf16_t*)(R + R_U); bf16_t* PB = (bf16_t*)R; bf16_t* H2 = (bf16_t*)R; \
    float* RSS = (float*)(ws + OFF_RSS); float* B13 = (float*)(ws + OFF_B13); float* BIN = (float*)(ws + OFF_BIN); float* VSS = (float*)(ws + OFF_VSS); \
    bf16_t* QKVLAT = (bf16_t*)(R + R_QKVLAT); float* KROPE = (float*)(R + R_KROPE); float* PROJ = (float*)(R + R_PROJ); \
    bf16_t* GM = (bf16_t*)(R + R_GM); float* QKVRAW = (float*)(R + R_QKVRAW); bf16_t* QKV = (bf16_t*)(R + R_QKVRAW);

__global__ void __launch_bounds__(512, 2) fwd_mega(Args args) {
    extern __shared__ __attribute__((aligned(16))) unsigned char lds[];
    cg::grid_group grid = cg::this_grid();
    int tid = threadIdx.x, lane = tid & 63, wave = __builtin_amdgcn_readfirstlane(tid >> 6);
    const int G = gridDim.x, bid = blockIdx.x;
    int gw = bid * 8 + wave; const int NGW = G * 8;
    long gt = (long)bid * 512 + tid; const long NGT = (long)G * 512;
    const int lo = args.ph_lo, hi = args.ph_hi;
    int pid = 0;
    unsigned* BARW = (unsigned*)(args.ws + OFF_CTL);
    volatile LAS unsigned* MISC = (volatile LAS unsigned*)((LAS unsigned char*)lds + 131072);
    if (tid < 16) MISC[tid] = 0u;
    if (bid == 0) for (int i = tid; i < XCD_BAR_WORDS; i += 512) BARW[i] = 0u;
    __syncthreads();
    XcdBarrier xbar; xbar.bar = BARW; xbar.x = 0; xbar.st = MISC;

    for (int rep0 = 0; rep0 < ((DUPMASK & 1) ? 2 : 1); ++rep0)
    if (EN_PRO && pid >= lo && pid < hi) {
        DERIVE_PTRS
        if (bid < 288) {
            LAS float* S = (LAS float*)lds; LAS float* P = (LAS float*)(lds + 36864);
            for (int idx = tid; idx < 9216; idx += 512) { const int cv = idx >> 10, k = idx & 1023; const float x = cv == 0 ? args.in[5][k] : args.in[4][(cv - 1) * 1024 + k]; S[idx] = x / (1.0f + expf(-x)); }
            __syncthreads();
            for (int item = bid; item < 288; item += G) {
                const int l = item / 72, cb = item % 72, j = tid & 127, s = tid >> 7;
                float acc[9];
#pragma unroll
                for (int cv = 0; cv < 9; ++cv) acc[cv] = 0.f;
                const float* wp = args.in[6] + ((size_t)l * 1024 + s * 256) * NMOD + cb * 128 + j;
                for (int k = 0; k < 256; k += 16) {
                    float wv[16];
#pragma unroll
                    for (int i = 0; i < 16; ++i) wv[i] = wp[(size_t)(k + i) * NMOD];
#pragma unroll
                    for (int cv = 0; cv < 9; ++cv) { const LAS float* sp = S + cv * 1024 + s * 256 + k;
#pragma unroll
                        for (int i = 0; i < 16; ++i) acc[cv] += sp[i] * wv[i]; }
                }
#pragma unroll
                for (int cv = 0; cv < 9; ++cv) P[(s * 9 + cv) * 128 + j] = acc[cv];
                __syncthreads();
                for (int idx = tid; idx < 1152; idx += 512) { const int cv = idx >> 7, jj = idx & 127;
                    const float v = P[(0 * 9 + cv) * 128 + jj] + P[(1 * 9 + cv) * 128 + jj] + P[(2 * 9 + cv) * 128 + jj] + P[(3 * 9 + cv) * 128 + jj] + args.in[7][l * NMOD + cb * 128 + jj];
                    MOD[((size_t)l * 9 + cv) * NMOD + cb * 128 + jj] = v; }
                __syncthreads();
            }
        }
        __syncthreads();
        {
            LAS float* scr = (LAS float*)(lds + 57344 + wave * 8448);
            for (int it0 = gw; it0 < 36832; it0 += NGW) {
                int it = it0; const float* src; int ldw, ldd; bf16_t* dst;
                if (it < 33792) { const int ls = it / 4224, r = it % 4224, which = r / 1408, q = r % 1408;
                    if (which < 2) { const int kb = q / 88, nb = q % 88, k0 = kb * 64, n0 = nb * 32; src = args.in[which ? 10 : 9] + (size_t)ls * 1024 * FF + (size_t)k0 * FF + n0; ldw = FF;
                        const int drow = (n0 >> 7) * 256 + (n0 & 127) + which * 128; dst = W13 + (size_t)ls * 5632 * 1024 + (size_t)drow * 1024 + k0; ldd = 1024; }
                    else { const int kb = q / 32, nb = q % 32, k0 = kb * 64, n0 = nb * 32; src = args.in[11] + (size_t)ls * FF * 1024 + (size_t)k0 * 1024 + n0; ldw = 1024;
                        dst = W2 + (size_t)ls * 1024 * FF + (size_t)n0 * FF + k0; ldd = FF; } }
                else { it -= 33792;
                if (it < 1440) { const int j = it / 720, q = it % 720, kb = q / 45, nb = q % 45, k0 = kb * 64, n0 = nb * 32; src = args.in[12] + (size_t)j * 1024 * 1440 + (size_t)k0 * 1440 + n0; ldw = 1440;
                    const int drow = n0 < 416 ? n0 : n0 + 96; dst = WIN + (size_t)j * 1536 * 1024 + (size_t)drow * 1024 + k0; ldd = 1024; }
                else { it -= 1440;
                if (it < 192) { const int j = it / 96, q = it % 96, kb = q / 24, nb = q % 24, k0 = kb * 64, n0 = nb * 32; src = args.in[15] + (size_t)j * 256 * 768 + (size_t)k0 * 768 + n0; ldw = 768;
                    dst = WQKV + (size_t)j * 1792 * 384 + (size_t)n0 * 384 + k0; ldd = 384; }
                else { it -= 192;
                if (it < 128) { const int j = it / 64, q = it % 64, kb = q / 32, nb = q % 32, k0 = kb * 64, n0 = nb * 32; src = args.in[16] + (size_t)j * 128 * 1024 + (size_t)k0 * 1024 + n0; ldw = 1024;
                    dst = WQKV + (size_t)j * 1792 * 384 + (size_t)(768 + n0) * 384 + 256 + k0; ldd = 384; }
                else { it -= 128;
                if (it < 1024) { const int j = it / 512, q = it % 512, kb = q / 32, nb = q % 32, k0 = kb * 64, n0 = nb * 32; src = args.in[22] + (size_t)j * 1024 * 1024 + (size_t)k0 * 1024 + n0; ldw = 1024;
                    dst = WOUT + (size_t)j * 1024 * 1024 + (size_t)n0 * 1024 + k0; ldd = 1024; }
                else { it -= 1024;
                    const int jg = it / 32, q = it % 32, kb = q / 8, nb = q % 8, k0 = kb * 64, n0 = nb * 32; src = args.in[23] + (size_t)jg * 65536 + (size_t)k0 * 256 + n0; ldw = 256;
                    dst = POOLT + (size_t)jg * 65536 + (size_t)n0 * 256 + k0; ldd = 256; } } } } }
                tr_item(src, ldw, dst, ldd, scr, lane);
            }
        }
        {
            const u32x4 z = {0u, 0u, 0u, 0u};
            for (long i = gt; i < 2 * 12288; i += NGT) { const int j = (int)(i / 12288); const long q = i % 12288; *(u32x4*)(WIN + (size_t)j * 1536 * 1024 + (size_t)416 * 1024 + q * 8) = z; }
            for (long i = gt; i < 2 * 45056; i += NGT) { const int j = (int)(i / 45056); const long q = i % 45056; bf16_t* base = WQKV + (size_t)j * 1792 * 384;
                if (q < 12288) { const int row = (int)(q >> 4), c = (int)(q & 15); *(u32x4*)(base + (size_t)row * 384 + 256 + c * 8) = z; }
                else { const long q2 = q - 12288; const int row = 768 + (int)(q2 >> 5), c = (int)(q2 & 31); *(u32x4*)(base + (size_t)row * 384 + c * 8) = z; } }
        }
        for (long i = gt; i < 131072 / 4; i += NGT) { const f32x4 v = *(const f32x4*)(args.in[20] + i * 4); u32x2 w; w.x = cvt_pk_bf16(v[0], v[1]); w.y = cvt_pk_bf16(v[2], v[3]); *(u32x2*)(WSB + i * 4) = w; }
        for (long i = gt; i < 65536; i += NGT) { const int t = (int)(i >> 4), ai = (int)(i & 15), a = ai >> 3, fi = ai & 7;
            const float inv = powf(10000.0f, -(float)(2 * fi) / 16.0f); const float pos = (float)(a == 0 ? (t >> 6) : (t & 63)); const float ang = pos * inv;
            ROPE[i] = cosf(ang); ROPE[65536 + i] = sinf(ang); }
        { const f32x4 z4 = {0.f, 0.f, 0.f, 0.f}; for (long i = gt; i < (long)12 * MTOK / 4; i += NGT) *(f32x4*)(RSS + i * 4) = z4;
          for (long i = gt; i < (long)2 * MTOK / 4; i += NGT) *(f32x4*)(VSS + i * 4) = z4; }
    }
    grid.sync();
    xbar = xcd_barrier_post(BARW, MISC);
    ++pid;
    for (int rep1 = 0; rep1 < ((DUPMASK & 2) ? 2 : 1); ++rep1)
    if (pid >= lo && pid < hi) {
        DERIVE_PTRS
        for (int ck = gw; ck < 8 * 176 + 2 * 48; ck += NGW) {
            const bf16_t* __restrict__ wbase; const float* shp; float* __restrict__ outp; int cvs;
            if (ck < 8 * 176) { const int ls = ck / 176, n0 = (ck - ls * 176) * 32, l = ls >> 1, sub = ls & 1; wbase = W13 + ((size_t)ls * 5632 + n0) * 1024;
                shp = MOD + (size_t)l * 9 * NMOD + (sub ? 6 : 0) * 1024; outp = B13 + (size_t)ls * 9 * 5632 + n0; cvs = 5632; }
            else { const int q = ck - 8 * 176, jj = q / 48, n0 = (q - jj * 48) * 32; wbase = WIN + ((size_t)jj * 1536 + n0) * 1024;
                shp = MOD + (size_t)(2 * jj) * 9 * NMOD + 3 * 1024; outp = BIN + (size_t)jj * 9 * 1536 + n0; cvs = 1536; }
            f32x4 sh[9][4];
#pragma unroll
            for (int cv = 0; cv < 9; ++cv) { const float* sp = shp + (size_t)cv * NMOD;
                sh[cv][0] = *(const f32x4*)(sp + lane * 8); sh[cv][1] = *(const f32x4*)(sp + lane * 8 + 4); sh[cv][2] = *(const f32x4*)(sp + 512 + lane * 8); sh[cv][3] = *(const f32x4*)(sp + 512 + lane * 8 + 4); }
#pragma unroll 2
            for (int r = 0; r < 32; ++r) {
                const u32x4 w0 = *(const u32x4*)(wbase + (size_t)r * 1024 + lane * 8), w1 = *(const u32x4*)(wbase + (size_t)r * 1024 + 512 + lane * 8);
                const f32x4 wa = {bflo(w0[0]), bfhi(w0[0]), bflo(w0[1]), bfhi(w0[1])}, wb = {bflo(w0[2]), bfhi(w0[2]), bflo(w0[3]), bfhi(w0[3])};
                const f32x4 wc2 = {bflo(w1[0]), bfhi(w1[0]), bflo(w1[1]), bfhi(w1[1])}, wd = {bflo(w1[2]), bfhi(w1[2]), bflo(w1[3]), bfhi(w1[3])};
                float res = 0.f;
#pragma unroll
                for (int cv = 0; cv < 9; ++cv) { const f32x4 p = sh[cv][0] * wa + sh[cv][1] * wb + sh[cv][2] * wc2 + sh[cv][3] * wd;
                    float a2 = (p[0] + p[1]) + (p[2] + p[3]); a2 = wave_sum(a2); if (lane == cv) res = a2; }
                if (lane < 9) outp[(size_t)lane * cvs + r] = res;
            }
        }
        for (int rb = gw; rb < MTOK; rb += 2 * NGW) {
            f32x4 v[2][4]; float ss[2]; int rr[2];
#pragma unroll
            for (int u2 = 0; u2 < 2; ++u2) { const int r = (rb + u2 * NGW < MTOK) ? rb + u2 * NGW : rb; rr[u2] = r;
                const float* xr = r < NCTX ? args.in[0] + (size_t)r * 1024 : args.in[1] + (size_t)(r - NCTX) * 1024; ss[u2] = 0.f;
#pragma unroll
                for (int q = 0; q < 4; ++q) { v[u2][q] = *(const f32x4*)(xr + 4 * lane + 256 * q); ss[u2] += (v[u2][q][0] * v[u2][q][0] + v[u2][q][1] * v[u2][q][1]) + (v[u2][q][2] * v[u2][q][2] + v[u2][q][3] * v[u2][q][3]); } }
#pragma unroll
            for (int u2 = 0; u2 < 2; ++u2) { if (u2 == 1 && rb + NGW >= MTOK) break; const int r = rr[u2]; const int cv = cv_of_row(r);
                const float* scp = MOD + (size_t)cv * NMOD + 1024; const float* gptr = args.in[8];
                const float st = wave_sum(ss[u2]); if (lane == 0) RSS[r] = st;
#pragma unroll
                for (int q = 0; q < 4; ++q) { const int c = 4 * lane + 256 * q; const f32x4 g4 = *(const f32x4*)(gptr + c), sc = *(const f32x4*)(scp + c);
                    *(f32x4*)(X + (size_t)r * 1024 + c) = v[u2][q];
                    const f32x4 hh = v[u2][q] * g4 * (sc + 1.0f); u32x2 w; w.x = cvt_pk_bf16(hh[0], hh[1]); w.y = cvt_pk_bf16(hh[2], hh[3]);
                    *(u32x2*)(H + (size_t)r * 1024 + c) = w; } }
        }
        if (pid + 1 < hi) xcd_barrier(xbar);
    }
    ++pid;

    for (int layer = 0; layer < 4; ++layer) {
        const int j = layer >> 1;
        const unsigned long long prog = (layer & 1) ? 0xDCFE32ull : 0xDCA9876532ull;
        const int nsteps = (layer & 1) ? 6 : 10;
        for (int step = 0; step < nsteps; ++step, ++pid) {
            if (!(pid >= lo && pid < hi)) continue;
            const int op = (int)((prog >> (4 * step)) & 15ull);
            const int reps = ((DUPMASK >> op) & 1) ? 2 : 1;
            for (int rep = 0; rep < reps; ++rep) {
            DERIVE_PTRS
            int bid = blockIdx.x; asm volatile("" : "+s"(bid)); int G = gridDim.x; asm volatile("" : "+s"(G));
            const int NGW = G * 8; const long NGT = (long)G * 512;
            const float* MODL = MOD + (size_t)layer * 9 * NMOD;
            tid = threadIdx.x; asm volatile("" : "+v"(tid)); lane = tid & 63; wave = __builtin_amdgcn_readfirstlane(tid >> 6); gw = bid * 8 + wave; gt = (long)bid * 512 + tid;
            if (EN_G1 && (op == 2 || op == 12)) {
                const int sub = op == 2 ? 0 : 1;
                const bf16_t* Ain = (sub == 1 && !(layer & 1)) ? H2 : H;
                pg8::Gemm g{Ain, W13 + (size_t)(layer * 2 + sub) * 5632 * 1024, MTOK, 5632, 1024, 1024, 1024, 0};
                pg8::StaticOrder S; S.init(MTOK, 5632, G, bid);
                pg8::EpiSwiglu E{U, RSS + (size_t)(layer * 3 + (sub ? 2 : 0)) * MTOK, B13 + (size_t)(layer * 2 + sub) * 9 * 5632};
                pg8::gemm_phase<pg8::EpiSwiglu>((LAS unsigned char*)lds, g, S, E);
            } else if (EN_GRES && (op == 3 || op == 13 || op == 10 || op == 15)) {
                const bf16_t* gA; const bf16_t* gB; int gK, glda, gldb, gapn; const float* egate; const float* escale; float ecoef;
                if (op == 3 || op == 13) { const int sub = op == 3 ? 0 : 1; gA = U; gB = W2 + (size_t)(layer * 2 + sub) * 1024 * FF; gK = FF; glda = FF; gldb = FF; gapn = 0;
                    egate = MODL + (sub ? 8 : 2) * 1024; escale = nullptr; ecoef = 0.5f; }
                else if (op == 10) { gA = MIX; gB = WOUT + (size_t)j * 1024 * 1024; gK = 1024; glda = 1024; gldb = 1024; gapn = 0; egate = MODL + 5 * 1024; escale = nullptr; ecoef = 1.0f; }
                else { gA = PB; gB = POOLT + (size_t)j * 1024 * 256; gK = 256; glda = 1024; gldb = 256; gapn = 512; egate = MODL + 5 * 1024; escale = args.in[24] + (size_t)j * 1024; ecoef = 1.0f; }
                int ln = layer, kn; bf16_t* an = H;
                if (op == 3) kn = 1; else if (op == 13) { ln = layer + 1; kn = 0; } else { kn = 2; if (op == 10) an = H2; }
                if (ln >= 4) { an = nullptr; ln = 0; }
                const pg8::Gemm g{gA, gB, MTOK, 1024, gK, glda, gldb, gapn};
                const pg8::EpiResid E{X, egate, escale, an, args.in[8] + ((size_t)ln * 3 + kn) * 1024, MOD + (size_t)ln * 9 * NMOD + (3 * kn + 1) * 1024, RSS + (size_t)(ln * 3 + kn) * MTOK, ecoef, 0};
                pg8::StaticOrder S; S.init(MTOK, 1024, G, bid, 1);
                pg8::gemm_phase<pg8::EpiResid, true>((LAS unsigned char*)lds, g, S, E);
            } else if (EN_GRAW && (op == 5 || op == 7)) {
                const bool gin = op == 5;
                const pg8::Gemm g{gin ? (const bf16_t*)H : (const bf16_t*)QKVLAT, gin ? WIN + (size_t)j * 1536 * 1024 : WQKV + (size_t)j * 1792 * 384, gin ? MTOK : MEXT, gin ? 1536 : 1792, gin ? 1024 : 384, gin ? 1024 : 384, gin ? 1024 : 384, 0};
                const pg8::EpiRaw E{PROJ, gin ? GM : QKV, gin ? RSS + (size_t)(layer * 3 + 1) * MTOK : (const float*)nullptr, BIN + (size_t)j * 9 * 1536, gin ? VSS + (size_t)j * MTOK : (float*)nullptr, 512, gin ? 2 : 0, gin ? 1024 : QLD, gin ? 1 : 0};
                pg8::StaticOrder S; S.init(gin ? MTOK : MEXT, gin ? 1536 : 1792, G, bid);
                pg8::gemm_phase<pg8::EpiRaw>((LAS unsigned char*)lds, g, S, E);
            } else if (EN_POST1 && op == 6) {
                {
                    LAS float* rs = (LAS float*)lds; LAS bf16_t* tT = (LAS bf16_t*)(lds + 1024);
                    const float* vn = args.in[19] + (size_t)j * 512; const float* gb = args.in[21] + (size_t)j * 512;
                    for (int item = bid; item < 1280; item += G) {
                        const int chunk = item >> 2, gq = item & 3; const size_t tok0 = (size_t)chunk * 128;
                        if (tid < 128) rs[tid] = __builtin_amdgcn_rsqf(VSS[(size_t)j * MTOK + tok0 + tid] * (1.0f / 512.0f) + EPS);
                        __syncthreads();
                        { const int q = tid >> 2, cp = tid & 3; const float rq = rs[q];
#pragma unroll
                          for (int cc = 0; cc < 4; ++cc) { const int c0 = cp * 32 + cc * 8; const u32x4 w = *(const u32x4*)(GM + (tok0 + q) * 1024 + 512 + gq * 128 + c0);
                              const f32x4 n0 = *(const f32x4*)(vn + gq * 128 + c0), n1 = *(const f32x4*)(vn + gq * 128 + c0 + 4);
                              float v[8] = {bflo(w[0]) * n0[0], bfhi(w[0]) * n0[1], bflo(w[1]) * n0[2], bfhi(w[1]) * n0[3], bflo(w[2]) * n1[0], bfhi(w[2]) * n1[1], bflo(w[3]) * n1[2], bfhi(w[3]) * n1[3]};
#pragma unroll
                              for (int e = 0; e < 8; ++e) tT[(c0 + e) * 136 + q] = (bf16_t)(cvt_pk_bf16(v[e] * rq, 0.f) & 0xffffu); } }
                        __syncthreads();
                        const int p = wave * 16 + (lane & 15); const size_t tok = tok0 + p; const float bsp = gb[gq * 128 + p];
                        u32x2 uu[8];
#pragma unroll
                        for (int n = 0; n < 8; ++n) uu[n] = *(const u32x2*)(GM + tok * 1024 + gq * 128 + 16 * n + 4 * (lane >> 4));
                        f32x4 acc[8];
#pragma unroll
                        for (int n = 0; n < 8; ++n) acc[n] = (f32x4){0.f, 0.f, 0.f, 0.f};
                        const bf16_t* wsp = WSB + ((size_t)(j * 4 + gq) * 128 + wave * 16 + (lane & 15)) * 128 + 8 * (lane >> 4);
#pragma unroll
                        for (int ks = 0; ks < 4; ++ks) { const bf16x8 a = *(const bf16x8*)(wsp + 32 * ks);
#pragma unroll
                            for (int n = 0; n < 8; ++n) { const bf16x8 b = *(const LAS bf16x8*)(tT + (16 * n + (lane & 15)) * 136 + 32 * ks + 8 * (lane >> 4));
                                acc[n] = __builtin_amdgcn_mfma_f32_16x16x32_bf16(b, a, acc[n], 0, 0, 0); } }
                        {
#pragma unroll
                          for (int n = 0; n < 8; ++n) { u32x2 w; w.x = cvt_pk_bf16(bflo(uu[n].x) * (acc[n][0] + bsp), bfhi(uu[n].x) * (acc[n][1] + bsp)); w.y = cvt_pk_bf16(bflo(uu[n].y) * (acc[n][2] + bsp), bfhi(uu[n].y) * (acc[n][3] + bsp));
                              *(u32x2*)(MIX + tok * 1024 + 512 + gq * 128 + 16 * n + 4 * (lane >> 4)) = w; } }
                        __syncthreads();
                    }
                }
                const float* qan = args.in[13] + (size_t)j * 256; const float* kvan = args.in[14] + (size_t)j * 128;
                for (int r = gw; r < MTOK; r += 4 * NGW) {
                    const int r1 = r + NGW, r2 = r + 2 * NGW, r3 = r + 3 * NGW; const bool has1 = r1 < MTOK, has2 = r2 < MTOK, has3 = r3 < MTOK;
                    P1Row p0, p1, p2, p3; p1_load(p0, PROJ + (size_t)r * 512, lane); p1_load(p1, PROJ + (size_t)(has1 ? r1 : r) * 512, lane);
                    p1_load(p2, PROJ + (size_t)(has2 ? r2 : r) * 512, lane); p1_load(p3, PROJ + (size_t)(has3 ? r3 : r) * 512, lane);
                    p1_finish(p0, r, j, lane, qan, kvan, QKVLAT, KROPE, OUT_CKV, OUT_KR); if (has1) p1_finish(p1, r1, j, lane, qan, kvan, QKVLAT, KROPE, OUT_CKV, OUT_KR);
                    if (has2) p1_finish(p2, r2, j, lane, qan, kvan, QKVLAT, KROPE, OUT_CKV, OUT_KR); if (has3) p1_finish(p3, r3, j, lane, qan, kvan, QKVLAT, KROPE, OUT_CKV, OUT_KR);
                }
                for (int cidx = gw; cidx < 4096; cidx += NGW) {
                    const int b = cidx >> 9, p = cidx & 511; const int e = NCTX + b * KVB + LLAT + p;
                    const u32x2 z = {0u, 0u}; *(u32x2*)(QKVLAT + (size_t)e * 384 + 4 * lane) = z;
                    if (lane < 32) { const f32x4 kv = *(const f32x4*)(args.in[2] + (((size_t)b * 2 + j) * 512 + p) * 128 + 4 * lane); u32x2 w2; w2.x = cvt_pk_bf16(kv[0], kv[1]); w2.y = cvt_pk_bf16(kv[2], kv[3]);
                        *(u32x2*)(QKVLAT + (size_t)e * 384 + 256 + 4 * lane) = w2; }
                }
            } else if (EN_POST2 && op == 8) {
                const float* qn = args.in[17] + (size_t)j * 96; const float* kn = args.in[18] + (size_t)j * 96;
                const int hh = lane >> 3, s = lane & 7;
                for (int e = gw; e < MEXT; e += 2 * NGW) {
                    const int e1 = e + NGW; const bool has1 = e1 < MEXT;
                    P2Row r0, r1;
                    p2_load(r0, e, j, hh, s, QKV, KROPE, args.in[3]); p2_load(r1, has1 ? e1 : e, j, hh, s, QKV, KROPE, args.in[3]);
                    p2_compute(r0, s, qn, kn, ROPE); p2_compute(r1, s, qn, kn, ROPE);
                    asm volatile("s_waitcnt vmcnt(0)" ::: "memory");
                    p2_store(r0, hh, s, QKV); if (has1) p2_store(r1, hh, s, QKV);
                    asm volatile("" ::: "memory");
                }
            } else if (EN_ATT && op == 9) {
                const int vcu = (G % 8 == 0) ? (bid % 8) * (G / 8) + bid / 8 : bid;
                for (int u = vcu; u < 1280; u += G) {
                    const bf16_t *Qb, *Kh, *Vh; bf16_t* Ob; int seq;
                    if (u < 1024) { const int bh = u >> 4, qt = u & 15, b = bh >> 3, h = bh & 7; const size_t e0 = NCTX + (size_t)b * KVB;
                        Qb = QKV + (e0 + qt * 256) * QLD + h * 96; Kh = QKV + e0 * QLD + 768 + h * 96; Vh = QKV + e0 * QLD + 1536 + h * 64;
                        Ob = MIX + ((size_t)NCTX + (size_t)b * LLAT + qt * 256) * 1024 + h * 64; seq = KVB; }
                    else { const int vv = u - 1024, b = vv >> 3, h = vv & 7; const size_t e0 = (size_t)b * 256;
                        Qb = QKV + e0 * QLD + h * 96; Kh = QKV + e0 * QLD + 768 + h * 96; Vh = QKV + e0 * QLD + 1536 + h * 64; Ob = MIX + e0 * 1024 + h * 64; seq = 256; }
                    __syncthreads();
                    att::attn_unit(Qb, Kh, Vh, Ob, seq, (char*)lds);
                }
            } else if (EN_POOL && op == 14) {
                const float* rs = RSS + (size_t)(layer * 3 + 1) * MTOK;
                for (long i = gt; i < (long)(MTOK / 32) * 128; i += NGT) {
                    const int seg = (int)(i >> 7), ch = (int)(i & 127), hw = 1 << (ch >> 5);
                    const int r0 = seg * 32; int t0, L; if (r0 < NCTX) { t0 = r0 & 255; L = 256; } else { t0 = (r0 - NCTX) & 4095; L = 4096; }
                    const int base = r0 - t0; const bf16_t* __restrict__ hp = H + (size_t)base * 1024 + ch * 8; const float* __restrict__ rsp = rs + base; bf16_t* __restrict__ pbp = PB + (size_t)base * 1024 + ch * 8;
                    float sum[8];
#pragma unroll
                    for (int e2 = 0; e2 < 8; ++e2) sum[e2] = 0.f;
#define POOL_LD(tt, wgt) do { const u32x4 w_ = *(const u32x4*)(hp + (size_t)(tt) * 1024); const float q_ = (wgt) * __builtin_amdgcn_rsqf(rsp[tt] * (1.0f / 1024.0f) + EPS); \
                        _Pragma("unroll") for (int e2 = 0; e2 < 4; ++e2) { sum[2 * e2] += bflo(w_[e2]) * q_; sum[2 * e2 + 1] += bfhi(w_[e2]) * q_; } } while (0)
#pragma unroll
                    for (int i2 = 0; i2 < 16; ++i2) { const int tt = t0 - hw + i2; const bool ok = (i2 < 2 * hw) && tt >= 0; const int tc = tt < 0 ? 0 : (tt > L - 1 ? L - 1 : tt); POOL_LD(tc, ok ? 1.0f : 0.0f); }
#pragma unroll 4
                    for (int t = t0; t < t0 + 32; ++t) {
                        const int lo2 = t - hw < 0 ? 0 : t - hw, hi2 = t + hw > L ? L : t + hw; const float inv = 1.0f / (float)(hi2 - lo2);
                        const u32x4 w0 = *(const u32x4*)(hp + (size_t)t * 1024); const float q0 = __builtin_amdgcn_rsqf(rsp[t] * (1.0f / 1024.0f) + EPS); u32x4 o;
#pragma unroll
                        for (int e2 = 0; e2 < 4; ++e2) o[e2] = cvt_pk_bf16(sum[2 * e2] * inv - bflo(w0[e2]) * q0, sum[2 * e2 + 1] * inv - bfhi(w0[e2]) * q0);
                        *(u32x4*)(pbp + (size_t)t * 1024) = o;
                        { const int tp = t + hw, tm = t - hw; const int tpc = tp > L - 1 ? L - 1 : tp, tmc = tm < 0 ? 0 : tm;
                          POOL_LD(tpc, tp < L ? 1.0f : 0.0f); POOL_LD(tmc, tm >= 0 ? -1.0f : 0.0f); }
                    }
#undef POOL_LD
                }
            }
            if (rep + 1 < reps || pid + 1 < hi) xcd_barrier(xbar);
            }
        }
    }
}

extern "C" void kernel_launch(void* const* d_in, const int* in_sizes, int n_in, void* d_out, int out_size, void* d_ws, size_t ws_size, hipStream_t stream) {
    static int grid = 0;
    if (grid == 0) {
        if (n_in != 25 || ws_size < WS_NEED) { fprintf(stderr, "kernel_launch: n_in %d ws %zu (need %zu)\n", n_in, ws_size, (size_t)WS_NEED); grid = -1; return; }
        int dev = 0, cus = 0, per_cu = 0;
        hipGetDevice(&dev); hipDeviceGetAttribute(&cus, hipDeviceAttributeMultiprocessorCount, dev);
        if (hipFuncSetAttribute((const void*)fwd_mega, hipFuncAttributeMaxDynamicSharedMemorySize, LDS_BYTES) != hipSuccess) { fprintf(stderr, "kernel_launch: hipFuncSetAttribute failed\n"); grid = -1; return; }
        if (hipOccupancyMaxActiveBlocksPerMultiprocessor(&per_cu, (const void*)fwd_mega, 512, LDS_BYTES) != hipSuccess || per_cu < 1) { fprintf(stderr, "kernel_launch: occupancy query gave %d\n", per_cu); per_cu = 1; }
        (void)hipGetLastError();
        grid = cus * per_cu;
    }
    if (grid < 0) return;
    Args a{};
    for (int i = 0; i < 25; ++i) a.in[i] = (const float*)d_in[i];
    a.out = (float*)d_out; a.ws = (unsigned char*)d_ws; a.ph_lo = 0; a.ph_hi = 34;
    void* kargs[] = {&a};
    hipError_t e = hipLaunchCooperativeKernel((const void*)fwd_mega, dim3(grid), dim3(512), kargs, LDS_BYTES, stream);
    if (e != hipSuccess) fprintf(stderr, "kernel_launch: cooperative launch failed: %s (grid %d)\n", hipGetErrorString(e), grid);
}
```

```cpp
#include <hip/hip_runtime.h>
#include <hip/hip_cooperative_groups.h>
#include <cstdio>
#include <cstdint>
namespace cg = cooperative_groups;
#ifndef EN_NORM
#define EN_NORM 1
#endif
#ifndef EN_G1
#define EN_G1 1
#endif
#ifndef EN_GRES
#define EN_GRES 1
#endif
#ifndef EN_GRAW
#define EN_GRAW 1
#endif
#ifndef EN_POST1
#define EN_POST1 1
#endif
#ifndef EN_POST2
#define EN_POST2 1
#endif
#ifndef EN_ATT
#define EN_ATT 1
#endif
#ifndef EN_POOL
#define EN_POOL 1
#endif
#ifndef EN_PRO
#define EN_PRO 1
#endif
#ifndef DUPMASK
#define DUPMASK 0
#endif

#define LAS __attribute__((address_space(3)))
typedef unsigned short bf16_t;
typedef short bf16x8 __attribute__((ext_vector_type(8)));
typedef short s16x4 __attribute__((ext_vector_type(4)));
typedef float f32x4 __attribute__((ext_vector_type(4)));
typedef float f32x16 __attribute__((ext_vector_type(16)));
typedef unsigned u32x4 __attribute__((ext_vector_type(4)));
typedef unsigned u32x2 __attribute__((ext_vector_type(2)));

constexpr int DM = 1024, FF = 2816, MTOK = 40960, MEXT = 45056, NCTX = 8192, LLAT = 4096, PAST = 512, KVB = 4608;
constexpr int NMOD = 9216;
constexpr int QLD = 2048;
constexpr float EPS = 1e-6f;
constexpr size_t SZ_W13 = (size_t)8 * 5632 * 1024 * 2, SZ_W2 = (size_t)8 * 1024 * 2816 * 2, SZ_WIN = (size_t)2 * 1536 * 1024 * 2,
                 SZ_WQKV = (size_t)2 * 1792 * 384 * 2, SZ_WOUT = (size_t)2 * 1024 * 1024 * 2, SZ_POOLT = (size_t)2 * 1024 * 256 * 2,
                 SZ_WS = (size_t)2 * 4 * 128 * 128 * 2, SZ_MOD = (size_t)4 * 9 * NMOD * 4, SZ_ROPE = (size_t)2 * 4096 * 16 * 4,
                 SZ_H = (size_t)MTOK * 1024 * 2;
constexpr size_t OFF_W13 = 0, OFF_W2 = OFF_W13 + SZ_W13, OFF_WIN = OFF_W2 + SZ_W2, OFF_WQKV = OFF_WIN + SZ_WIN, OFF_WOUT = OFF_WQKV + SZ_WQKV,
                 OFF_POOLT = OFF_WOUT + SZ_WOUT, OFF_WS = OFF_POOLT + SZ_POOLT, OFF_MOD = OFF_WS + SZ_WS, OFF_ROPE = OFF_MOD + SZ_MOD,
                 OFF_H = OFF_ROPE + SZ_ROPE, OFF_R = OFF_H + SZ_H;
constexpr size_t R_QKVLAT = 0, R_KROPE = (size_t)MEXT * 384 * 2, R_PROJ = 41943040, R_GM = R_PROJ + (size_t)MTOK * 512 * 4,
                 R_QKVRAW = R_PROJ, SZ_R = SZ_H + (size_t)MTOK * 2816 * 2;
static_assert(R_KROPE + (size_t)MTOK * 32 * 4 <= R_PROJ, "ws map");
static_assert(R_QKVRAW + (size_t)MEXT * QLD * 2 <= SZ_R, "ws map");
constexpr size_t OFF_CTL = OFF_R + SZ_R, SZ_CTL = 16384;
constexpr size_t OFF_RSS = OFF_CTL + SZ_CTL, SZ_RSS = (size_t)12 * MTOK * 4;
constexpr size_t OFF_B13 = OFF_RSS + SZ_RSS, SZ_B13 = (size_t)8 * 9 * 5632 * 4;
constexpr size_t OFF_BIN = OFF_B13 + SZ_B13, SZ_BIN = (size_t)2 * 9 * 1536 * 4;
constexpr size_t R_U = SZ_H;
static_assert(R_U + (size_t)MTOK * 2816 * 2 <= SZ_R, "ws map");
constexpr size_t OFF_VSS = OFF_BIN + SZ_BIN, SZ_VSS = (size_t)2 * MTOK * 4;
constexpr size_t WS_NEED = OFF_VSS + SZ_VSS;

__device__ __forceinline__ unsigned cvt_pk_bf16(float lo, float hi) { unsigned r; asm volatile("v_cvt_pk_bf16_f32 %0, %1, %2" : "=v"(r) : "v"(lo), "v"(hi)); return r; }
__device__ __forceinline__ float bf2f(unsigned short b) { return __uint_as_float(((unsigned)b) << 16); }
__device__ __forceinline__ float bflo(unsigned w) { return __uint_as_float(w << 16); }
__device__ __forceinline__ float bfhi(unsigned w) { return __uint_as_float(w & 0xffff0000u); }
__device__ __forceinline__ float wave_sum(float v) {
#pragma unroll
    for (int o = 1; o < 64; o <<= 1) v += __shfl_xor(v, o);
    return v;
}
__device__ __forceinline__ float fast_sigmoid(float x) { return __builtin_amdgcn_rcpf(1.0f + __builtin_amdgcn_exp2f(-1.4426950408889634f * x)); }
__device__ __forceinline__ float silu_f(float x) { return x * fast_sigmoid(x); }
__device__ __forceinline__ float gelu_tanh_f(float x) { const float y = 0.7978845608028654f * (x + 0.044715f * x * x * x); return x * fast_sigmoid(2.0f * y); }
__device__ __forceinline__ f32x4 sigmoid4(f32x4 x) {
    const f32x4 t = x * -1.4426950408889634f; f32x4 e;
#pragma unroll
    for (int i = 0; i < 4; ++i) e[i] = __builtin_amdgcn_exp2f(t[i]);
    const f32x4 d = e + 1.0f; f32x4 r;
#pragma unroll
    for (int i = 0; i < 4; ++i) r[i] = __builtin_amdgcn_rcpf(d[i]);
    return r;
}
__device__ __forceinline__ f32x4 silu4(f32x4 x) { return x * sigmoid4(x); }
__device__ __forceinline__ f32x4 gelu_tanh4(f32x4 x) { const f32x4 y = (x + x * x * x * 0.044715f) * (2.0f * 0.7978845608028654f); return x * sigmoid4(y); }
__device__ __forceinline__ int cv_of_row(int r) { return r < NCTX ? 0 : 1 + ((r - NCTX) >> 12); }

#ifndef PROBE_KREP
#define PROBE_KREP 1
#endif
namespace pg8 {
constexpr int BM = 256, BK = 64, HALF = 128, HTB = HALF * BK * 2, STAGE_BYTES = 8 * HTB, NXCD = 8, WGM = 8;
__host__ __device__ __forceinline__ int lds_byte(int r, int c) { const int st = (r >> 4) * 2 + (c >> 5), rr = r & 15, cc = c & 31, ob = rr * 64 + cc * 2; return st * 1024 + (ob ^ (((ob >> 9) & 1) << 5)); }
__host__ __device__ __forceinline__ void stage_rc(int b, int& R, int& C) { const int st = b / 1024, sb = b % 1024, swz = sb ^ (((sb >> 9) & 1) << 5); R = (st >> 1) * 16 + swz / 64; C = (st & 1) * 32 + (swz % 64) / 2; }
__host__ __device__ __forceinline__ int perm32(int rho) { const int n = rho >> 4, i = rho & 15; return 8 * (i >> 2) + 4 * n + (i & 3); }

struct Unit { int pm, pn, half; };
struct Gemm { const bf16_t* A; const bf16_t* Bt; int M, N, K, lda, ldb, apn, ksp, pad_; };

struct StaticOrder {
    int nM, nN, nwg, G, c, ht;
    __device__ void init(int M, int N, int G_, int c_, int ht_ = 0) { nM = M / BM; nN = N / BM; nwg = nM * nN; G = G_; c = c_; ht = ht_; }
    __device__ bool next(int i, Unit& u) const {
        long L = (long)i * G + c; u.half = -1;
        if (ht) { const int nfull = nwg / G, rem = nwg - nfull * G;
            if (rem > 0 && 2 * rem <= G && i >= nfull) { if (i > nfull || (c >> 1) >= rem) return false; L = (long)nfull * G + (c >> 1); u.half = c & 1; } }
        if (L >= nwg) return false;
        int wgid = (int)L; { const int q = nwg / NXCD, r = nwg % NXCD, xcd = wgid % NXCD, off = wgid / NXCD; wgid = (xcd < r ? xcd * (q + 1) : r * (q + 1) + (xcd - r) * q) + off; }
        const int nig = WGM * nN, gid = wgid / nig, fm = gid * WGM, gsz = (nM - fm) < WGM ? (nM - fm) : WGM;
        u.pm = fm + ((wgid % nig) % gsz); u.pn = (wgid % nig) / gsz; return true;
    }
};

struct EpiSwiglu {
    static constexpr bool PERM = true; static constexpr int KREP = PROBE_KREP;
    bf16_t* U; const float* rss; const float* bias;
    static constexpr bool PREF = true;
    __device__ __forceinline__ bool pref_on() const { return true; }
    __device__ __forceinline__ const float* pref_ptr(const Unit& u, int tid) const { const int cv = u.pm < 32 ? 0 : 1 + ((u.pm - 32) >> 4);
        return tid < 256 ? rss + u.pm * BM + tid : bias + (size_t)cv * 5632 + u.pn * BM + (tid - 256); }
    __device__ __forceinline__ void run(f32x4 (&acc)[2][2][4][2], const Unit& u, int wr, int wc, int fr, int fq, const LAS float* sc) const {
        const int row0 = u.pm * BM + wr * 64 + fr, col0 = u.pn * HALF + wc * 32 + 8 * fq;
        const LAS float* bp = sc + 256 + wc * 32 + 8 * fq;
        const f32x4 ba0 = *(const LAS f32x4*)(bp), ba1 = *(const LAS f32x4*)(bp + 4), bb0 = *(const LAS f32x4*)(bp + HALF), bb1 = *(const LAS f32x4*)(bp + HALF + 4);
#pragma unroll
        for (int ai = 0; ai < 2; ++ai)
#pragma unroll
            for (int m = 0; m < 4; ++m) {
                const int row = row0 + ai * HALF + m * 16;
                bf16_t* rowp = U + (size_t)row * FF + col0;
                const float rstd = (1.0f / (float)KREP) * __builtin_amdgcn_rsqf(sc[ai * HALF + wr * 64 + m * 16 + fr] * (1.0f / 1024.0f) + EPS);
                const f32x4 a0 = acc[ai][0][m][0] * rstd + ba0, a1 = acc[ai][0][m][1] * rstd + ba1, b0 = acc[ai][1][m][0] * rstd + bb0, b1 = acc[ai][1][m][1] * rstd + bb1;
                const f32x4 v0 = silu4(a0) * b0, v1 = silu4(a1) * b1;
                u32x4 w; w.x = cvt_pk_bf16(v0[0], v0[1]); w.y = cvt_pk_bf16(v0[2], v0[3]); w.z = cvt_pk_bf16(v1[0], v1[1]); w.w = cvt_pk_bf16(v1[2], v1[3]);
                *(u32x4*)rowp = w;
            }
    }
};
struct EpiResid {
    static constexpr bool PERM = true; static constexpr int KREP = 1;
    float* X; const float* gate; const float* scale;
    bf16_t* An; const float* gn; const float* scn; float* rssn;
    float coef; int pad_;
    static constexpr bool PREF = false;
    __device__ __forceinline__ bool pref_on() const { return false; }
    __device__ __forceinline__ const float* pref_ptr(const Unit&, int) const { return nullptr; }
    __device__ __forceinline__ void run(f32x4 (&acc)[2][2][4][2], const Unit& u, int wr, int wc, int fr, int fq, const LAS float*) const {
        const int row0 = u.pm * BM + wr * 64 + fr; int col0 = u.pn * BM + wc * 32 + 8 * fq;
        const int cv = u.pm < 32 ? 0 : 1 + ((u.pm - 32) >> 4);
        const bool nx = An != nullptr;
        const int hb = u.half > 0 ? HALF : 0, nbj = u.half < 0 ? 2 : 1;
        col0 += hb;
        f32x4 gv[2][2], gm[2][2];
#pragma unroll
        for (int bj = 0; bj < 2; ++bj)
#pragma unroll
            for (int n = 0; n < 2; ++n) { const int c = col0 + (bj < nbj ? bj : 0) * HALF + 4 * n; f32x4 g = *(const f32x4*)(gate + (size_t)cv * NMOD + c) * coef;
                if (scale) g = g * *(const f32x4*)(scale + c); gv[bj][n] = g;
                gm[bj][n] = nx ? *(const f32x4*)(gn + c) * (*(const f32x4*)(scn + (size_t)cv * NMOD + c) + 1.0f) : (f32x4){0.f, 0.f, 0.f, 0.f}; }
#pragma unroll
        for (int ai = 0; ai < 2; ++ai)
#pragma unroll
            for (int m = 0; m < 4; ++m) { const int row = row0 + ai * HALF + m * 16; float* rowp = X + (size_t)row * DM + col0;
                float ss = 0.f;
#pragma unroll
                for (int bj = 0; bj < 2; ++bj) if (bj < nbj) { f32x4* p = (f32x4*)(rowp + bj * HALF);
                    const f32x4 x0 = __builtin_nontemporal_load(p) + acc[ai][bj][m][0] * gv[bj][0], x1 = __builtin_nontemporal_load(p + 1) + acc[ai][bj][m][1] * gv[bj][1];
                    __builtin_nontemporal_store(x0, p); __builtin_nontemporal_store(x1, p + 1);
                    if (nx) { ss += ((x0[0] * x0[0] + x0[1] * x0[1]) + (x0[2] * x0[2] + x0[3] * x0[3])) + ((x1[0] * x1[0] + x1[1] * x1[1]) + (x1[2] * x1[2] + x1[3] * x1[3]));
                        const f32x4 a0 = x0 * gm[bj][0], a1 = x1 * gm[bj][1]; u32x4 w; w.x = cvt_pk_bf16(a0[0], a0[1]); w.y = cvt_pk_bf16(a0[2], a0[3]); w.z = cvt_pk_bf16(a1[0], a1[1]); w.w = cvt_pk_bf16(a1[2], a1[3]);
                        *(u32x4*)(An + (size_t)row * DM + col0 + bj * HALF) = w; } }
                if (nx) { ss += __shfl_xor(ss, 16); ss += __shfl_xor(ss, 32);
                    if (fq == 0) (void)__hip_atomic_fetch_add(rssn + row, ss, __ATOMIC_RELAXED, __HIP_MEMORY_SCOPE_AGENT); } }
    }
};
struct EpiRaw {
    static constexpr bool PERM = true; static constexpr int KREP = 1;
    float* R; bf16_t* G; const float* rss; const float* bias; float* vss; int ldr, nraw, ldg, act;
    static constexpr bool PREF = true;
    __device__ __forceinline__ bool pref_on() const { return rss != nullptr; }
    __device__ __forceinline__ const float* pref_ptr(const Unit& u, int tid) const { const int cv = u.pm < 32 ? 0 : 1 + ((u.pm - 32) >> 4);
        return tid < 256 ? rss + u.pm * BM + tid : bias + (size_t)cv * 1536 + u.pn * BM + (tid - 256); }
    __device__ __forceinline__ void run(f32x4 (&acc)[2][2][4][2], const Unit& u, int wr, int wc, int fr, int fq, const LAS float* sc) const {
        const int row0 = u.pm * BM + wr * 64 + fr, cw = wc * 32 + 8 * fq;
        if (rss) {
            f32x4 bv[2][2];
#pragma unroll
            for (int bj = 0; bj < 2; ++bj)
#pragma unroll
                for (int n = 0; n < 2; ++n) bv[bj][n] = *(const LAS f32x4*)(sc + 256 + cw + bj * HALF + 4 * n);
#pragma unroll
            for (int ai = 0; ai < 2; ++ai)
#pragma unroll
                for (int m = 0; m < 4; ++m) { const float rstd = __builtin_amdgcn_rsqf(sc[ai * HALF + wr * 64 + m * 16 + fr] * (1.0f / 1024.0f) + EPS);
#pragma unroll
                    for (int bj = 0; bj < 2; ++bj)
#pragma unroll
                        for (int n = 0; n < 2; ++n) acc[ai][bj][m][n] = acc[ai][bj][m][n] * rstd + bv[bj][n]; }
        }
        if (u.pn < nraw) {
#pragma unroll
            for (int ai = 0; ai < 2; ++ai)
#pragma unroll
                for (int m = 0; m < 4; ++m) { float* rowp = R + (size_t)(row0 + ai * HALF + m * 16) * ldr + u.pn * BM + cw;
#pragma unroll
                    for (int bj = 0; bj < 2; ++bj) { *(f32x4*)(rowp + bj * HALF) = acc[ai][bj][m][0]; *(f32x4*)(rowp + bj * HALF + 4) = acc[ai][bj][m][1]; } }
        } else {
            const bool dovs = vss != nullptr && (u.pn - nraw) >= 2;
#pragma unroll
            for (int ai = 0; ai < 2; ++ai)
#pragma unroll
                for (int m = 0; m < 4; ++m) { bf16_t* rowp = G + (size_t)(row0 + ai * HALF + m * 16) * ldg + (u.pn - nraw) * BM + cw; float vs = 0.f;
#pragma unroll
                    for (int bj = 0; bj < 2; ++bj) { f32x4 v0 = acc[ai][bj][m][0], v1 = acc[ai][bj][m][1];
                        if (act) { v0 = gelu_tanh4(v0); v1 = gelu_tanh4(v1); }
                        vs += ((v0[0] * v0[0] + v0[1] * v0[1]) + (v0[2] * v0[2] + v0[3] * v0[3])) + ((v1[0] * v1[0] + v1[1] * v1[1]) + (v1[2] * v1[2] + v1[3] * v1[3]));
                        u32x4 w; w.x = cvt_pk_bf16(v0[0], v0[1]); w.y = cvt_pk_bf16(v0[2], v0[3]); w.z = cvt_pk_bf16(v1[0], v1[1]); w.w = cvt_pk_bf16(v1[2], v1[3]);
                        *(u32x4*)(rowp + bj * HALF) = w; }
                    if (dovs) { vs += __shfl_xor(vs, 16); vs += __shfl_xor(vs, 32);
                        if (fq == 0) (void)__hip_atomic_fetch_add(vss + row0 + ai * HALF + m * 16, vs, __ATOMIC_RELAXED, __HIP_MEMORY_SCOPE_AGENT); } }
        }
    }
};

template <class Epi, bool HT = false>
__device__ __forceinline__ void gemm_phase(LAS unsigned char* lds, const Gemm g, const StaticOrder S, const Epi E) {
    int tid = threadIdx.x; asm volatile("" : "+v"(tid));
    const int wid = __builtin_amdgcn_readfirstlane(tid >> 6), lane = tid & 63, wr = wid >> 2, wc = wid & 3, fr = lane & 15, fq = lane >> 4;
    const int nt = g.K / BK;
#define PG8_NT(u) (g.ksp ? ((u).pn < g.ksp ? 4 : 2) : nt)
#define PG8_KO(u) ((size_t)(g.ksp ? ((u).pn < g.ksp ? 0 : 512) : 0))
    unsigned voffA[2], voffB[2];
#pragma unroll
    for (int i = 0; i < 2; ++i) { int R, C; stage_rc(tid * 16 + i * 8192, R, C); const int Rb = Epi::PERM ? ((R & ~31) + perm32(R & 31)) : R;
        voffA[i] = (unsigned)(R * g.lda + C) * 2u; voffB[i] = (unsigned)(Rb * g.ldb + C) * 2u; }
    const size_t kstep = (size_t)(BK * 2);
    const size_t hstepA = (size_t)HALF * g.lda * 2, hstepB = (size_t)HALF * g.ldb * 2;
    const size_t tstepA = 2 * hstepA, tstepB = 2 * hstepB;
    const unsigned ldsw = (unsigned)wid * 1024u;
    const int aoff = lds_byte(wr * 64 + fr, fq * 8), boff = lds_byte(wc * 32 + fr, fq * 8);
#define PG8_SA(b, h) (((b) * 2 + (h)) * HTB)
#define PG8_SB(b, h) ((4 + (b) * 2 + (h)) * HTB)
#define PG8_STAGE(bufoff, gbase, voff) do { _Pragma("unroll") for (int _i = 0; _i < 2; ++_i) \
        __builtin_amdgcn_global_load_lds((const unsigned*)((const char*)(gbase) + (voff)[_i]), (LAS unsigned*)(lds + (bufoff) + ldsw + _i * 8192), 16, 0, 0); } while (0)
#define PG8_LDA(dst, b, h) do { _Pragma("unroll") for (int m = 0; m < 4; ++m) _Pragma("unroll") for (int k = 0; k < 2; ++k) dst[m][k] = *(const LAS bf16x8*)(lds + PG8_SA(b, h) + aoff + m * 2048 + k * 1024); } while (0)
#define PG8_LDB(dst, b, h) do { _Pragma("unroll") for (int n = 0; n < 2; ++n) _Pragma("unroll") for (int k = 0; k < 2; ++k) dst[n][k] = *(const LAS bf16x8*)(lds + PG8_SB(b, h) + boff + n * 2048 + k * 1024); } while (0)
#define PG8_MMA(ai, bj, At, Bt) do { __builtin_amdgcn_s_setprio(1); _Pragma("unroll") for (int m = 0; m < 4; ++m) _Pragma("unroll") for (int n = 0; n < 2; ++n) _Pragma("unroll") for (int k = 0; k < 2; ++k) \
        acc[ai][bj][m][n] = __builtin_amdgcn_mfma_f32_16x16x32_bf16(Bt[n][k], At[m][k], acc[ai][bj][m][n], 0, 0, 0); __builtin_amdgcn_s_setprio(0); } while (0)
#define PG8_WAIT_V(n) asm volatile("s_waitcnt vmcnt(" #n ")" ::: "memory")
#define PG8_WAIT_L(n) asm volatile("s_waitcnt lgkmcnt(" #n ")" ::: "memory")
#define PG8_BAR __builtin_amdgcn_s_barrier()
#define PG8_SCHED __builtin_amdgcn_sched_barrier(0)
    Unit cur, nxt; int ui = 0;
    if (!S.next(0, cur)) return;
    constexpr int EPI_LDS = 131328;
#define PG8_PREF(u) do { if (Epi::PREF && E.pref_on()) __builtin_amdgcn_global_load_lds((const unsigned*)E.pref_ptr(u, tid), (LAS unsigned*)(lds + EPI_LDS + (ui & 1) * 2048 + wid * 256), 4, 0, 0); } while (0)
    PG8_PREF(cur);
    f32x4 acc[2][2][4][2];
#pragma unroll
    for (int a = 0; a < 2; ++a)
#pragma unroll
        for (int b = 0; b < 2; ++b)
#pragma unroll
            for (int m = 0; m < 4; ++m)
#pragma unroll
                for (int n = 0; n < 2; ++n) acc[a][b][m][n] = (f32x4){0.f, 0.f, 0.f, 0.f};
    bf16x8 At[4][2], B0[2][2], B1[2][2];
    const char* cA = (const char*)g.A + (size_t)cur.pm * tstepA + (size_t)cur.pn * g.apn + PG8_KO(cur); const char* cB = (const char*)g.Bt + (size_t)cur.pn * tstepB + ((HT && cur.half > 0) ? hstepB : 0) + PG8_KO(cur);
    int ntc = PG8_NT(cur);
    size_t hBc = (HT && cur.half >= 0) ? 0 : hstepB;
    PG8_STAGE(PG8_SB(0, 0), cB, voffB); PG8_STAGE(PG8_SB(0, 1), cB + hBc, voffB); PG8_STAGE(PG8_SA(0, 0), cA, voffA); PG8_STAGE(PG8_SA(0, 1), cA + hstepA, voffA);
    if (wr == 1) PG8_BAR;
    PG8_WAIT_V(2); PG8_BAR;
    PG8_STAGE(PG8_SB(1, 0), cB + kstep, voffB); PG8_STAGE(PG8_SA(1, 0), cA + kstep, voffA); PG8_STAGE(PG8_SB(1, 1), cB + hBc + kstep, voffB);
    PG8_WAIT_V(6); PG8_BAR;
#define PG8_KBODY(B1ON) \
        for (int t = 0, tk = 0; t < ntc * Epi::KREP; t += 2) { \
            const bool last = (t == ntc * Epi::KREP - 2); \
            const int tk2 = (tk + 2 >= ntc) ? tk + 2 - ntc : tk + 2; \
            const char* a1 = cA + (size_t)(tk + 1) * kstep; \
            const char* a2 = last ? nA : cA + (size_t)tk2 * kstep; const char* b2 = last ? nB : cB + (size_t)tk2 * kstep; const size_t hb2 = last ? nhB : hBc; tk = tk2; \
            const char* a3 = a2 + kstep; const char* b3 = b2 + kstep; \
            PG8_LDB(B0, 0, 0); if (B1ON) PG8_LDB(B1, 0, 1); PG8_SCHED; PG8_LDA(At, 0, 0); PG8_STAGE(PG8_SA(1, 1), a1 + hstepA, voffA); \
            PG8_WAIT_V(8); PG8_WAIT_L(0); PG8_BAR; PG8_MMA(0, 0, At, B0); if (B1ON) PG8_MMA(0, 1, At, B1); PG8_BAR; PG8_SCHED; \
            PG8_LDA(At, 0, 1); PG8_STAGE(PG8_SB(0, 0), b2, voffB); PG8_STAGE(PG8_SB(0, 1), b2 + hb2, voffB); PG8_STAGE(PG8_SA(0, 0), a2, voffA); \
            PG8_WAIT_V(8); PG8_WAIT_L(0); PG8_BAR; PG8_MMA(1, 0, At, B0); if (B1ON) PG8_MMA(1, 1, At, B1); PG8_BAR; PG8_SCHED; \
            PG8_LDB(B0, 1, 0); if (B1ON) PG8_LDB(B1, 1, 1); PG8_SCHED; PG8_LDA(At, 1, 0); PG8_STAGE(PG8_SA(0, 1), a2 + hstepA, voffA); \
            PG8_WAIT_V(8); PG8_WAIT_L(0); PG8_BAR; PG8_MMA(0, 0, At, B0); if (B1ON) PG8_MMA(0, 1, At, B1); PG8_BAR; PG8_SCHED; \
            PG8_LDA(At, 1, 1); PG8_STAGE(PG8_SB(1, 0), b3, voffB); PG8_STAGE(PG8_SB(1, 1), b3 + hb2, voffB); PG8_STAGE(PG8_SA(1, 0), a3, voffA); \
            PG8_WAIT_V(8); PG8_WAIT_L(0); PG8_BAR; PG8_MMA(1, 0, At, B0); if (B1ON) PG8_MMA(1, 1, At, B1); PG8_BAR; PG8_SCHED; \
        }
    for (;;) {
        const bool has_next = S.next(ui + 1, nxt);
        const char* nA = has_next ? (const char*)g.A + (size_t)nxt.pm * tstepA + (size_t)nxt.pn * g.apn + PG8_KO(nxt) : cA;
        const char* nB = has_next ? (const char*)g.Bt + (size_t)nxt.pn * tstepB + ((HT && nxt.half > 0) ? hstepB : 0) + PG8_KO(nxt) : cB;
        const size_t nhB = has_next ? ((HT && nxt.half >= 0) ? 0 : hstepB) : hBc;
        if (HT && cur.half >= 0) { PG8_KBODY(false) } else { PG8_KBODY(true) }
        if (wr == 0) PG8_BAR;
        E.run(acc, cur, wr, wc, fr, fq, (const LAS float*)(lds + EPI_LDS + (ui & 1) * 2048));
        if (!has_next) break;
#pragma unroll
        for (int a = 0; a < 2; ++a)
#pragma unroll
            for (int b = 0; b < 2; ++b)
#pragma unroll
                for (int m = 0; m < 4; ++m)
#pragma unroll
                    for (int n = 0; n < 2; ++n) acc[a][b][m][n] = (f32x4){0.f, 0.f, 0.f, 0.f};
        cur = nxt; cA = nA; cB = nB; hBc = nhB; ++ui; ntc = PG8_NT(cur);
        PG8_PREF(cur);
        if (wr == 1) PG8_BAR;
    }
    PG8_WAIT_V(0);
    PG8_BAR;
#undef PG8_KBODY
#undef PG8_NT
#undef PG8_KO
#undef PG8_PREF
#undef PG8_SA
#undef PG8_SB
#undef PG8_STAGE
#undef PG8_LDA
#undef PG8_LDB
#undef PG8_MMA
#undef PG8_WAIT_V
#undef PG8_WAIT_L
#undef PG8_BAR
#undef PG8_SCHED
}
}

namespace att {
constexpr int NW = 8, QBLK = 32, KVBLK = 64;
constexpr float SCALE = 0.10206207261596575f;
constexpr float THR = 8.f;
constexpr size_t SHM_V = 16384, SHM_K = 16384, SHM_ATTN = 2 * SHM_V + 2 * SHM_K + NW * 64 * 4;
#define KSWZ(row, colB) ((row) * 256 + ((colB) ^ (((row) & 7) << 4)))
#define SBAR() __builtin_amdgcn_sched_barrier(0)
__device__ __forceinline__ int crow(int r, int hi) { return (r & 3) + 8 * (r >> 2) + 4 * hi; }
__device__ __forceinline__ void partialSM(f32x16& p0, f32x16& p1, float& m_reg, float& mn, float& alpha) {
  constexpr float C = SCALE * 1.4426950408889634f;
  float pmax = p0[0];
#pragma unroll
  for (int r = 1; r < 16; ++r) pmax = fmaxf(pmax, p0[r]);
#pragma unroll
  for (int r = 0; r < 16; ++r) pmax = fmaxf(pmax, p1[r]);
  { auto rr = __builtin_amdgcn_permlane32_swap(__float_as_uint(pmax), __float_as_uint(pmax), false, false);
    pmax = fmaxf(__uint_as_float(rr[0]), __uint_as_float(rr[1])); }
  if (__builtin_expect(__all(pmax - m_reg <= THR / SCALE), 1)) { mn = m_reg; alpha = 1.f; }
  else { mn = fmaxf(m_reg, pmax); alpha = __builtin_amdgcn_exp2f((m_reg - mn) * C); m_reg = mn; }
  float mnC = -mn * C;
#pragma unroll
  for (int r = 0; r < 16; ++r) p0[r] = fmaf(p0[r], C, mnC);
#pragma unroll
  for (int r = 0; r < 16; ++r) p1[r] = fmaf(p1[r], C, mnC);
#pragma unroll
  for (int r = 0; r < 16; ++r) p0[r] = __builtin_amdgcn_exp2f(p0[r]);
}
__device__ __forceinline__ void finishSM(f32x16& p0, f32x16& p1, float alpha, float& l_reg, bf16x8& pa0, bf16x8& pa1, bf16x8& pa2, bf16x8& pa3) {
#pragma unroll
  for (int r = 0; r < 16; ++r) p1[r] = __builtin_amdgcn_exp2f(p1[r]);
  float ps = 0;
#pragma unroll
  for (int r = 0; r < 16; ++r) ps += p0[r];
#pragma unroll
  for (int r = 0; r < 16; ++r) ps += p1[r];
  { auto rr = __builtin_amdgcn_permlane32_swap(__float_as_uint(ps), __float_as_uint(ps), false, false);
    ps = __uint_as_float(rr[0]) + __uint_as_float(rr[1]); }
  l_reg = l_reg * alpha + ps;
#define PK4(P, BASE, OUT) do { unsigned a0 = cvt_pk_bf16(P[BASE + 0], P[BASE + 1]), a1 = cvt_pk_bf16(P[BASE + 2], P[BASE + 3]);   \
    unsigned b0 = cvt_pk_bf16(P[BASE + 4], P[BASE + 5]), b1 = cvt_pk_bf16(P[BASE + 6], P[BASE + 7]);                              \
    auto r0 = __builtin_amdgcn_permlane32_swap(a0, b0, false, false); auto r1 = __builtin_amdgcn_permlane32_swap(a1, b1, false, false); \
    u32x4 w = {r0[0], r1[0], r0[1], r1[1]}; OUT = *reinterpret_cast<bf16x8*>(&w); } while (0)
  PK4(p0, 0, pa0); PK4(p0, 8, pa1); PK4(p1, 0, pa2); PK4(p1, 8, pa3);
#undef PK4
}
__device__ __forceinline__ void qkt(f32x16& p0, f32x16& p1, const char* Ks, const bf16x8* qr, int r32, int hi) {
  p0 = f32x16{}; p1 = f32x16{};
#pragma unroll
  for (int d0 = 0; d0 < 6; ++d0) { int cb = (d0 * 16 + hi * 8) * 2;
    bf16x8 b0 = *reinterpret_cast<const bf16x8*>(Ks + KSWZ(r32, cb));
    bf16x8 b1 = *reinterpret_cast<const bf16x8*>(Ks + KSWZ(32 + r32, cb));
    p0 = __builtin_amdgcn_mfma_f32_32x32x16_bf16(b0, qr[d0], p0, 0, 0, 0);
    p1 = __builtin_amdgcn_mfma_f32_32x32x16_bf16(b1, qr[d0], p1, 0, 0, 0); }
}
__device__ __forceinline__ int v_st(int k, int c) { const int kk = (k & ~0xC) | ((k & 4) << 1) | ((k & 8) >> 1); return ((kk >> 3) * 4 + (c >> 5)) * 512 + ((kk & 7) * 32 + (c & 31)) * 2; }
__device__ __forceinline__ int v_rd_base(int lane) { return ((lane & 3) << 3) | (((lane >> 2) & 3) << 6) | (((lane >> 4) & 1) << 5) | (((lane >> 5) & 1) << 8); }
constexpr int v_rd_off(int d0, int ks, int half) { return d0 * 512 + ks * 4096 + half * 2048; }
template <int OFF> __device__ __forceinline__ s16x4 tr_read(int vb) {
  s16x4 r; asm volatile("ds_read_b64_tr_b16 %0, %1 offset:%2" : "=&v"(r) : "v"(vb), "i"(OFF) : "memory"); return r;
}
template <int D0> __device__ __forceinline__ void pv_one(f32x16& od, int vb, bf16x8 pa0, bf16x8 pa1, bf16x8 pa2, bf16x8 pa3) {
  const s16x4 l0 = tr_read<v_rd_off(D0, 0, 0)>(vb), h0 = tr_read<v_rd_off(D0, 0, 1)>(vb), l1 = tr_read<v_rd_off(D0, 1, 0)>(vb), h1 = tr_read<v_rd_off(D0, 1, 1)>(vb);
  const s16x4 l2 = tr_read<v_rd_off(D0, 2, 0)>(vb), h2 = tr_read<v_rd_off(D0, 2, 1)>(vb), l3 = tr_read<v_rd_off(D0, 3, 0)>(vb), h3 = tr_read<v_rd_off(D0, 3, 1)>(vb);
  asm volatile("s_waitcnt lgkmcnt(0)" ::: "memory"); SBAR();
#define PK(L, H) (bf16x8){L[0], L[1], L[2], L[3], H[0], H[1], H[2], H[3]}
  od = __builtin_amdgcn_mfma_f32_32x32x16_bf16(pa0, PK(l0, h0), od, 0, 0, 0);
  od = __builtin_amdgcn_mfma_f32_32x32x16_bf16(pa1, PK(l1, h1), od, 0, 0, 0);
  od = __builtin_amdgcn_mfma_f32_32x32x16_bf16(pa2, PK(l2, h2), od, 0, 0, 0);
  od = __builtin_amdgcn_mfma_f32_32x32x16_bf16(pa3, PK(l3, h3), od, 0, 0, 0);
#undef PK
}
__device__ __forceinline__ void pv_d0(f32x16* o, int vb, bf16x8 pa0, bf16x8 pa1, bf16x8 pa2, bf16x8 pa3) {
  pv_one<0>(o[0], vb, pa0, pa1, pa2, pa3); pv_one<1>(o[1], vb, pa0, pa1, pa2, pa3);
}
__device__ __forceinline__ void attn_unit(const bf16_t* __restrict__ Qb, const bf16_t* __restrict__ Kh, const bf16_t* __restrict__ Vh,
                                          bf16_t* __restrict__ Ob, int seq, char* lds) {
  int tid = threadIdx.x; asm volatile("" : "+v"(tid));
  const int wid = tid >> 6, lane = tid & 63, r32 = lane & 31, hi = lane >> 5;
  char* V_lds = lds; char* K_lds = lds + 2 * SHM_V;
  float* ws = (float*)(lds + 2 * SHM_V + 2 * SHM_K) + wid * 64; float* li_l = ws; float* al_l = ws + 32;
  float m_reg = -1e30f, l_reg = 0; f32x16 o[2] = {}; bf16x8 qr[6];
  const bf16_t* Qw = Qb + (long)(wid * QBLK + r32) * QLD + hi * 8;
#pragma unroll
  for (int d0 = 0; d0 < 6; ++d0) qr[d0] = *reinterpret_cast<const bf16x8*>(Qw + d0 * 16);
  const bool kld = wid < 6;
  const int ksr = tid / 12, ksc = (tid - ksr * 12) * 8;
  const int vsr = tid >> 3, vsc = (tid & 7) * 8, vst0 = v_st(vsr, vsc);
  const int vb0 = (int)(uintptr_t)V_lds + v_rd_base(lane);
  struct { bf16x8 vs0, ks0, ks1; } sr_[2];
#define SLOAD(i, k0) do { sr_[i].vs0 = *reinterpret_cast<const bf16x8*>(&Vh[(long)((k0) + vsr) * QLD + vsc]); \
    if (kld) { sr_[i].ks0 = *reinterpret_cast<const bf16x8*>(&Kh[(long)((k0) + ksr) * QLD + ksc]); sr_[i].ks1 = *reinterpret_cast<const bf16x8*>(&Kh[(long)((k0) + 32 + ksr) * QLD + ksc]); } } while (0)
#define SWRITE(b, i) do { *(bf16x8*)(V_lds + (b) * SHM_V + vst0) = sr_[i].vs0; \
    if (kld) { int kc = ksc * 2; *(bf16x8*)(K_lds + (b) * SHM_K + KSWZ(ksr, kc)) = sr_[i].ks0; *(bf16x8*)(K_lds + (b) * SHM_K + KSWZ(32 + ksr, kc)) = sr_[i].ks1; } } while (0)
#define SWAIT() asm volatile("s_waitcnt vmcnt(3)" ::: "memory")
#define RESC(a) do { if (__any((a) < 1.f)) { if (hi == 0) al_l[r32] = (a); asm volatile("s_waitcnt lgkmcnt(0)" ::: "memory"); \
    _Pragma("unroll") for (int d = 0; d < 2; ++d) _Pragma("unroll") for (int r = 0; r < 16; ++r) o[d][r] *= al_l[crow(r, hi)]; } } while (0)
  f32x16 pA0, pA1, pB0, pB1; float mnA, mnB, alA, alB; bf16x8 pa0, pa1, pa2, pa3; const int NT = seq / KVBLK;
  constexpr int SE = 0, SO = 1;
  SLOAD(SE, 0); asm volatile("s_waitcnt vmcnt(0)" ::: "memory"); SWRITE(0, SE); __syncthreads();
  qkt(pA0, pA1, K_lds, qr, r32, hi); partialSM(pA0, pA1, m_reg, mnA, alA);
  SLOAD(SO, KVBLK); if (2 < NT) SLOAD(SE, 2 * KVBLK);
  SWAIT(); SWRITE(1, SO); __syncthreads();
  for (int j = 1; j + 1 < NT; j += 2) {
    SBAR(); qkt(pB0, pB1, K_lds + SHM_K, qr, r32, hi);
    finishSM(pA0, pA1, alA, l_reg, pa0, pa1, pa2, pa3); SBAR();
    SLOAD(SO, (j + 2) * KVBLK); SBAR();
    pv_d0(o, vb0, pa0, pa1, pa2, pa3); partialSM(pB0, pB1, m_reg, mnB, alB);
    __syncthreads(); SWAIT(); SWRITE(0, SE);
    RESC(alB); __syncthreads();
    SBAR(); qkt(pA0, pA1, K_lds, qr, r32, hi);
    finishSM(pB0, pB1, alB, l_reg, pa0, pa1, pa2, pa3); SBAR();
    if (j + 3 < NT) SLOAD(SE, (j + 3) * KVBLK); SBAR();
    pv_d0(o, vb0 + (int)SHM_V, pa0, pa1, pa2, pa3); partialSM(pA0, pA1, m_reg, mnA, alA);
    __syncthreads(); SWAIT(); SWRITE(1, SO);
    RESC(alA); __syncthreads();
  }
  SBAR(); qkt(pB0, pB1, K_lds + SHM_K, qr, r32, hi);
  finishSM(pA0, pA1, alA, l_reg, pa0, pa1, pa2, pa3); SBAR();
  pv_d0(o, vb0, pa0, pa1, pa2, pa3); partialSM(pB0, pB1, m_reg, mnB, alB);
  __syncthreads(); RESC(alB);
  finishSM(pB0, pB1, alB, l_reg, pa0, pa1, pa2, pa3); SBAR();
  pv_d0(o, vb0 + (int)SHM_V, pa0, pa1, pa2, pa3);
  if (hi == 0) li_l[r32] = l_reg; asm volatile("s_waitcnt lgkmcnt(0)" ::: "memory");
  bf16_t* Ow = Ob + (long)(wid * QBLK) * 1024;
#pragma unroll
  for (int r = 0; r < 16; ++r) { const int orow = crow(r, hi); const float rl = __builtin_amdgcn_rcpf(li_l[orow]);
#pragma unroll
    for (int d0 = 0; d0 < 2; ++d0) Ow[(long)orow * 1024 + d0 * 32 + r32] = (bf16_t)(cvt_pk_bf16(o[d0][r] * rl, 0.f) & 0xffffu); }
#undef SLOAD
#undef SWRITE
#undef SWAIT
#undef RESC
}
}


#define XB_TMO      128
#define XB_XCNT(j)  (256  + 64 * (j))
#define XB_XSUB(j)  (1280 + 64 * (j))
#define XB_XGEN(j)  (2304 + 64 * (j))
#define XB_TOP      3328
#define XB_TOPGEN   3392
#define XCD_BAR_WORDS 3456
#define XB_SPIN_CAP (1u << 20)
__device__ __forceinline__ unsigned xb_ld(unsigned* p)              { return __hip_atomic_load(p, __ATOMIC_RELAXED, __HIP_MEMORY_SCOPE_AGENT); }
__device__ __forceinline__ unsigned xb_add(unsigned* p, unsigned v) { return __hip_atomic_fetch_add(p, v, __ATOMIC_RELAXED, __HIP_MEMORY_SCOPE_AGENT); }
__device__ __forceinline__ unsigned xb_xcc_id() { return (unsigned)__builtin_amdgcn_s_getreg((3 << 11) | 20) & 0xFu; }
#define XB_SPIN(cond, bar) do { unsigned _sp = 0; while (cond) { __builtin_amdgcn_s_sleep(1); \
    if ((++_sp & 255u) == 0u) { if (xb_ld(&(bar)[XB_TMO])) break; if (_sp > XB_SPIN_CAP) { atomicAdd(&(bar)[XB_TMO], 1u); break; } } } } while (0)
struct XcdBarrier { unsigned* bar; unsigned x; volatile LAS unsigned* st; };
__device__ __forceinline__ XcdBarrier xcd_barrier_post(unsigned* bar, volatile LAS unsigned* st) {
    XcdBarrier b; b.bar = bar; b.x = xb_xcc_id(); b.st = st;
    if (threadIdx.x == 0) (void)xb_add(&bar[XB_XCNT(b.x)], 1u);
    return b;
}
__device__ __forceinline__ void xcd_barrier_complete(unsigned* bar, unsigned x, unsigned& nloc, unsigned& nx) {
    const unsigned G = gridDim.x * gridDim.y * gridDim.z;
    unsigned sum, cnt, mine, sp = 0u;
    for (;;) {
        sum = 0u; cnt = 0u; mine = 0u;
#pragma unroll
        for (unsigned j = 0; j < 16; ++j) { const unsigned c = xb_ld(&bar[XB_XCNT(j)]); sum += c; cnt += (c > 0u) ? 1u : 0u; mine = (j == x) ? c : mine; }
        if (sum == G) break;
        __builtin_amdgcn_s_sleep(1);
        if ((++sp & 255u) == 0u) { if (xb_ld(&bar[XB_TMO])) break; if (sp > XB_SPIN_CAP) { atomicAdd(&bar[XB_TMO], 1u); break; } }
    }
    nloc = mine > 0u ? mine : 1u; nx = cnt > 0u ? cnt : 1u;
}
__device__ __forceinline__ void xcd_barrier(const XcdBarrier& b) {
    asm volatile("s_waitcnt vmcnt(0)" ::: "memory");
    __syncthreads();
    if (threadIdx.x == 0) {
        unsigned* bar = b.bar;
        __builtin_amdgcn_s_waitcnt(0);
        unsigned nloc = b.st[0], nx = b.st[1];
        if (nloc == 0u) { xcd_barrier_complete(bar, b.x, nloc, nx); b.st[0] = nloc; b.st[1] = nx; }
        const unsigned old = xb_add(&bar[XB_XSUB(b.x)], 1u);
        const unsigned gen = old / nloc;
        if (old + 1u == (gen + 1u) * nloc) {
            __builtin_amdgcn_fence(__ATOMIC_RELEASE, "agent");
            asm volatile("s_waitcnt vmcnt(0)" ::: "memory");
            const unsigned og = xb_add(&bar[XB_TOP], 1u);
            const unsigned tg = og / nx;
            if (og + 1u == (tg + 1u) * nx) xb_add(&bar[XB_TOPGEN], 1u);
            else XB_SPIN(xb_ld(&bar[XB_TOPGEN]) == tg, bar);
            __builtin_amdgcn_fence(__ATOMIC_ACQUIRE, "agent");
            xb_add(&bar[XB_XGEN(b.x)], 1u);
            asm volatile("s_waitcnt vmcnt(0)" ::: "memory");
        } else {
            XB_SPIN(xb_ld(&bar[XB_XGEN(b.x)]) == gen, bar);
            __builtin_amdgcn_fence(__ATOMIC_ACQUIRE, "agent");
            asm volatile("s_waitcnt vmcnt(0)" ::: "memory");
        }
    }
    __syncthreads();
}

constexpr int LDS_BYTES = 139264;
struct Args { const float* in[25]; float* out; unsigned char* ws; int ph_lo, ph_hi; };

__device__ __forceinline__ void tr_item(const float* W, int ldw, bf16_t* dst, int ldd, LAS float* scr, int lane) {
    float tv[32];
#pragma unroll
    for (int i = 0; i < 32; ++i) tv[i] = W[(size_t)(2 * i + (lane >> 5)) * ldw + (lane & 31)];
#pragma unroll
    for (int i = 0; i < 32; ++i) scr[(2 * i + (lane >> 5)) * 33 + (lane & 31)] = tv[i];
    asm volatile("s_waitcnt lgkmcnt(0)" ::: "memory");
    const int c = lane & 7;
#pragma unroll
    for (int j = 0; j < 4; ++j) { const int n = (lane >> 3) + 8 * j; const LAS float* s = scr + (8 * c) * 33 + n;
        u32x4 o; o.x = cvt_pk_bf16(s[0 * 33], s[1 * 33]); o.y = cvt_pk_bf16(s[2 * 33], s[3 * 33]); o.z = cvt_pk_bf16(s[4 * 33], s[5 * 33]); o.w = cvt_pk_bf16(s[6 * 33], s[7 * 33]);
        *(u32x4*)(dst + (size_t)n * ldd + 8 * c) = o; }
    asm volatile("s_waitcnt lgkmcnt(0)" ::: "memory");
}


struct P2Row { f32x4 q[3], k[3]; u32x2 v[2]; int kind, t, e; };
__device__ __forceinline__ f32x4 ld_bf4(const bf16_t* p) { const u32x2 w = *(const u32x2*)p; return (f32x4){bflo(w.x), bfhi(w.x), bflo(w.y), bfhi(w.y)}; }
__device__ __forceinline__ void p2_load(P2Row& r, int e, int j, int hh, int s, const bf16_t* QKV, const float* KROPE, const float* cache_kr) {
    const float* krp; r.e = e; r.t = 0;
    if (e < NCTX) { r.kind = 0; krp = KROPE + (size_t)e * 32; }
    else { const int b = (e - NCTX) / KVB, tt = (e - NCTX) - b * KVB;
        if (tt < LLAT) { r.kind = 1; r.t = tt; krp = KROPE + (size_t)(NCTX + b * LLAT + tt) * 32; }
        else { r.kind = 2; krp = cache_kr + (((size_t)b * 2 + j) * 512 + (tt - LLAT)) * 32; } }
    const bf16_t* raw = QKV + (size_t)e * QLD;
#pragma unroll
    for (int jj = 0; jj < 3; ++jj) r.q[jj] = ld_bf4(raw + hh * 96 + 4 * (s + 8 * jj));
#pragma unroll
    for (int jj = 0; jj < 2; ++jj) { r.k[jj] = ld_bf4(raw + 768 + hh * 128 + 4 * (s + 8 * jj)); r.v[jj] = *(const u32x2*)(raw + 768 + hh * 128 + 64 + 4 * (s + 8 * jj)); }
    r.k[2] = *(const f32x4*)(krp + 4 * s);
}
__device__ __forceinline__ void p2_compute(P2Row& r, int s, const float* qn, const float* kn, const float* ROPE) {
    float sq = 0.f, sk = 0.f;
#pragma unroll
    for (int jj = 0; jj < 3; ++jj) { sq += (r.q[jj][0] * r.q[jj][0] + r.q[jj][1] * r.q[jj][1]) + (r.q[jj][2] * r.q[jj][2] + r.q[jj][3] * r.q[jj][3]);
                                     sk += (r.k[jj][0] * r.k[jj][0] + r.k[jj][1] * r.k[jj][1]) + (r.k[jj][2] * r.k[jj][2] + r.k[jj][3] * r.k[jj][3]); }
    sq += __shfl_xor(sq, 1); sq += __shfl_xor(sq, 2); sq += __shfl_xor(sq, 4);
    sk += __shfl_xor(sk, 1); sk += __shfl_xor(sk, 2); sk += __shfl_xor(sk, 4);
    const float rq = 1.0f / sqrtf(sq * (1.0f / 96.0f) + EPS), rk = 1.0f / sqrtf(sk * (1.0f / 96.0f) + EPS);
#pragma unroll
    for (int jj = 0; jj < 3; ++jj) { r.q[jj] = r.q[jj] * rq * *(const f32x4*)(qn + 4 * (s + 8 * jj)); r.k[jj] = r.k[jj] * rk * *(const f32x4*)(kn + 4 * (s + 8 * jj)); }
    f32x4 qp, kp;
#pragma unroll
    for (int c = 0; c < 4; ++c) { qp[c] = __shfl_xor(r.q[2][c], 2); kp[c] = __shfl_xor(r.k[2][c], 2); }
    if (r.kind == 1) {
        const int a = s >> 2, fi0 = (s & 1) * 4; const bool second = (s & 2) != 0;
        const f32x4 cs = *(const f32x4*)(ROPE + (size_t)r.t * 16 + a * 8 + fi0), sn = *(const f32x4*)(ROPE + 65536 + (size_t)r.t * 16 + a * 8 + fi0);
        if (!second) { r.q[2] = r.q[2] * cs - qp * sn; r.k[2] = r.k[2] * cs - kp * sn; }
        else { r.q[2] = qp * sn + r.q[2] * cs; r.k[2] = kp * sn + r.k[2] * cs; }
    }
}
__device__ __forceinline__ void p2_store(const P2Row& r, int hh, int s, bf16_t* QKV) {
    bf16_t* orow = QKV + (size_t)r.e * QLD;
#pragma unroll
    for (int jj = 0; jj < 3; ++jj) {
        if (r.kind != 2) { u32x2 w; w.x = cvt_pk_bf16(r.q[jj][0], r.q[jj][1]); w.y = cvt_pk_bf16(r.q[jj][2], r.q[jj][3]); *(u32x2*)(orow + hh * 96 + 4 * (s + 8 * jj)) = w; }
        u32x2 w2; w2.x = cvt_pk_bf16(r.k[jj][0], r.k[jj][1]); w2.y = cvt_pk_bf16(r.k[jj][2], r.k[jj][3]); *(u32x2*)(orow + 768 + hh * 96 + 4 * (s + 8 * jj)) = w2; }
#pragma unroll
    for (int jj = 0; jj < 2; ++jj) *(u32x2*)(orow + 1536 + hh * 64 + 4 * (s + 8 * jj)) = r.v[jj];
}
struct P1Row { f32x4 q4, k4, r4; };
__device__ __forceinline__ void p1_load(P1Row& p, const float* pr, int lane) {
    p.q4 = *(const f32x4*)(pr + 4 * lane);
    p.k4 = (f32x4){0.f, 0.f, 0.f, 0.f}; if (lane < 32) p.k4 = *(const f32x4*)(pr + 256 + 4 * lane);
    p.r4 = (f32x4){0.f, 0.f, 0.f, 0.f}; if (lane < 8) p.r4 = *(const f32x4*)(pr + 384 + 4 * lane);
}
__device__ __forceinline__ void p1_finish(const P1Row& p, int r, int j, int lane, const float* qan, const float* kvan, bf16_t* QKVLAT, float* KROPE, float* OUT_CKV, float* OUT_KR) {
    const int e = r < NCTX ? r : NCTX + ((r - NCTX) >> 12) * KVB + ((r - NCTX) & 4095);
    const float ssq = wave_sum((p.q4[0] * p.q4[0] + p.q4[1] * p.q4[1]) + (p.q4[2] * p.q4[2] + p.q4[3] * p.q4[3]));
    const float ssk = wave_sum((p.k4[0] * p.k4[0] + p.k4[1] * p.k4[1]) + (p.k4[2] * p.k4[2] + p.k4[3] * p.k4[3]));
    const float rq = 1.0f / sqrtf(ssq * (1.0f / 256.0f) + EPS), rk = 1.0f / sqrtf(ssk * (1.0f / 128.0f) + EPS);
    const f32x4 qo = p.q4 * rq * *(const f32x4*)(qan + 4 * lane);
    u32x2 w; w.x = cvt_pk_bf16(qo[0], qo[1]); w.y = cvt_pk_bf16(qo[2], qo[3]); *(u32x2*)(QKVLAT + (size_t)e * 384 + 4 * lane) = w;
    if (lane < 32) { const f32x4 ko = p.k4 * rk * *(const f32x4*)(kvan + 4 * lane); u32x2 w2; w2.x = cvt_pk_bf16(ko[0], ko[1]); w2.y = cvt_pk_bf16(ko[2], ko[3]);
        *(u32x2*)(QKVLAT + (size_t)e * 384 + 256 + 4 * lane) = w2;
        if (r < NCTX) *(f32x4*)(OUT_CKV + (((size_t)(r >> 8) * 2 + j) * 256 + (r & 255)) * 128 + 4 * lane) = ko; }
    if (lane < 8) { *(f32x4*)(KROPE + (size_t)r * 32 + 4 * lane) = p.r4;
        if (r < NCTX) *(f32x4*)(OUT_KR + (((size_t)(r >> 8) * 2 + j) * 256 + (r & 255)) * 32 + 4 * lane) = p.r4; }
}

#define DERIVE_PTRS \
    unsigned char* ws = args.ws; \
    float* X = args.out; \
    float* OUT_CKV = args.out + (size_t)MTOK * 1024; float* OUT_KR = OUT_CKV + (size_t)32 * 2 * 256 * 128; \
    bf16_t* W13 = (bf16_t*)(ws + OFF_W13); bf16_t* W2 = (bf16_t*)(ws + OFF_W2); bf16_t* WIN = (bf16_t*)(ws + OFF_WIN); bf16_t* WQKV = (bf16_t*)(ws + OFF_WQKV); \
    bf16_t* WOUT = (bf16_t*)(ws + OFF_WOUT); bf16_t* POOLT = (bf16_t*)(ws + OFF_POOLT); bf16_t* WSB = (bf16_t*)(ws + OFF_WS); \
    float* MOD = (float*)(ws + OFF_MOD); float* ROPE = (float*)(ws + OFF_ROPE); \
    bf16_t* H = (bf16_t*)(ws + OFF_H); bf16_t* MIX = H; \
    unsigned char* R = ws + OFF_R; \
    bf16_t* U = (bf16_t*)(R + R_U); bf16_t* PB = (bf16_t*)R; bf16_t* H2 = (bf16_t*)R; \
    float* RSS = (float*)(ws + OFF_RSS); float* B13 = (float*)(ws + OFF_B13); float* BIN = (float*)(ws + OFF_BIN); float* VSS = (float*)(ws + OFF_VSS); \
    bf16_t* QKVLAT = (bf16_t*)(R + R_QKVLAT); float* KROPE = (float*)(R + R_KROPE); float* PROJ = (float*)(R + R_PROJ); \
    bf16_t* GM = (bf16_t*)(R + R_GM); float* QKVRAW = (float*)(R + R_QKVRAW); bf16_t* QKV = (bf16_t*)(R + R_QKVRAW);

__global__ void __launch_bounds__(512, 2) fwd_mega(Args args) {
    extern __shared__ __attribute__((aligned(16))) unsigned char lds[];
    cg::grid_group grid = cg::this_grid();
    int tid = threadIdx.x, lane = tid & 63, wave = __builtin_amdgcn_readfirstlane(tid >> 6);
    const int G = gridDim.x, bid = blockIdx.x;
    int gw = bid * 8 + wave; const int NGW = G * 8;
    long gt = (long)bid * 512 + tid; const long NGT = (long)G * 512;
    const int lo = args.ph_lo, hi = args.ph_hi;
    int pid = 0;
    unsigned* BARW = (unsigned*)(args.ws + OFF_CTL);
    volatile LAS unsigned* MISC = (volatile LAS unsigned*)((LAS unsigned char*)lds + 131072);
    if (tid < 16) MISC[tid] = 0u;
    if (bid == 0) for (int i = tid; i < XCD_BAR_WORDS; i += 512) BARW[i] = 0u;
    __syncthreads();
    XcdBarrier xbar; xbar.bar = BARW; xbar.x = 0; xbar.st = MISC;

    for (int rep0 = 0; rep0 < ((DUPMASK & 1) ? 2 : 1); ++rep0)
    if (EN_PRO && pid >= lo && pid < hi) {
        DERIVE_PTRS
        if (bid < 288) {
            LAS float* S = (LAS float*)lds; LAS float* P = (LAS float*)(lds + 36864);
            for (int idx = tid; idx < 9216; idx += 512) { const int cv = idx >> 10, k = idx & 1023; const float x = cv == 0 ? args.in[5][k] : args.in[4][(cv - 1) * 1024 + k]; S[idx] = x / (1.0f + expf(-x)); }
            __syncthreads();
            for (int item = bid; item < 288; item += G) {
                const int l = item / 72, cb = item % 72, j = tid & 127, s = tid >> 7;
                float acc[9];
#pragma unroll
                for (int cv = 0; cv < 9; ++cv) acc[cv] = 0.f;
                const float* wp = args.in[6] + ((size_t)l * 1024 + s * 256) * NMOD + cb * 128 + j;
                for (int k = 0; k < 256; k += 16) {
                    float wv[16];
#pragma unroll
                    for (int i = 0; i < 16; ++i) wv[i] = wp[(size_t)(k + i) * NMOD];
#pragma unroll
                    for (int cv = 0; cv < 9; ++cv) { const LAS float* sp = S + cv * 1024 + s * 256 + k;
#pragma unroll
                        for (int i = 0; i < 16; ++i) acc[cv] += sp[i] * wv[i]; }
                }
#pragma unroll
                for (int cv = 0; cv < 9; ++cv) P[(s * 9 + cv) * 128 + j] = acc[cv];
                __syncthreads();
                for (int idx = tid; idx < 1152; idx += 512) { const int cv = idx >> 7, jj = idx & 127;
                    const float v = P[(0 * 9 + cv) * 128 + jj] + P[(1 * 9 + cv) * 128 + jj] + P[(2 * 9 + cv) * 128 + jj] + P[(3 * 9 + cv) * 128 + jj] + args.in[7][l * NMOD + cb * 128 + jj];
                    MOD[((size_t)l * 9 + cv) * NMOD + cb * 128 + jj] = v; }
                __syncthreads();
            }
        }
        __syncthreads();
        {
            LAS float* scr = (LAS float*)(lds + 57344 + wave * 8448);
            for (int it0 = gw; it0 < 36832; it0 += NGW) {
                int it = it0; const float* src; int ldw, ldd; bf16_t* dst;
                if (it < 33792) { const int ls = it / 4224, r = it % 4224, which = r / 1408, q = r % 1408;
                    if (which < 2) { const int kb = q / 88, nb = q % 88, k0 = kb * 64, n0 = nb * 32; src = args.in[which ? 10 : 9] + (size_t)ls * 1024 * FF + (size_t)k0 * FF + n0; ldw = FF;
                        const int drow = (n0 >> 7) * 256 + (n0 & 127) + which * 128; dst = W13 + (size_t)ls * 5632 * 1024 + (size_t)drow * 1024 + k0; ldd = 1024; }
                    else { const int kb = q / 32, nb = q % 32, k0 = kb * 64, n0 = nb * 32; src = args.in[11] + (size_t)ls * FF * 1024 + (size_t)k0 * 1024 + n0; ldw = 1024;
                        dst = W2 + (size_t)ls * 1024 * FF + (size_t)n0 * FF + k0; ldd = FF; } }
                else { it -= 33792;
                if (it < 1440) { const int j = it / 720, q = it % 720, kb = q / 45, nb = q % 45, k0 = kb * 64, n0 = nb * 32; src = args.in[12] + (size_t)j * 1024 * 1440 + (size_t)k0 * 1440 + n0; ldw = 1440;
                    const int drow = n0 < 416 ? n0 : n0 + 96; dst = WIN + (size_t)j * 1536 * 1024 + (size_t)drow * 1024 + k0; ldd = 1024; }
                else { it -= 1440;
                if (it < 192) { const int j = it / 96, q = it % 96, kb = q / 24, nb = q % 24, k0 = kb * 64, n0 = nb * 32; src = args.in[15] + (size_t)j * 256 * 768 + (size_t)k0 * 768 + n0; ldw = 768;
                    dst = WQKV + (size_t)j * 1792 * 384 + (size_t)n0 * 384 + k0; ldd = 384; }
                else { it -= 192;
                if (it < 128) { const int j = it / 64, q = it % 64, kb = q / 32, nb = q % 32, k0 = kb * 64, n0 = nb * 32; src = args.in[16] + (size_t)j * 128 * 1024 + (size_t)k0 * 1024 + n0; ldw = 1024;
                    dst = WQKV + (size_t)j * 1792 * 384 + (size_t)(768 + n0) * 384 + 256 + k0; ldd = 384; }
                else { it -= 128;
                if (it < 1024) { const int j = it / 512, q = it % 512, kb = q / 32, nb = q % 32, k0 = kb * 64, n0 = nb * 32; src = args.in[22] + (size_t)j * 1024 * 1024 + (size_t)k0 * 1024 + n0; ldw = 1024;
                    dst = WOUT + (size_t)j * 1024 * 1024 + (size_t)n0 * 1024 + k0; ldd = 1024; }
                else { it -= 1024;
                    const int jg = it / 32, q = it % 32, kb = q / 8, nb = q % 8, k0 = kb * 64, n0 = nb * 32; src = args.in[23] + (size_t)jg * 65536 + (size_t)k0 * 256 + n0; ldw = 256;
                    dst = POOLT + (size_t)jg * 65536 + (size_t)n0 * 256 + k0; ldd = 256; } } } } }
                tr_item(src, ldw, dst, ldd, scr, lane);
            }
        }
        {
            const u32x4 z = {0u, 0u, 0u, 0u};
            for (long i = gt; i < 2 * 12288; i += NGT) { const int j = (int)(i / 12288); const long q = i % 12288; *(u32x4*)(WIN + (size_t)j * 1536 * 1024 + (size_t)416 * 1024 + q * 8) = z; }
            for (long i = gt; i < 2 * 45056; i += NGT) { const int j = (int)(i / 45056); const long q = i % 45056; bf16_t* base = WQKV + (size_t)j * 1792 * 384;
                if (q < 12288) { const int row = (int)(q >> 4), c = (int)(q & 15); *(u32x4*)(base + (size_t)row * 384 + 256 + c * 8) = z; }
                else { const long q2 = q - 12288; const int row = 768 + (int)(q2 >> 5), c = (int)(q2 & 31); *(u32x4*)(base + (size_t)row * 384 + c * 8) = z; } }
        }
        for (long i = gt; i < 131072 / 4; i += NGT) { const f32x4 v = *(const f32x4*)(args.in[20] + i * 4); u32x2 w; w.x = cvt_pk_bf16(v[0], v[1]); w.y = cvt_pk_bf16(v[2], v[3]); *(u32x2*)(WSB + i * 4) = w; }
        for (long i = gt; i < 65536; i += NGT) { const int t = (int)(i >> 4), ai = (int)(i & 15), a = ai >> 3, fi = ai & 7;
            const float inv = powf(10000.0f, -(float)(2 * fi) / 16.0f); const float pos = (float)(a == 0 ? (t >> 6) : (t & 63)); const float ang = pos * inv;
            ROPE[i] = cosf(ang); ROPE[65536 + i] = sinf(ang); }
        { const f32x4 z4 = {0.f, 0.f, 0.f, 0.f}; for (long i = gt; i < (long)12 * MTOK / 4; i += NGT) *(f32x4*)(RSS + i * 4) = z4;
          for (long i = gt; i < (long)2 * MTOK / 4; i += NGT) *(f32x4*)(VSS + i * 4) = z4; }
    }
    grid.sync();
    xbar = xcd_barrier_post(BARW, MISC);
    ++pid;
    for (int rep1 = 0; rep1 < ((DUPMASK & 2) ? 2 : 1); ++rep1)
    if (pid >= lo && pid < hi) {
        DERIVE_PTRS
        for (int ck = gw; ck < 8 * 176 + 2 * 48; ck += NGW) {
            const bf16_t* __restrict__ wbase; const float* shp; float* __restrict__ outp; int cvs;
            if (ck < 8 * 176) { const int ls = ck / 176, n0 = (ck - ls * 176) * 32, l = ls >> 1, sub = ls & 1; wbase = W13 + ((size_t)ls * 5632 + n0) * 1024;
                shp = MOD + (size_t)l * 9 * NMOD + (sub ? 6 : 0) * 1024; outp = B13 + (size_t)ls * 9 * 5632 + n0; cvs = 5632; }
            else { const int q = ck - 8 * 176, jj = q / 48, n0 = (q - jj * 48) * 32; wbase = WIN + ((size_t)jj * 1536 + n0) * 1024;
                shp = MOD + (size_t)(2 * jj) * 9 * NMOD + 3 * 1024; outp = BIN + (size_t)jj * 9 * 1536 + n0; cvs = 1536; }
            f32x4 sh[9][4];
#pragma unroll
            for (int cv = 0; cv < 9; ++cv) { const float* sp = shp + (size_t)cv * NMOD;
                sh[cv][0] = *(const f32x4*)(sp + lane * 8); sh[cv][1] = *(const f32x4*)(sp + lane * 8 + 4); sh[cv][2] = *(const f32x4*)(sp + 512 + lane * 8); sh[cv][3] = *(const f32x4*)(sp + 512 + lane * 8 + 4); }
#pragma unroll 2
            for (int r = 0; r < 32; ++r) {
                const u32x4 w0 = *(const u32x4*)(wbase + (size_t)r * 1024 + lane * 8), w1 = *(const u32x4*)(wbase + (size_t)r * 1024 + 512 + lane * 8);
                const f32x4 wa = {bflo(w0[0]), bfhi(w0[0]), bflo(w0[1]), bfhi(w0[1])}, wb = {bflo(w0[2]), bfhi(w0[2]), bflo(w0[3]), bfhi(w0[3])};
                const f32x4 wc2 = {bflo(w1[0]), bfhi(w1[0]), bflo(w1[1]), bfhi(w1[1])}, wd = {bflo(w1[2]), bfhi(w1[2]), bflo(w1[3]), bfhi(w1[3])};
                float res = 0.f;
#pragma unroll
                for (int cv = 0; cv < 9; ++cv) { const f32x4 p = sh[cv][0] * wa + sh[cv][1] * wb + sh[cv][2] * wc2 + sh[cv][3] * wd;
                    float a2 = (p[0] + p[1]) + (p[2] + p[3]); a2 = wave_sum(a2); if (lane == cv) res = a2; }
                if (lane < 9) outp[(size_t)lane * cvs + r] = res;
            }
        }
        for (int rb = gw; rb < MTOK; rb += 2 * NGW) {
            f32x4 v[2][4]; float ss[2]; int rr[2];
#pragma unroll
            for (int u2 = 0; u2 < 2; ++u2) { const int r = (rb + u2 * NGW < MTOK) ? rb + u2 * NGW : rb; rr[u2] = r;
                const float* xr = r < NCTX ? args.in[0] + (size_t)r * 1024 : args.in[1] + (size_t)(r - NCTX) * 1024; ss[u2] = 0.f;
#pragma unroll
                for (int q = 0; q < 4; ++q) { v[u2][q] = *(const f32x4*)(xr + 4 * lane + 256 * q); ss[u2] += (v[u2][q][0] * v[u2][q][0] + v[u2][q][1] * v[u2][q][1]) + (v[u2][q][2] * v[u2][q][2] + v[u2][q][3] * v[u2][q][3]); } }
#pragma unroll
            for (int u2 = 0; u2 < 2; ++u2) { if (u2 == 1 && rb + NGW >= MTOK) break; const int r = rr[u2]; const int cv = cv_of_row(r);
                const float* scp = MOD + (size_t)cv * NMOD + 1024; const float* gptr = args.in[8];
                const float st = wave_sum(ss[u2]); if (lane == 0) RSS[r] = st;
#pragma unroll
                for (int q = 0; q < 4; ++q) { const int c = 4 * lane + 256 * q; const f32x4 g4 = *(const f32x4*)(gptr + c), sc = *(const f32x4*)(scp + c);
                    *(f32x4*)(X + (size_t)r * 1024 + c) = v[u2][q];
                    const f32x4 hh = v[u2][q] * g4 * (sc + 1.0f); u32x2 w; w.x = cvt_pk_bf16(hh[0], hh[1]); w.y = cvt_pk_bf16(hh[2], hh[3]);
                    *(u32x2*)(H + (size_t)r * 1024 + c) = w; } }
        }
        if (pid + 1 < hi) xcd_barrier(xbar);
    }
    ++pid;

    for (int layer = 0; layer < 4; ++layer) {
        const int j = layer >> 1;
        const unsigned long long prog = (layer & 1) ? 0xDCFE32ull : 0xDCA9876532ull;
        const int nsteps = (layer & 1) ? 6 : 10;
        for (int step = 0; step < nsteps; ++step, ++pid) {
            if (!(pid >= lo && pid < hi)) continue;
            const int op = (int)((prog >> (4 * step)) & 15ull);
            const int reps = ((DUPMASK >> op) & 1) ? 2 : 1;
            for (int rep = 0; rep < reps; ++rep) {
            DERIVE_PTRS
            int bid = blockIdx.x; asm volatile("" : "+s"(bid)); int G = gridDim.x; asm volatile("" : "+s"(G));
            const int NGW = G * 8; const long NGT = (long)G * 512;
            const float* MODL = MOD + (size_t)layer * 9 * NMOD;
            tid = threadIdx.x; asm volatile("" : "+v"(tid)); lane = tid & 63; wave = __builtin_amdgcn_readfirstlane(tid >> 6); gw = bid * 8 + wave; gt = (long)bid * 512 + tid;
            if (EN_G1 && (op == 2 || op == 12)) {
                const int sub = op == 2 ? 0 : 1;
                const bf16_t* Ain = (sub == 1 && !(layer & 1)) ? H2 : H;
                pg8::Gemm g{Ain, W13 + (size_t)(layer * 2 + sub) * 5632 * 1024, MTOK, 5632, 1024, 1024, 1024, 0, 0, 0};
                pg8::StaticOrder S; S.init(MTOK, 5632, G, bid);
                pg8::EpiSwiglu E{U, RSS + (size_t)(layer * 3 + (sub ? 2 : 0)) * MTOK, B13 + (size_t)(layer * 2 + sub) * 9 * 5632};
                pg8::gemm_phase<pg8::EpiSwiglu>((LAS unsigned char*)lds, g, S, E);
            } else if (EN_GRES && (op == 3 || op == 13 || op == 10 || op == 15)) {
                const bf16_t* gA; const bf16_t* gB; int gK, glda, gldb, gapn; const float* egate; const float* escale; float ecoef;
                if (op == 3 || op == 13) { const int sub = op == 3 ? 0 : 1; gA = U; gB = W2 + (size_t)(layer * 2 + sub) * 1024 * FF; gK = FF; glda = FF; gldb = FF; gapn = 0;
                    egate = MODL + (sub ? 8 : 2) * 1024; escale = nullptr; ecoef = 0.5f; }
                else if (op == 10) { gA = MIX; gB = WOUT + (size_t)j * 1024 * 1024; gK = 1024; glda = 1024; gldb = 1024; gapn = 0; egate = MODL + 5 * 1024; escale = nullptr; ecoef = 1.0f; }
                else { gA = PB; gB = POOLT + (size_t)j * 1024 * 256; gK = 256; glda = 1024; gldb = 256; gapn = 512; egate = MODL + 5 * 1024; escale = args.in[24] + (size_t)j * 1024; ecoef = 1.0f; }
                int ln = layer, kn; bf16_t* an = H;
                if (op == 3) kn = 1; else if (op == 13) { ln = layer + 1; kn = 0; } else { kn = 2; if (op == 10) an = H2; }
                if (ln >= 4) { an = nullptr; ln = 0; }
                const pg8::Gemm g{gA, gB, MTOK, 1024, gK, glda, gldb, gapn, 0, 0};
                const pg8::EpiResid E{X, egate, escale, an, args.in[8] + ((size_t)ln * 3 + kn) * 1024, MOD + (size_t)ln * 9 * NMOD + (3 * kn + 1) * 1024, RSS + (size_t)(ln * 3 + kn) * MTOK, ecoef, 0};
                pg8::StaticOrder S; S.init(MTOK, 1024, G, bid, 1);
                pg8::gemm_phase<pg8::EpiResid, true>((LAS unsigned char*)lds, g, S, E);
            } else if (EN_GRAW && (op == 5 || op == 7)) {
                const bool gin = op == 5;
                const pg8::Gemm g{gin ? (const bf16_t*)H : (const bf16_t*)QKVLAT, gin ? WIN + (size_t)j * 1536 * 1024 : WQKV + (size_t)j * 1792 * 384, gin ? MTOK : MEXT, gin ? 1536 : 1792, gin ? 1024 : 384, gin ? 1024 : 384, gin ? 1024 : 384, 0, gin ? 0 : 3, 0};
                const pg8::EpiRaw E{PROJ, gin ? GM : QKV, gin ? RSS + (size_t)(layer * 3 + 1) * MTOK : (const float*)nullptr, BIN + (size_t)j * 9 * 1536, gin ? VSS + (size_t)j * MTOK : (float*)nullptr, 512, gin ? 2 : 0, gin ? 1024 : QLD, gin ? 1 : 0};
                pg8::StaticOrder S; S.init(gin ? MTOK : MEXT, gin ? 1536 : 1792, G, bid);
                pg8::gemm_phase<pg8::EpiRaw>((LAS unsigned char*)lds, g, S, E);
            } else if (EN_POST1 && op == 6) {
                {
                    LAS float* rs = (LAS float*)lds; LAS bf16_t* tT = (LAS bf16_t*)(lds + 1024);
                    const float* vn = args.in[19] + (size_t)j * 512; const float* gb = args.in[21] + (size_t)j * 512;
                    for (int item = bid; item < 1280; item += G) {
                        const int chunk = item >> 2, gq = item & 3; const size_t tok0 = (size_t)chunk * 128;
                        if (tid < 128) rs[tid] = __builtin_amdgcn_rsqf(VSS[(size_t)j * MTOK + tok0 + tid] * (1.0f / 512.0f) + EPS);
                        __syncthreads();
                        { const int q = tid >> 2, cp = tid & 3; const float rq = rs[q];
#pragma unroll
                          for (int cc = 0; cc < 4; ++cc) { const int c0 = cp * 32 + cc * 8; const u32x4 w = *(const u32x4*)(GM + (tok0 + q) * 1024 + 512 + gq * 128 + c0);
                              const f32x4 n0 = *(const f32x4*)(vn + gq * 128 + c0), n1 = *(const f32x4*)(vn + gq * 128 + c0 + 4);
                              float v[8] = {bflo(w[0]) * n0[0], bfhi(w[0]) * n0[1], bflo(w[1]) * n0[2], bfhi(w[1]) * n0[3], bflo(w[2]) * n1[0], bfhi(w[2]) * n1[1], bflo(w[3]) * n1[2], bfhi(w[3]) * n1[3]};
#pragma unroll
                              for (int e = 0; e < 8; ++e) tT[(c0 + e) * 136 + q] = (bf16_t)(cvt_pk_bf16(v[e] * rq, 0.f) & 0xffffu); } }
                        __syncthreads();
                        const int p = wave * 16 + (lane & 15); const size_t tok = tok0 + p; const float bsp = gb[gq * 128 + p];
                        u32x2 uu[8];
#pragma unroll
                        for (int n = 0; n < 8; ++n) uu[n] = *(const u32x2*)(GM + tok * 1024 + gq * 128 + 16 * n + 4 * (lane >> 4));
                        f32x4 acc[8];
#pragma unroll
                        for (int n = 0; n < 8; ++n) acc[n] = (f32x4){0.f, 0.f, 0.f, 0.f};
                        const bf16_t* wsp = WSB + ((size_t)(j * 4 + gq) * 128 + wave * 16 + (lane & 15)) * 128 + 8 * (lane >> 4);
#pragma unroll
                        for (int ks = 0; ks < 4; ++ks) { const bf16x8 a = *(const bf16x8*)(wsp + 32 * ks);
#pragma unroll
                            for (int n = 0; n < 8; ++n) { const bf16x8 b = *(const LAS bf16x8*)(tT + (16 * n + (lane & 15)) * 136 + 32 * ks + 8 * (lane >> 4));
                                acc[n] = __builtin_amdgcn_mfma_f32_16x16x32_bf16(b, a, acc[n], 0, 0, 0); } }
                        {
#pragma unroll
                          for (int n = 0; n < 8; ++n) { u32x2 w; w.x = cvt_pk_bf16(bflo(uu[n].x) * (acc[n][0] + bsp), bfhi(uu[n].x) * (acc[n][1] + bsp)); w.y = cvt_pk_bf16(bflo(uu[n].y) * (acc[n][2] + bsp), bfhi(uu[n].y) * (acc[n][3] + bsp));
                              *(u32x2*)(MIX + tok * 1024 + 512 + gq * 128 + 16 * n + 4 * (lane >> 4)) = w; } }
                        __syncthreads();
                    }
                }
                const float* qan = args.in[13] + (size_t)j * 256; const float* kvan = args.in[14] + (size_t)j * 128;
                for (int r = gw; r < MTOK; r += 4 * NGW) {
                    const int r1 = r + NGW, r2 = r + 2 * NGW, r3 = r + 3 * NGW; const bool has1 = r1 < MTOK, has2 = r2 < MTOK, has3 = r3 < MTOK;
                    P1Row p0, p1, p2, p3; p1_load(p0, PROJ + (size_t)r * 512, lane); p1_load(p1, PROJ + (size_t)(has1 ? r1 : r) * 512, lane);
                    p1_load(p2, PROJ + (size_t)(has2 ? r2 : r) * 512, lane); p1_load(p3, PROJ + (size_t)(has3 ? r3 : r) * 512, lane);
                    p1_finish(p0, r, j, lane, qan, kvan, QKVLAT, KROPE, OUT_CKV, OUT_KR); if (has1) p1_finish(p1, r1, j, lane, qan, kvan, QKVLAT, KROPE, OUT_CKV, OUT_KR);
                    if (has2) p1_finish(p2, r2, j, lane, qan, kvan, QKVLAT, KROPE, OUT_CKV, OUT_KR); if (has3) p1_finish(p3, r3, j, lane, qan, kvan, QKVLAT, KROPE, OUT_CKV, OUT_KR);
                }
                for (int cidx = gw; cidx < 4096; cidx += NGW) {
                    const int b = cidx >> 9, p = cidx & 511; const int e = NCTX + b * KVB + LLAT + p;
                    const u32x2 z = {0u, 0u}; *(u32x2*)(QKVLAT + (size_t)e * 384 + 4 * lane) = z;
                    if (lane < 32) { const f32x4 kv = *(const f32x4*)(args.in[2] + (((size_t)b * 2 + j) * 512 + p) * 128 + 4 * lane); u32x2 w2; w2.x = cvt_pk_bf16(kv[0], kv[1]); w2.y = cvt_pk_bf16(kv[2], kv[3]);
                        *(u32x2*)(QKVLAT + (size_t)e * 384 + 256 + 4 * lane) = w2; }
                }
            } else if (EN_POST2 && op == 8) {
                const float* qn = args.in[17] + (size_t)j * 96; const float* kn = args.in[18] + (size_t)j * 96;
                const int hh = lane >> 3, s = lane & 7;
                for (int e = gw; e < MEXT; e += 2 * NGW) {
                    const int e1 = e + NGW; const bool has1 = e1 < MEXT;
                    P2Row r0, r1;
                    p2_load(r0, e, j, hh, s, QKV, KROPE, args.in[3]); p2_load(r1, has1 ? e1 : e, j, hh, s, QKV, KROPE, args.in[3]);
                    p2_compute(r0, s, qn, kn, ROPE); p2_compute(r1, s, qn, kn, ROPE);
                    asm volatile("s_waitcnt vmcnt(0)" ::: "memory");
                    p2_store(r0, hh, s, QKV); if (has1) p2_store(r1, hh, s, QKV);
                    asm volatile("" ::: "memory");
                }
            } else if (EN_ATT && op == 9) {
                const int vcu = (G % 8 == 0) ? (bid % 8) * (G / 8) + bid / 8 : bid;
                for (int u = vcu; u < 1280; u += G) {
                    const bf16_t *Qb, *Kh, *Vh; bf16_t* Ob; int seq;
                    if (u < 1024) { const int bh = u >> 4, qt = u & 15, b = bh >> 3, h = bh & 7; const size_t e0 = NCTX + (size_t)b * KVB;
                        Qb = QKV + (e0 + qt * 256) * QLD + h * 96; Kh = QKV + e0 * QLD + 768 + h * 96; Vh = QKV + e0 * QLD + 1536 + h * 64;
                        Ob = MIX + ((size_t)NCTX + (size_t)b * LLAT + qt * 256) * 1024 + h * 64; seq = KVB; }
                    else { const int vv = u - 1024, b = vv >> 3, h = vv & 7; const size_t e0 = (size_t)b * 256;
                        Qb = QKV + e0 * QLD + h * 96; Kh = QKV + e0 * QLD + 768 + h * 96; Vh = QKV + e0 * QLD + 1536 + h * 64; Ob = MIX + e0 * 1024 + h * 64; seq = 256; }
                    __syncthreads();
                    att::attn_unit(Qb, Kh, Vh, Ob, seq, (char*)lds);
                }
            } else if (EN_POOL && op == 14) {
                const float* rs = RSS + (size_t)(layer * 3 + 1) * MTOK;
                for (long i = gt; i < (long)(MTOK / 32) * 128; i += NGT) {
                    const int seg = (int)(i >> 7), ch = (int)(i & 127), hw = 1 << (ch >> 5);
                    const int r0 = seg * 32; int t0, L; if (r0 < NCTX) { t0 = r0 & 255; L = 256; } else { t0 = (r0 - NCTX) & 4095; L = 4096; }
                    const int base = r0 - t0; const bf16_t* __restrict__ hp = H + (size_t)base * 1024 + ch * 8; const float* __restrict__ rsp = rs + base; bf16_t* __restrict__ pbp = PB + (size_t)base * 1024 + ch * 8;
                    float sum[8];
#pragma unroll
                    for (int e2 = 0; e2 < 8; ++e2) sum[e2] = 0.f;
#define POOL_LD(tt, wgt) do { const u32x4 w_ = *(const u32x4*)(hp + (size_t)(tt) * 1024); const float q_ = (wgt) * __builtin_amdgcn_rsqf(rsp[tt] * (1.0f / 1024.0f) + EPS); \
                        _Pragma("unroll") for (int e2 = 0; e2 < 4; ++e2) { sum[2 * e2] += bflo(w_[e2]) * q_; sum[2 * e2 + 1] += bfhi(w_[e2]) * q_; } } while (0)
#pragma unroll
                    for (int i2 = 0; i2 < 16; ++i2) { const int tt = t0 - hw + i2; const bool ok = (i2 < 2 * hw) && tt >= 0; const int tc = tt < 0 ? 0 : (tt > L - 1 ? L - 1 : tt); POOL_LD(tc, ok ? 1.0f : 0.0f); }
#pragma unroll 4
                    for (int t = t0; t < t0 + 32; ++t) {
                        const int lo2 = t - hw < 0 ? 0 : t - hw, hi2 = t + hw > L ? L : t + hw; const float inv = 1.0f / (float)(hi2 - lo2);
                        const u32x4 w0 = *(const u32x4*)(hp + (size_t)t * 1024); const float q0 = __builtin_amdgcn_rsqf(rsp[t] * (1.0f / 1024.0f) + EPS); u32x4 o;
#pragma unroll
                        for (int e2 = 0; e2 < 4; ++e2) o[e2] = cvt_pk_bf16(sum[2 * e2] * inv - bflo(w0[e2]) * q0, sum[2 * e2 + 1] * inv - bfhi(w0[e2]) * q0);
                        *(u32x4*)(pbp + (size_t)t * 1024) = o;
                        { const int tp = t + hw, tm = t - hw; const int tpc = tp > L - 1 ? L - 1 : tp, tmc = tm < 0 ? 0 : tm;
                          POOL_LD(tpc, tp < L ? 1.0f : 0.0f); POOL_LD(tmc, tm >= 0 ? -1.0f : 0.0f); }
                    }
#undef POOL_LD
                }
            }
            if (rep + 1 < reps || pid + 1 < hi) xcd_barrier(xbar);
            }
        }
    }
}

extern "C" void kernel_launch(void* const* d_in, const int* in_sizes, int n_in, void* d_out, int out_size, void* d_ws, size_t ws_size, hipStream_t stream) {
    static int grid = 0;
    if (grid == 0) {
        if (n_in != 25 || ws_size < WS_NEED) { fprintf(stderr, "kernel_launch: n_in %d ws %zu (need %zu)\n", n_in, ws_size, (size_t)WS_NEED); grid = -1; return; }
        int dev = 0, cus = 0, per_cu = 0;
        hipGetDevice(&dev); hipDeviceGetAttribute(&cus, hipDeviceAttributeMultiprocessorCount, dev);
        if (hipFuncSetAttribute((const void*)fwd_mega, hipFuncAttributeMaxDynamicSharedMemorySize, LDS_BYTES) != hipSuccess) { fprintf(stderr, "kernel_launch: hipFuncSetAttribute failed\n"); grid = -1; return; }
        if (hipOccupancyMaxActiveBlocksPerMultiprocessor(&per_cu, (const void*)fwd_mega, 512, LDS_BYTES) != hipSuccess || per_cu < 1) { fprintf(stderr, "kernel_launch: occupancy query gave %d\n", per_cu); per_cu = 1; }
        (void)hipGetLastError();
        grid = cus * per_cu;
    }
    if (grid < 0) return;
    Args a{};
    for (int i = 0; i < 25; ++i) a.in[i] = (const float*)d_in[i];
    a.out = (float*)d_out; a.ws = (unsigned char*)d_ws; a.ph_lo = 0; a.ph_hi = 34;
    void* kargs[] = {&a};
    hipError_t e = hipLaunchCooperativeKernel((const void*)fwd_mega, dim3(grid), dim3(512), kargs, LDS_BYTES, stream);
    if (e != hipSuccess) fprintf(stderr, "kernel_launch: cooperative launch failed: %s (grid %d)\n", hipGetErrorString(e), grid);
}
```
